# Optimizing an MI355X kernel written in HIP

```python
import math
import jax, jax.numpy as jnp
from jax import lax
import numpy as np

D_MODEL = 1024
BATCH = 16
SEQ = 4096
DEPTH = 2

CHUNK = 64
HEAD_DIM = 64
D_MIX = D_MODEL
N_GH = 4
GROUP_W = N_GH * HEAD_DIM
IDX_HEADS = 8
IDX_DIM = 64
TOPK_MAX = 256
RET_THETA = 10000.0
GLA_DK = HEAD_DIM // 2
GLA_RANK = 16
GLA_TAU = 16.0
DIFF_DK = HEAD_DIM // 2
ROPE_THETA = 500000.0
ROPE_FRAC = 4
D_FF = 4 * D_MODEL
Q_BLOCK = 128
EPS = 1e-6
NEG_INF = -1e30

IN_SPLITS = (
    GROUP_W, HEAD_DIM, HEAD_DIM, IDX_HEADS * IDX_DIM, IDX_DIM, IDX_HEADS,
    GROUP_W, GROUP_W, GROUP_W, GROUP_W,
    N_GH * GLA_DK, N_GH * GLA_DK, GROUP_W, GLA_RANK, GROUP_W,
    2 * N_GH * DIFF_DK, 2 * N_GH * DIFF_DK, GROUP_W,
)
IN_COLS = sum(IN_SPLITS)

kernel_name = "chunk_causal_hybrid_head_group_trunk"


def rms_norm(x, g):
    xf = x.astype(jnp.float32)
    y = xf * lax.rsqrt(jnp.mean(xf * xf, axis=-1, keepdims=True) + EPS)
    return (y * g.astype(jnp.float32)).astype(x.dtype)


def head_norm(y, g, center, dtype):
    B, T, H, D = y.shape
    yf = y.astype(jnp.float32)
    if center:
        yf = yf - jnp.mean(yf, axis=-1, keepdims=True)
    yf = yf * lax.rsqrt(jnp.mean(yf * yf, axis=-1, keepdims=True) + EPS)
    yf = yf * g.astype(jnp.float32).reshape(H, D)
    return yf.reshape(B, T, H * D).astype(dtype)


def rope(x, pos, rot_dims, theta):
    half = rot_dims // 2
    inv = theta ** (-jnp.arange(half, dtype=jnp.float32) / half)
    ang = pos.astype(jnp.float32)[..., None] * inv
    cos = jnp.cos(ang)[:, :, None, :].astype(x.dtype)
    sin = jnp.sin(ang)[:, :, None, :].astype(x.dtype)
    x1, x2, xp = x[..., :half], x[..., half:rot_dims], x[..., rot_dims:]
    return jnp.concatenate([x1 * cos - x2 * sin, x1 * sin + x2 * cos, xp], axis=-1)


def split_blocks(a, size):
    B, T = a.shape[:2]
    return jnp.moveaxis(a.reshape((B, T // size, size) + a.shape[2:]), 1, 0)


def merge_blocks(a):
    N, B, S = a.shape[:3]
    return jnp.moveaxis(a, 0, 1).reshape((B, N * S) + a.shape[3:])


def dsa_mixer(q, k, v, qi, ki, wi, pos):
    B, T = q.shape[:2]
    topk = min(TOPK_MAX, T // 4)
    q = rope(q, pos, HEAD_DIM // ROPE_FRAC, ROPE_THETA) * (HEAD_DIM ** -0.5)
    k = rope(k[:, :, None], pos, HEAD_DIM // ROPE_FRAC, ROPE_THETA)[:, :, 0]
    qi = rope(qi, pos, IDX_DIM // ROPE_FRAC, ROPE_THETA)
    ki = rope(ki[:, :, None], pos, IDX_DIM // ROPE_FRAC, ROPE_THETA)[:, :, 0]
    wi = wi * (IDX_HEADS ** -0.5 * IDX_DIM ** -0.5)
    key_chunk = jnp.arange(T) // CHUNK
    gather = jax.vmap(lambda tab, idx: tab[idx])

    def block(args):
        qb, qib, wib, blk = args
        q_chunk = (blk * Q_BLOCK + jnp.arange(Q_BLOCK)) // CHUNK
        admissible = key_chunk[None, :] <= q_chunk[:, None]
        logits = jnp.einsum("bqhd,bsd->bqhs", qib, ki)
        score = jnp.einsum("bqh,bqhs->bqs", wib, jax.nn.relu(logits)).astype(jnp.float32)
        score = jnp.where(admissible[None], score, NEG_INF)
        _, sel = lax.top_k(score, topk)
        valid = (sel // CHUNK) <= q_chunk[None, :, None]
        k_sel = gather(k, sel)
        v_sel = gather(v, sel)
        s = jnp.einsum("bqhd,bqkd->bqhk", qb, k_sel).astype(jnp.float32)
        s = jnp.where(valid[:, :, None, :], s, NEG_INF)
        p = jax.nn.softmax(s, axis=-1).astype(v.dtype)
        return jnp.einsum("bqhk,bqkd->bqhd", p, v_sel)

    out = lax.map(block, (split_blocks(q, Q_BLOCK), split_blocks(qi, Q_BLOCK),
                          split_blocks(wi, Q_BLOCK), jnp.arange(T // Q_BLOCK)))
    return merge_blocks(out)


def retention_mixer(q, k, v, pos):
    B, T, H, D = q.shape
    f32 = jnp.float32
    q = (rope(q, pos, HEAD_DIM, RET_THETA) * (HEAD_DIM ** -0.5)).astype(f32)
    k = rope(k, pos, HEAD_DIM, RET_THETA).astype(f32)
    v = v.astype(f32)
    log_g = jnp.log(1.0 - 2.0 ** (-5.0 - jnp.arange(H, dtype=f32)))
    i = jnp.arange(CHUNK, dtype=f32)
    d_intra = jnp.exp(jnp.abs(i[:, None] - i[None, :])[None] * log_g[:, None, None])
    xi = jnp.exp((i + 1.0)[:, None] * log_g[None, :])[None, :, :, None]
    zeta = jnp.exp((CHUNK - 1.0 - i)[:, None] * log_g[None, :])[None, :, :, None]
    g_chunk = jnp.exp(CHUNK * log_g)[None, :, None, None]

    def step(R, xs):
        qc, kc, vc = xs
        s = jnp.einsum("bihd,bjhd->bhij", qc, kc) * d_intra[None]
        intra = jnp.einsum("bhij,bjhd->bihd", s, vc)
        inter = jnp.einsum("bihd,bhde->bihe", qc, R) * xi
        R = g_chunk * R + jnp.einsum("bjhd,bjhe->bhde", kc * zeta, vc)
        return R, intra + inter

    R0 = jnp.zeros((B, H, D, D), f32)
    _, out = lax.scan(step, R0, (split_blocks(q, CHUNK), split_blocks(k, CHUNK),
                                 split_blocks(v, CHUNK)))
    return merge_blocks(out)


def gla_mixer(q, k, v, a_low, w_a2, b_a):
    B, T, H, DV = v.shape
    f32 = jnp.float32
    log_a = jax.nn.log_sigmoid((jnp.einsum("btr,rk->btk", a_low, w_a2) + b_a).astype(f32)) / GLA_TAU
    log_a = log_a.reshape(B, T, H, GLA_DK)
    q = (q * (GLA_DK ** -0.5)).astype(f32)
    k = k.astype(f32)
    v = v.astype(f32)

    def step(S, xs):
        qc, kc, vc, lac = xs
        b = jnp.cumsum(lac, axis=1)
        decay = jnp.exp(-jnp.abs(b[:, :, None] - b[:, None, :]))
        A = jnp.einsum("bthk,btshk,bshk->bhts", qc, decay, kc)
        intra = jnp.einsum("bhts,bshd->bthd", A, vc)
        inter = jnp.einsum("bthk,bhkd->bthd", qc * jnp.exp(b), S)
        b_last = b[:, -1]
        S = jnp.exp(b_last)[..., None] * S + jnp.einsum(
            "bshk,bshd->bhkd", kc * jnp.exp(b_last[:, None] - b), vc)
        return S, intra + inter

    S0 = jnp.zeros((B, H, GLA_DK, DV), f32)
    _, out = lax.scan(step, S0, (split_blocks(q, CHUNK), split_blocks(k, CHUNK),
                                 split_blocks(v, CHUNK), split_blocks(log_a, CHUNK)))
    return merge_blocks(out)


def diff_mixer(q, k, v, pos, lam_q1, lam_k1, lam_q2, lam_k2, lam_init):
    B, T = q.shape[:2]
    f32 = jnp.float32
    q = rope(q, pos, DIFF_DK // ROPE_FRAC, ROPE_THETA) * (DIFF_DK ** -0.5)
    k = rope(k, pos, DIFF_DK // ROPE_FRAC, ROPE_THETA)
    q = q.reshape(B, T, N_GH, 2, DIFF_DK)
    k = k.reshape(B, T, N_GH, 2, DIFF_DK)
    lam = (jnp.exp(jnp.sum(lam_q1.astype(f32) * lam_k1.astype(f32)))
           - jnp.exp(jnp.sum(lam_q2.astype(f32) * lam_k2.astype(f32))) + lam_init)
    key_chunk = jnp.arange(T) // CHUNK

    def block(args):
        qb, blk = args
        q_chunk = (blk * Q_BLOCK + jnp.arange(Q_BLOCK)) // CHUNK
        mask = key_chunk[None, :] <= q_chunk[:, None]
        s = jnp.einsum("bqhcd,bshcd->bhcqs", qb, k).astype(f32)
        s = jnp.where(mask[None, None, None], s, NEG_INF)
        p = jax.nn.softmax(s, axis=-1)
        w = p[:, :, 0] - lam * p[:, :, 1]
        return jnp.einsum("bhqs,bshd->bqhd", w.astype(v.dtype), v)

    out = lax.map(block, (split_blocks(q, Q_BLOCK), jnp.arange(T // Q_BLOCK)))
    return merge_blocks(out)


def hybrid_layer(x, cond, pos, layer_idx, mod_w, mod_b, attn_pre_g, attn_post_g,
                 mlp_pre_g, mlp_post_g, w_in, gla_wa2, gla_ba, lam_q1, lam_k1,
                 lam_q2, lam_k2, head_norm_g, w_out, mlp_w1, mlp_w2):
    B, T, _ = x.shape
    dt = x.dtype
    mod = (cond @ mod_w + mod_b)[:, None, :]
    shift1, scale1, gate1, shift2, scale2, gate2 = jnp.split(mod, 6, axis=-1)

    h = rms_norm(x, attn_pre_g) * (1.0 + scale1) + shift1
    proj = h @ w_in
    (a_q, a_k, a_v, a_qi, a_ki, a_wi, b_q, b_k, b_v, b_g,
     c_q, c_k, c_v, c_a, c_g, d_q, d_k, d_v) = jnp.split(
        proj, np.cumsum(IN_SPLITS)[:-1].tolist(), axis=-1)
    heads = lambda a, d: a.reshape(B, T, -1, d)
    g_a, g_b, g_c, g_d = jnp.split(head_norm_g, 4)
    lam_init = 0.8 - 0.6 * math.exp(-0.3 * layer_idx)

    y_a = head_norm(dsa_mixer(heads(a_q, HEAD_DIM), a_k, a_v, heads(a_qi, IDX_DIM),
                              a_ki, a_wi, pos), g_a, False, dt)
    y_b = jax.nn.silu(b_g) * head_norm(retention_mixer(
        heads(b_q, HEAD_DIM), heads(b_k, HEAD_DIM), heads(b_v, HEAD_DIM), pos), g_b, True, dt)
    y_c = jax.nn.silu(c_g) * head_norm(gla_mixer(
        heads(c_q, GLA_DK), heads(c_k, GLA_DK), heads(c_v, HEAD_DIM), c_a, gla_wa2, gla_ba),
        g_c, True, dt)
    y_d = head_norm(diff_mixer(heads(d_q, DIFF_DK), heads(d_k, DIFF_DK), heads(d_v, HEAD_DIM),
                               pos, lam_q1, lam_k1, lam_q2, lam_k2, lam_init),
                    g_d, False, dt) * (1.0 - lam_init)
    y = jnp.concatenate([y_a, y_b, y_c, y_d], axis=-1) @ w_out
    x = x + gate1 * rms_norm(y, attn_post_g)

    h = rms_norm(x, mlp_pre_g) * (1.0 + scale2) + shift2
    y = jnp.square(jax.nn.relu(h @ mlp_w1)) @ mlp_w2
    return x + gate2 * rms_norm(y, mlp_post_g)


def setup_inputs(seed: int = 0) -> dict:
    key = jax.random.key(seed)
    ks = jax.random.split(key, 20)
    nrm = lambda k, shape, s: jax.random.normal(k, shape, jnp.float32) * s
    gain = lambda k, shape: 1.0 + 0.02 * jax.random.normal(k, shape, jnp.float32)
    x = nrm(ks[0], (BATCH, SEQ, D_MODEL), 1.0)
    c = nrm(ks[1], (BATCH, D_MODEL), 1.0)
    offset = jax.random.randint(ks[2], (BATCH, 1), 0, 64, dtype=jnp.int32) * CHUNK
    positions = offset + jnp.arange(SEQ, dtype=jnp.int32)[None, :]
    return {
        "x": x,
        "c": c,
        "positions": positions,
        "mod_w": nrm(ks[3], (DEPTH, D_MODEL, 6 * D_MODEL), 0.5 * D_MODEL ** -0.5),
        "mod_b": nrm(ks[4], (DEPTH, 6 * D_MODEL), 0.01),
        "attn_pre_g": gain(ks[5], (DEPTH, D_MODEL)),
        "attn_post_g": gain(ks[6], (DEPTH, D_MODEL)),
        "mlp_pre_g": gain(ks[7], (DEPTH, D_MODEL)),
        "mlp_post_g": gain(ks[8], (DEPTH, D_MODEL)),
        "w_in": nrm(ks[9], (DEPTH, D_MODEL, IN_COLS), D_MODEL ** -0.5),
        "gla_wa2": nrm(ks[10], (DEPTH, GLA_RANK, N_GH * GLA_DK), GLA_RANK ** -0.5),
        "gla_ba": nrm(ks[11], (DEPTH, N_GH * GLA_DK), 0.1),
        "lam_q1": nrm(ks[12], (DEPTH, DIFF_DK), 0.1),
        "lam_k1": nrm(ks[13], (DEPTH, DIFF_DK), 0.1),
        "lam_q2": nrm(ks[14], (DEPTH, DIFF_DK), 0.1),
        "lam_k2": nrm(ks[15], (DEPTH, DIFF_DK), 0.1),
        "head_norm_g": gain(ks[16], (DEPTH, D_MIX)),
        "w_out": nrm(ks[17], (DEPTH, D_MIX, D_MODEL), D_MIX ** -0.5),
        "mlp_w1": nrm(ks[18], (DEPTH, D_MODEL, D_FF), D_MODEL ** -0.5),
        "mlp_w2": nrm(ks[19], (DEPTH, D_FF, D_MODEL), D_FF ** -0.5),
    }


def reference(x, c, positions, mod_w, mod_b, attn_pre_g, attn_post_g, mlp_pre_g,
              mlp_post_g, w_in, gla_wa2, gla_ba, lam_q1, lam_k1, lam_q2, lam_k2,
              head_norm_g, w_out, mlp_w1, mlp_w2):
    cond = jax.nn.silu(c)
    for l in range(DEPTH):
        x = hybrid_layer(x, cond, positions, l, mod_w[l], mod_b[l], attn_pre_g[l],
                         attn_post_g[l], mlp_pre_g[l], mlp_post_g[l], w_in[l],
                         gla_wa2[l], gla_ba[l], lam_q1[l], lam_k1[l], lam_q2[l],
                         lam_k2[l], head_norm_g[l], w_out[l], mlp_w1[l], mlp_w2[l])
    return x
```

```cpp
#include <hip/hip_runtime.h>
#include <cstdio>
#include <cstdint>
namespace pg8 {
#define PG8_LAS __attribute__((address_space(3)))
typedef unsigned short bf16_t;
typedef short bf16x8 __attribute__((ext_vector_type(8)));
typedef float f32x4 __attribute__((ext_vector_type(4)));
typedef unsigned u32x4 __attribute__((ext_vector_type(4)));
typedef int i32x4 __attribute__((ext_vector_type(4)));
typedef int i32x8 __attribute__((ext_vector_type(8)));
__device__ __forceinline__ i32x8 cat8(bf16x8 lo, bf16x8 hi) { return __builtin_shufflevector(__builtin_bit_cast(i32x4, lo), __builtin_bit_cast(i32x4, hi), 0, 1, 2, 3, 4, 5, 6, 7); }
constexpr int BM = 256, BK = 64, HALF = 128, HTB = HALF * BK * 2  , STAGE_BYTES = 8 * HTB, NXCD = 8, WGM = 8;

__host__ __device__ __forceinline__ int lds_byte(int r, int c) { const int st = (r >> 4) * 2 + (c >> 5), rr = r & 15, cc = c & 31, ob = rr * 64 + cc * 2; return st * 1024 + (ob ^ (((ob >> 9) & 1) << 5)); }
__host__ __device__ __forceinline__ void stage_rc(int b, int& R, int& C) { const int st = b / 1024, sb = b % 1024, swz = sb ^ (((sb >> 9) & 1) << 5); R = (st >> 1) * 16 + swz / 64; C = (st & 1) * 32 + (swz % 64) / 2; }
__host__ __device__ __forceinline__ int perm32(int rho) { const int n = rho >> 4, i = rho & 15; return 8 * (i >> 2) + 4 * n + (i & 3); }

struct Unit { int pm, pn; };
struct Gemm { const bf16_t* A; const bf16_t* Bt; int M, N, K; };

struct StaticOrder {
    int nM, nN, nwg, G, c;
    __host__ __device__ void init(int M, int N, int G_, int c_) { nM = M / BM; nN = N / BM; nwg = nM * nN; G = G_; c = c_; }
    __host__ __device__ bool next(int i, Unit& u) const {
        const long L = (long)i * G + c; if (L >= nwg) return false;
        int wgid = (int)L; { const int q = nwg / NXCD, r = nwg % NXCD, xcd = wgid % NXCD, off = wgid / NXCD; wgid = (xcd < r ? xcd * (q + 1) : r * (q + 1) + (xcd - r) * q) + off; }
        const int nig = WGM * nN, gid = wgid / nig, fm = gid * WGM, gsz = (nM - fm) < WGM ? (nM - fm) : WGM;
        u.pm = fm + ((wgid % nig) % gsz); u.pn = (wgid % nig) / gsz; return true;
    }
    __device__ __forceinline__ void a_ready(const Unit&) const {}
    __device__ __forceinline__ void done(const Unit&) const {}
};

template <class Epi, class Sched, bool ALIGN_EPI = false, bool SP2 = false, bool F8 = false>
__device__ __forceinline__ void gemm_phase(PG8_LAS unsigned char* lds, const Gemm g, const Sched& S, const Epi& E, int tid_in) {
    int tid_o = tid_in; asm volatile("" : "+v"(tid_o));
    const int tid = tid_o, wid = __builtin_amdgcn_readfirstlane(tid >> 6), lane = tid & 63, wr = wid >> 2, wc = wid & 3, fr = lane & 15, fq = lane >> 4;
    const int K = g.K, nt = K / BK;
    unsigned voffA[2], voffB[2];
#pragma unroll
    for (int i = 0; i < 2; ++i) { int R, C; stage_rc(tid * 16 + i * 8192, R, C); const int Rb = Epi::PERM ? ((R & ~31) + perm32(R & 31)) : R;
        voffA[i] = (unsigned)(R * K + C) * 2u; voffB[i] = (unsigned)(Rb * K + C) * 2u; }
    const size_t kstep = (size_t)(BK * 2);
    const size_t hstep = (size_t)HALF * K * 2;
    const size_t tstep = 2 * hstep;
    const unsigned ldsw = (unsigned)wid * 1024u;
    const int aoff = lds_byte(wr * 64 + fr, fq * 8), boff = lds_byte(wc * 32 + fr, fq * 8);
#define PG8_SA(b, h) (((b) * 2 + (h)) * HTB)
#define PG8_SB(b, h) ((4 + (b) * 2 + (h)) * HTB)
#define PG8_STAGE(bufoff, gbase, voff) do { _Pragma("unroll") for (int _i = 0; _i < 2; ++_i) \
        __builtin_amdgcn_global_load_lds((const unsigned*)((const char*)(gbase) + (voff)[_i]), (PG8_LAS unsigned*)(lds + (bufoff) + ldsw + _i * 8192), 16, 0, 0); } while (0)
#define PG8_LDA(dst, b, h) do { _Pragma("unroll") for (int m = 0; m < 4; ++m) _Pragma("unroll") for (int k = 0; k < 2; ++k) dst[m][k] = *(const PG8_LAS bf16x8*)(lds + PG8_SA(b, h) + aoff + m * 2048 + k * 1024); } while (0)
#define PG8_LDB(dst, b, h) do { _Pragma("unroll") for (int n = 0; n < 2; ++n) _Pragma("unroll") for (int k = 0; k < 2; ++k) dst[n][k] = *(const PG8_LAS bf16x8*)(lds + PG8_SB(b, h) + boff + n * 2048 + k * 1024); } while (0)
#define PG8_MMA(ai, bj, At, Bt) do { __builtin_amdgcn_s_setprio(1); if constexpr (F8) { _Pragma("unroll") for (int m = 0; m < 4; ++m) _Pragma("unroll") for (int n = 0; n < 2; ++n) \
        acc[ai][bj][m][n] = __builtin_amdgcn_mfma_scale_f32_16x16x128_f8f6f4(cat8(Bt[n][0], Bt[n][1]), cat8(At[m][0], At[m][1]), acc[ai][bj][m][n], 0, 0, 0, 0, 0, 0); } else { \
        _Pragma("unroll") for (int m = 0; m < 4; ++m) _Pragma("unroll") for (int n = 0; n < 2; ++n) _Pragma("unroll") for (int k = 0; k < 2; ++k) \
        acc[ai][bj][m][n] = __builtin_amdgcn_mfma_f32_16x16x32_bf16(Bt[n][k], At[m][k], acc[ai][bj][m][n], 0, 0, 0); } __builtin_amdgcn_s_setprio(0); } while (0)
#define PG8_WAIT_V(n) asm volatile("s_waitcnt vmcnt(" #n ")" ::: "memory")
#define PG8_WAIT_L(n) asm volatile("s_waitcnt lgkmcnt(" #n ")" ::: "memory")
#define PG8_BAR __builtin_amdgcn_s_barrier()
#define PG8_SCHED __builtin_amdgcn_sched_barrier(0)
    Unit cur, nxt; int ui = 0;
    if (!S.next(0, cur)) return;
    f32x4 acc[2][2][4][2];
#pragma unroll
    for (int a = 0; a < 2; ++a)
#pragma unroll
        for (int b = 0; b < 2; ++b)
#pragma unroll
            for (int m = 0; m < 4; ++m)
#pragma unroll
                for (int n = 0; n < 2; ++n) acc[a][b][m][n] = (f32x4){0.f, 0.f, 0.f, 0.f};
    bf16x8 At[4][2], B0[2][2], B1[2][2];
    const char* cA = (const char*)g.A + (size_t)cur.pm * tstep; const char* cB = (const char*)g.Bt + (size_t)cur.pn * tstep;
    S.a_ready(cur);
    if constexpr (SP2) {
        PG8_STAGE(PG8_SB(0, 0), cB, voffB); PG8_STAGE(PG8_SB(0, 1), cB + hstep, voffB); PG8_STAGE(PG8_SA(0, 0), cA, voffA); PG8_STAGE(PG8_SA(0, 1), cA + hstep, voffA);
        if (wr == 1) PG8_BAR;
        PG8_WAIT_V(2); PG8_BAR;
        PG8_STAGE(PG8_SB(1, 0), cB + kstep, voffB); PG8_STAGE(PG8_SA(1, 0), cA + kstep, voffA); PG8_STAGE(PG8_SB(1, 1), cB + hstep + kstep, voffB);
        PG8_WAIT_V(6); PG8_BAR;
    } else {
        PG8_STAGE(PG8_SB(0, 0), cB, voffB); PG8_STAGE(PG8_SA(0, 0), cA, voffA); PG8_STAGE(PG8_SB(0, 1), cB + hstep, voffB); PG8_STAGE(PG8_SA(0, 1), cA + hstep, voffA);
        if (wr == 1) PG8_BAR;
        PG8_WAIT_V(4); PG8_BAR;
        PG8_STAGE(PG8_SB(1, 0), cB + kstep, voffB); PG8_STAGE(PG8_SA(1, 0), cA + kstep, voffA); PG8_STAGE(PG8_SB(1, 1), cB + hstep + kstep, voffB);
        PG8_WAIT_V(6); PG8_BAR;
    }
    for (;;) {
        const bool has_next = S.next(ui + 1, nxt);
        const char* nA = has_next ? (const char*)g.A + (size_t)nxt.pm * tstep : cA; const char* nB = has_next ? (const char*)g.Bt + (size_t)nxt.pn * tstep : cB;
        for (int t = 0; t < nt; t += 2) {
            if constexpr (F8) asm volatile("" : "+v"(voffA[0]), "+v"(voffA[1]), "+v"(voffB[0]), "+v"(voffB[1]));
            const bool last = (t == nt - 2);
            const char* a1 = cA + (size_t)(t + 1) * kstep;
            const char* a2 = last ? nA : cA + (size_t)(t + 2) * kstep; const char* b2 = last ? nB : cB + (size_t)(t + 2) * kstep;
            const char* a3 = a2 + kstep; const char* b3 = b2 + kstep;
            if (last && has_next) S.a_ready(nxt);
            if constexpr (SP2) {
            PG8_LDB(B0, 0, 0); PG8_LDB(B1, 0, 1); PG8_SCHED; PG8_LDA(At, 0, 0); PG8_STAGE(PG8_SA(1, 1), a1 + hstep, voffA);
            PG8_WAIT_V(8); PG8_WAIT_L(0); PG8_BAR; PG8_MMA(0, 0, At, B0); PG8_MMA(0, 1, At, B1); PG8_BAR; PG8_SCHED;
            PG8_LDA(At, 0, 1); PG8_STAGE(PG8_SB(0, 0), b2, voffB); PG8_STAGE(PG8_SB(0, 1), b2 + hstep, voffB); PG8_STAGE(PG8_SA(0, 0), a2, voffA);
            PG8_WAIT_V(8); PG8_WAIT_L(0); PG8_BAR; PG8_MMA(1, 0, At, B0); PG8_MMA(1, 1, At, B1); PG8_BAR; PG8_SCHED;
            PG8_LDB(B0, 1, 0); PG8_LDB(B1, 1, 1); PG8_SCHED; PG8_LDA(At, 1, 0); PG8_STAGE(PG8_SA(0, 1), a2 + hstep, voffA);
            PG8_WAIT_V(8); PG8_WAIT_L(0); PG8_BAR; PG8_MMA(0, 0, At, B0); PG8_MMA(0, 1, At, B1); PG8_BAR; PG8_SCHED;
            PG8_LDA(At, 1, 1); PG8_STAGE(PG8_SB(1, 0), b3, voffB); PG8_STAGE(PG8_SB(1, 1), b3 + hstep, voffB); PG8_STAGE(PG8_SA(1, 0), a3, voffA);
            PG8_WAIT_V(8); PG8_WAIT_L(0); PG8_BAR; PG8_MMA(1, 0, At, B0); PG8_MMA(1, 1, At, B1); PG8_BAR; PG8_SCHED;
            } else {
            PG8_LDB(B0, 0, 0); PG8_SCHED; PG8_LDA(At, 0, 0); PG8_STAGE(PG8_SA(1, 1), a1 + hstep, voffA);
            PG8_WAIT_L(8); PG8_BAR; PG8_WAIT_L(0); PG8_MMA(0, 0, At, B0); PG8_BAR; PG8_SCHED;
            PG8_LDB(B1, 0, 1); PG8_STAGE(PG8_SB(0, 0), b2, voffB);
            PG8_BAR; PG8_WAIT_L(0); PG8_MMA(0, 1, At, B1); PG8_BAR;
            PG8_LDA(At, 0, 1); PG8_STAGE(PG8_SA(0, 0), a2, voffA);
            PG8_BAR; PG8_WAIT_L(0); PG8_MMA(1, 0, At, B0); PG8_BAR; PG8_SCHED;
            PG8_STAGE(PG8_SB(0, 1), b2 + hstep, voffB);
            PG8_WAIT_V(6); PG8_BAR; PG8_MMA(1, 1, At, B1); PG8_BAR;
            PG8_LDB(B0, 1, 0); PG8_SCHED; PG8_LDA(At, 1, 0); PG8_STAGE(PG8_SA(0, 1), a2 + hstep, voffA);
            PG8_WAIT_L(8); PG8_BAR; PG8_WAIT_L(0); PG8_MMA(0, 0, At, B0); PG8_BAR; PG8_SCHED;
            PG8_LDB(B1, 1, 1); PG8_STAGE(PG8_SB(1, 0), b3, voffB);
            PG8_BAR; PG8_WAIT_L(0); PG8_MMA(0, 1, At, B1); PG8_BAR;
            PG8_LDA(At, 1, 1); PG8_STAGE(PG8_SA(1, 0), a3, voffA);
            PG8_BAR; PG8_WAIT_L(0); PG8_MMA(1, 0, At, B0); PG8_BAR; PG8_SCHED;
            PG8_STAGE(PG8_SB(1, 1), b3 + hstep, voffB);
            PG8_WAIT_V(6); PG8_BAR; PG8_MMA(1, 1, At, B1); PG8_BAR;
            }
        }
        if constexpr (ALIGN_EPI) { if (wr == 0) PG8_BAR; }
        if constexpr (!Epi::AFTER_DRAIN) {
            if constexpr (F8) { int le; asm volatile("v_mbcnt_lo_u32_b32 %0, -1, 0\n\tv_mbcnt_hi_u32_b32 %0, -1, %0" : "=v"(le)); E(acc, cur, wr, wc, le & 15, le >> 4); }
            else E(acc, cur, wr, wc, fr, fq);
            S.done(cur); }
        if (!has_next) break;
#pragma unroll
        for (int a = 0; a < 2; ++a)
#pragma unroll
            for (int b = 0; b < 2; ++b)
#pragma unroll
                for (int m = 0; m < 4; ++m)
#pragma unroll
                    for (int n = 0; n < 2; ++n) acc[a][b][m][n] = (f32x4){0.f, 0.f, 0.f, 0.f};
        cur = nxt; cA = nA; cB = nB; ++ui;
        if constexpr (ALIGN_EPI) { if (wr == 1) PG8_BAR; }
    }
    PG8_WAIT_V(0);
    if constexpr (!ALIGN_EPI) { if (wr == 0) PG8_BAR; }
    PG8_BAR;
    if constexpr (Epi::AFTER_DRAIN) { E.fused(acc, cur, wr, wc, fr, fq, lds, wid, lane); S.done(cur); }
#undef PG8_SA
#undef PG8_SB
#undef PG8_STAGE
#undef PG8_LDA
#undef PG8_LDB
#undef PG8_MMA
#undef PG8_WAIT_V
#undef PG8_WAIT_L
#undef PG8_BAR
#undef PG8_SCHED
}
}
#define LAS __attribute__((address_space(3)))
#define XB_TMO      128
#define XB_XCNT(j)  (256  + 64 * (j))
#define XB_XSUB(j)  (1280 + 64 * (j))
#define XB_XGEN(j)  (2304 + 64 * (j))
#define XB_TOP      3328
#define XB_TOPGEN   3392
#define XCD_BAR_WORDS 3456
#define XB_SPIN_CAP (1u << 18)

__device__ __forceinline__ unsigned xb_ld(unsigned* p)              { return __hip_atomic_load(p, __ATOMIC_RELAXED, __HIP_MEMORY_SCOPE_AGENT); }
__device__ __forceinline__ unsigned xb_add(unsigned* p, unsigned v) { return __hip_atomic_fetch_add(p, v, __ATOMIC_RELAXED, __HIP_MEMORY_SCOPE_AGENT); }
__device__ __forceinline__ unsigned xb_xcc_id() { return (unsigned)__builtin_amdgcn_s_getreg((3 << 11) | 20) & 0xFu; }
#define XB_SPIN(cond, bar) do { unsigned _sp = 0; while (cond) { __builtin_amdgcn_s_sleep(1); \
    if ((++_sp & 255u) == 0u) { if (xb_ld(&(bar)[XB_TMO])) break; if (_sp > XB_SPIN_CAP) { atomicAdd(&(bar)[XB_TMO], 1u); break; } } } } while (0)

struct XcdBarrier {
    unsigned* bar; unsigned x;
    volatile LAS unsigned* st;
};

__device__ __forceinline__ XcdBarrier xcd_barrier_post(unsigned* bar, volatile LAS unsigned* st) {
    XcdBarrier b; b.bar = bar; b.x = xb_xcc_id(); b.st = st;
    if (threadIdx.x == 0) (void)xb_add(&bar[XB_XCNT(b.x)], 1u);
    return b;
}
__device__ __forceinline__ void xcd_barrier_complete(unsigned* bar, unsigned x, unsigned& nloc, unsigned& nx) {
    const unsigned G = gridDim.x * gridDim.y * gridDim.z;
    unsigned sum, cnt, mine, sp = 0u;
    for (;;) {
        sum = 0u; cnt = 0u; mine = 0u;
#pragma unroll
        for (unsigned j = 0; j < 16; ++j) { const unsigned c = xb_ld(&bar[XB_XCNT(j)]); sum += c; cnt += (c > 0u) ? 1u : 0u; mine = (j == x) ? c : mine; }
        if (sum == G) break;
        __builtin_amdgcn_s_sleep(1);
        if ((++sp & 255u) == 0u) { if (xb_ld(&bar[XB_TMO])) break; if (sp > XB_SPIN_CAP) { atomicAdd(&bar[XB_TMO], 1u); break; } }
    }
    nloc = mine > 0u ? mine : 1u; nx = cnt > 0u ? cnt : 1u;
}

__device__ __forceinline__ void xcd_barrier(const XcdBarrier& b) {
    asm volatile("s_waitcnt vmcnt(0)" ::: "memory");
    __syncthreads();
    if (threadIdx.x == 0) {
        unsigned* bar = b.bar;
        __builtin_amdgcn_s_waitcnt(0);
        unsigned nloc = b.st[0], nx = b.st[1];
        if (nloc == 0u) { xcd_barrier_complete(bar, b.x, nloc, nx); b.st[0] = nloc; b.st[1] = nx; }
        const unsigned old = xb_add(&bar[XB_XSUB(b.x)], 1u);
        const unsigned gen = old / nloc;
        if (old + 1u == (gen + 1u) * nloc) {
            __builtin_amdgcn_fence(__ATOMIC_RELEASE, "agent");
            asm volatile("s_waitcnt vmcnt(0)" ::: "memory");
            const unsigned og = xb_add(&bar[XB_TOP], 1u);
            const unsigned tg = og / nx;
            if (og + 1u == (tg + 1u) * nx) xb_add(&bar[XB_TOPGEN], 1u);
            else XB_SPIN(xb_ld(&bar[XB_TOPGEN]) == tg, bar);
            __builtin_amdgcn_fence(__ATOMIC_ACQUIRE, "agent");
            xb_add(&bar[XB_XGEN(b.x)], 1u);
            asm volatile("s_waitcnt vmcnt(0)" ::: "memory");
        } else {
            XB_SPIN(xb_ld(&bar[XB_XGEN(b.x)]) == gen, bar);
            __builtin_amdgcn_fence(__ATOMIC_ACQUIRE, "agent");
            asm volatile("s_waitcnt vmcnt(0)" ::: "memory");
        }
    }
    __syncthreads();
}

constexpr int BATCH = 16, T = 4096, D = 1024, M = BATCH * T, NPROJ = 3584, NPROJ_SRC = 3544, FF = 4096, NCH = T / 64;
constexpr float EPS = 1e-6f;
constexpr float LOG2E = 1.44269504089f, INV2PI = 0.15915494309189535f;
constexpr float LOG2_5E5 = 18.931568569324174f, LOG2_1E4 = 13.287712379549449f;
constexpr int COL_AQ = 0, COL_AK = 256, COL_AV = 320, COL_AKI = 384, COL_CA = 448, COL_AWI = 464, COL_AQI = 512,
              COL_BQ = 1024, COL_BK = 1280, COL_BV = 1536, COL_BG = 1792, COL_CQ = 2048, COL_CK = 2176, COL_CV = 2304, COL_CG = 2560,
              COL_DQ = 2816, COL_DK = 3072, COL_DV = 3328;

constexpr size_t MiB = 1u << 20;
constexpr size_t WS_CTL = 0, CTL_ZERO_BYTES = 1 * MiB;
constexpr size_t WS_MOD = 1 * MiB;
constexpr size_t WS_SS = 2 * MiB;
constexpr size_t WS_GC = 6 * MiB;
constexpr size_t WS_W = 8 * MiB, W_LAYER = 25 * MiB, W_IN = 0, W_OUT = 7 * MiB, W_1 = 9 * MiB, W_2 = 17 * MiB;
constexpr size_t WS_H = 64 * MiB;
constexpr size_t WS_MASK = WS_H, WS_SCB = WS_H + 32 * MiB;
constexpr size_t WS_PROJ = 192 * MiB;
constexpr size_t WS_Y = 640 * MiB;
constexpr size_t WS_Y2 = 768 * MiB;
constexpr size_t WS_UB = WS_Y2, WS_RB = WS_Y2 + 64 * MiB, WS_UC = WS_Y2 + 96 * MiB;
constexpr size_t WS_U = WS_PROJ;
constexpr size_t WS_KIP = 896 * MiB;
constexpr size_t WS_X1A = 904 * MiB, WS_X1B = 704 * MiB;
constexpr size_t WS_END = 968 * MiB;
constexpr int CW_TMO = 0, CW_BAR = 4096;

constexpr int SCRATCH_BYTES = 147456;
constexpr int LDSCTL_OFF = SCRATCH_BYTES, LDS_BYTES = SCRATCH_BYTES + 1024;
constexpr int NWAVES = 8, NTHREADS = 512;
constexpr int NPHASES = 20;

__host__ __device__ __forceinline__ size_t PX(size_t tok, int col) { return ((tok >> 6) * (NPROJ / 64) + (size_t)(col >> 6)) * 4096 + ((size_t)((col & 63) >> 3) * 64 + (tok & 63)) * 8 + (size_t)(col & 7); }
constexpr int PXC = 512;
constexpr size_t PX_TILE_STRIDE = (size_t)(NPROJ / 64) * 4096;
#define GAS __attribute__((address_space(1)))
#define LAS __attribute__((address_space(3)))
typedef unsigned short bf16;
typedef short bf16x8 __attribute__((ext_vector_type(8)));
typedef short s16x4 __attribute__((ext_vector_type(4)));
typedef float f32x4 __attribute__((ext_vector_type(4)));
typedef float f32x16 __attribute__((ext_vector_type(16)));
typedef unsigned u32x4 __attribute__((ext_vector_type(4)));
typedef unsigned u32x2 __attribute__((ext_vector_type(2)));
typedef float f32x2_t __attribute__((ext_vector_type(2)));
typedef __bf16 bf16x2_t __attribute__((ext_vector_type(2)));
typedef unsigned long long u64;

__device__ __forceinline__ unsigned cvtpk(float lo, float hi) { f32x2_t v = {lo, hi}; bf16x2_t b = __builtin_convertvector(v, bf16x2_t); return __builtin_bit_cast(unsigned, b); }
__device__ __forceinline__ bf16 f2bf(float f) { return (bf16)(cvtpk(f, 0.f) & 0xffffu); }
__device__ __forceinline__ float bf2f(short b) { return __uint_as_float(((unsigned)(unsigned short)b) << 16); }
__device__ __forceinline__ float bflo(unsigned w) { return __uint_as_float(w << 16); }
__device__ __forceinline__ float bfhi(unsigned w) { return __uint_as_float(w & 0xffff0000u); }
__device__ __forceinline__ bf16x8 ldg16(const bf16* p) { return *(const bf16x8*)p; }
__device__ __forceinline__ f32x16 mfma32(bf16x8 a, bf16x8 b, f32x16 c) { return __builtin_amdgcn_mfma_f32_32x32x16_bf16(a, b, c, 0, 0, 0); }
__device__ __forceinline__ int crow(int reg, int hh) { return (reg & 3) + 8 * (reg >> 2) + 4 * hh; }
__device__ __forceinline__ f32x16 zero16() { f32x16 z;
#pragma unroll
    for (int i = 0; i < 16; ++i) z[i] = 0.f; return z; }
#define LDS_FENCE() asm volatile("s_waitcnt lgkmcnt(0)" ::: "memory")
template <int S> __device__ __forceinline__ bf16x8 pack8(const f32x16& x) {
    u32x4 p; p.x = cvtpk(x[8 * S + 0], x[8 * S + 1]); p.y = cvtpk(x[8 * S + 2], x[8 * S + 3]); p.z = cvtpk(x[8 * S + 4], x[8 * S + 5]); p.w = cvtpk(x[8 * S + 6], x[8 * S + 7]);
    return __builtin_bit_cast(bf16x8, p);
}
typedef short v4i16_t __attribute__((ext_vector_type(4)));
__device__ __forceinline__ s16x4 vtr(const LAS unsigned char* p) { return __builtin_bit_cast(s16x4, __builtin_amdgcn_ds_read_tr16_b64_v4i16((LAS v4i16_t*)p)); }
__device__ __forceinline__ const LAS unsigned char* tr_base_perm(const LAS unsigned char* img, int lane) { return img + (4 * (lane >> 5) + ((lane & 15) >> 2)) * 64 + (16 * ((lane >> 4) & 1) + 4 * (lane & 3)) * 2; }
__device__ __forceinline__ const LAS unsigned char* tr_base_nat(const LAS unsigned char* img, int lane) { return img + (8 * (lane >> 5) + ((lane & 15) >> 2)) * 64 + (16 * ((lane >> 4) & 1) + 4 * (lane & 3)) * 2; }
template <int HALF, int K0> __device__ __forceinline__ bf16x8 ld_tr_perm(const LAS unsigned char* pb) {
    const s16x4 lo = vtr(pb + (HALF * 4096 + K0 * 64)), hi = vtr(pb + (HALF * 4096 + (K0 + 8) * 64));
    return __builtin_shufflevector(lo, hi, 0, 1, 2, 3, 4, 5, 6, 7);
}
template <int HALF, int K0> __device__ __forceinline__ bf16x8 ld_tr_nat(const LAS unsigned char* nb) {
    const s16x4 lo = vtr(nb + (HALF * 4096 + K0 * 64)), hi = vtr(nb + (HALF * 4096 + (K0 + 4) * 64));
    return __builtin_shufflevector(lo, hi, 0, 1, 2, 3, 4, 5, 6, 7);
}
template <int XM> __device__ __forceinline__ float swz_xor(float v) { return __int_as_float(__builtin_amdgcn_ds_swizzle(__float_as_int(v), (XM << 10) | 0x1f)); }
__device__ __forceinline__ float half_sum(float v) { const auto rr = __builtin_amdgcn_permlane32_swap(__float_as_uint(v), __float_as_uint(v), false, false); return __uint_as_float(rr[0]) + __uint_as_float(rr[1]); }
__device__ __forceinline__ float half_max(float v) { const auto rr = __builtin_amdgcn_permlane32_swap(__float_as_uint(v), __float_as_uint(v), false, false); return fmaxf(__uint_as_float(rr[0]), __uint_as_float(rr[1])); }
__device__ __forceinline__ int wave_sum_i(int v) {
    v += __builtin_amdgcn_update_dpp(0, v, 0xB1, 0xF, 0xF, true);
    v += __builtin_amdgcn_update_dpp(0, v, 0x4E, 0xF, 0xF, true);
    v += __builtin_amdgcn_update_dpp(0, v, 0x141, 0xF, 0xF, true);
    v += __builtin_amdgcn_update_dpp(0, v, 0x140, 0xF, 0xF, true);
    return __builtin_amdgcn_readlane(v, 0) + __builtin_amdgcn_readlane(v, 16) + __builtin_amdgcn_readlane(v, 32) + __builtin_amdgcn_readlane(v, 48);
}
__device__ __forceinline__ float wave_sum(float v) {
    v += swz_xor<1>(v); v += swz_xor<2>(v); v += swz_xor<4>(v); v += swz_xor<8>(v); v += swz_xor<16>(v);
    return half_sum(v);
}

struct EpiProj {
    static constexpr bool PERM = true, AFTER_DRAIN = false;
    bf16* O; const int* pos; bf16* KIP;
    __device__ __forceinline__ void operator()(const pg8::f32x4 (&acc)[2][2][4][2], const pg8::Unit& u, int wr, int wc, int fr, int fq) const {
        const int pn = u.pn;
        int mode = 0; float sc0 = 1.f, sc1 = 1.f; bool act = false;
        if (pn == 0) { mode = 1; sc0 = sc1 = 0.125f * LOG2E; act = true; }
        else if (pn == 1) { mode = 1; act = (wc < 2); if (wc == 2 && fq == 2) sc1 = 0.04419417382415922f; }
        else if (pn == 2 || pn == 3) { mode = 1; act = true; }
        else if (pn == 4) { mode = 2; sc0 = sc1 = 0.125f; act = true; }
        else if (pn == 5) { mode = 2; act = true; }
        else if (pn == 8) { sc0 = 0.17677669529663687f; }
        else if (pn == 11) { mode = 3; sc0 = sc1 = 0.17677669529663687f * LOG2E; act = true; }
        else if (pn == 12) { mode = 3; act = true; }
        float inv[2][2]; bool lane_act = false;
#pragma unroll
        for (int n = 0; n < 2; ++n)
#pragma unroll
            for (int p = 0; p < 2; ++p) {
                float e = 0.f;
                if (mode == 1) e = -(float)(4 * fq + 2 * n + p) * (LOG2_5E5 / 8.f);
                else if (mode == 2) e = -(float)(16 * (wc & 1) + 4 * fq + 2 * n + p) * (LOG2_1E4 / 32.f);
                else if (mode == 3) e = -(float)(2 * n + p) * (LOG2_5E5 / 4.f);
                inv[n][p] = exp2f(e);
            }
        if (mode == 1) lane_act = act && ((wc & 1) == 0) && (fq < 2);
        else if (mode == 2) lane_act = act;
        else if (mode == 3) lane_act = act && (fq == 0);
        const int row0 = u.pm * 256 + wr * 64 + fr;
        const int col0 = pn * 256 + wc * 32 + 8 * fq;
#pragma unroll
        for (int ai = 0; ai < 2; ++ai)
#pragma unroll
            for (int m = 0; m < 4; ++m) {
                const int row = row0 + ai * 128 + m * 16;
                float cs[2][2], sn[2][2];
                if (lane_act) {
                    const float pf = (float)pos[row];
#pragma unroll
                    for (int n = 0; n < 2; ++n)
#pragma unroll
                        for (int p = 0; p < 2; ++p) {
                            const float ang = pf * inv[n][p];
                            const float rv = __builtin_fmaf(ang, INV2PI, -__builtin_rintf(ang * INV2PI));
                            sn[n][p] = __builtin_amdgcn_sinf(rv); cs[n][p] = __builtin_amdgcn_cosf(rv);
                        }
                } else {
#pragma unroll
                    for (int n = 0; n < 2; ++n)
#pragma unroll
                        for (int p = 0; p < 2; ++p) { sn[n][p] = 0.f; cs[n][p] = 1.f; }
                }

#pragma unroll
                for (int bj = 0; bj < 2; ++bj) {
                    const float sc = bj ? sc1 : sc0;
                    pg8::f32x4 v0 = acc[ai][bj][m][0], v1 = acc[ai][bj][m][1];
                    float o[8];
                    o[0] = v0[0] * cs[0][0] - v0[1] * sn[0][0]; o[1] = v0[0] * sn[0][0] + v0[1] * cs[0][0];
                    o[2] = v0[2] * cs[0][1] - v0[3] * sn[0][1]; o[3] = v0[2] * sn[0][1] + v0[3] * cs[0][1];
                    o[4] = v1[0] * cs[1][0] - v1[1] * sn[1][0]; o[5] = v1[0] * sn[1][0] + v1[1] * cs[1][0];
                    o[6] = v1[2] * cs[1][1] - v1[3] * sn[1][1]; o[7] = v1[2] * sn[1][1] + v1[3] * cs[1][1];
                    u32x4 w; w.x = cvtpk(o[0] * sc, o[1] * sc); w.y = cvtpk(o[2] * sc, o[3] * sc); w.z = cvtpk(o[4] * sc, o[5] * sc); w.w = cvtpk(o[6] * sc, o[7] * sc);
                    *(u32x4*)(O + PX((size_t)row, col0 + bj * 128)) = w;
                    if (bj == 1 && pn == 1 && wc < 2)
                        *(u32x4*)(KIP + (size_t)(row >> 5) * 2048 + ((4 * wc + fq) * 32 + (row & 31)) * 8) = w;
                }
                asm volatile("" ::: "memory");
            }
    }
};
struct EpiY2 {
    static constexpr bool PERM = true, AFTER_DRAIN = false;
    bf16* O; float* SS; float osc;
    __device__ __forceinline__ void operator()(const pg8::f32x4 (&acc)[2][2][4][2], const pg8::Unit& u, int wr, int wc, int fr, int fq) const {
        const int row0 = u.pm * 256 + wr * 64 + fr, col0 = u.pn * 256 + wc * 32 + 8 * fq;
#pragma unroll
        for (int ai = 0; ai < 2; ++ai)
#pragma unroll
            for (int m = 0; m < 4; ++m) {
                const int row = row0 + ai * 128 + m * 16; float ss = 0.f;
                bf16* rowp = O + (size_t)row * D + col0;
#pragma unroll
                for (int bj = 0; bj < 2; ++bj) {
                    const pg8::f32x4 v0 = acc[ai][bj][m][0] * osc, v1 = acc[ai][bj][m][1] * osc;
                    ss += (v0[0] * v0[0] + v0[1] * v0[1]) + (v0[2] * v0[2] + v0[3] * v0[3]) + (v1[0] * v1[0] + v1[1] * v1[1]) + (v1[2] * v1[2] + v1[3] * v1[3]);
                    u32x4 w; w.x = cvtpk(v0[0], v0[1]); w.y = cvtpk(v0[2], v0[3]); w.z = cvtpk(v1[0], v1[1]); w.w = cvtpk(v1[2], v1[3]);
                    *(u32x4*)(rowp + bj * 128) = w;
                }
                ss += swz_xor<16>(ss); ss = half_sum(ss);
                if (fq == 0) SS[(size_t)row * 16 + u.pn * 4 + wc] = ss;
            }
    }
};
constexpr float U_SCALE = 4.f, W2_SCALE = 256.f;
__device__ __forceinline__ unsigned pk4_fp8(float a, float b, float c, float d) {
    int w = __builtin_amdgcn_cvt_pk_fp8_f32(a, b, 0, false); w = __builtin_amdgcn_cvt_pk_fp8_f32(c, d, w, true); return (unsigned)w;
}
struct EpiRelu2F8 {
    static constexpr bool PERM = true, AFTER_DRAIN = false;
    unsigned char* O;
    __device__ __forceinline__ void operator()(const pg8::f32x4 (&acc)[2][2][4][2], const pg8::Unit& u, int wr, int wc, int fr, int fq) const {
        const int row0 = u.pm * 256 + wr * 64 + fr, col0 = u.pn * 256 + wc * 32 + 8 * fq;
#pragma unroll
        for (int ai = 0; ai < 2; ++ai)
#pragma unroll
            for (int m = 0; m < 4; ++m) {
                unsigned char* rowp = O + (size_t)(row0 + ai * 128 + m * 16) * FF + col0;
#pragma unroll
                for (int bj = 0; bj < 2; ++bj) {
                    pg8::f32x4 v0 = acc[ai][bj][m][0], v1 = acc[ai][bj][m][1];
#pragma unroll
                    for (int j = 0; j < 4; ++j) { const float a = fmaxf(v0[j], 0.f), b = fmaxf(v1[j], 0.f); v0[j] = fminf(a * a * U_SCALE, 448.f); v1[j] = fminf(b * b * U_SCALE, 448.f); }
                    u32x2 w; w.x = pk4_fp8(v0[0], v0[1], v0[2], v0[3]); w.y = pk4_fp8(v1[0], v1[1], v1[2], v1[3]);
                    *(u32x2*)(rowp + bj * 128) = w;
                }
            }
    }
};
struct EpiRelu2 {
    static constexpr bool PERM = true, AFTER_DRAIN = false;
    bf16* O;
    __device__ __forceinline__ void operator()(const pg8::f32x4 (&acc)[2][2][4][2], const pg8::Unit& u, int wr, int wc, int fr, int fq) const {
        const int row0 = u.pm * 256 + wr * 64 + fr, col0 = u.pn * 256 + wc * 32 + 8 * fq;
#pragma unroll
        for (int ai = 0; ai < 2; ++ai)
#pragma unroll
            for (int m = 0; m < 4; ++m) {
                bf16* rowp = O + (size_t)(row0 + ai * 128 + m * 16) * FF + col0;
#pragma unroll
                for (int bj = 0; bj < 2; ++bj) {
                    pg8::f32x4 v0 = acc[ai][bj][m][0], v1 = acc[ai][bj][m][1];
#pragma unroll
                    for (int j = 0; j < 4; ++j) { const float a = fmaxf(v0[j], 0.f), b = fmaxf(v1[j], 0.f); v0[j] = a * a; v1[j] = b * b; }
                    u32x4 w; w.x = cvtpk(v0[0], v0[1]); w.y = cvtpk(v0[2], v0[3]); w.z = cvtpk(v1[0], v1[1]); w.w = cvtpk(v1[2], v1[3]);
                    *(u32x4*)(rowp + bj * 128) = w;
                }
            }
    }
};

__device__ __forceinline__ int map_rope(int j, int R) { return (j < R) ? ((j >> 1) + (j & 1) * (R >> 1)) : j; }
__device__ __forceinline__ int win_src(int n) {
    if (n < 256) return (n >> 6) * 64 + map_rope(n & 63, 16);
    if (n < 320) return 256 + map_rope(n - 256, 16);
    if (n < 384) return 320 + (n - 320);
    if (n < 448) return 896 + map_rope(n - 384, 16);
    if (n < 464) return 2504 + (n - 448);
    if (n < 472) return 960 + (n - 464);
    if (n < 512) return -1;
    if (n < 1024) { const int m = n - 512; return 384 + (m >> 6) * 64 + map_rope(m & 63, 16); }
    if (n < 1280) { const int m = n - 1024; return 968 + (m >> 6) * 64 + map_rope(m & 63, 64); }
    if (n < 1536) { const int m = n - 1280; return 1224 + (m >> 6) * 64 + map_rope(m & 63, 64); }
    if (n < 1792) return 1480 + (n - 1536);
    if (n < 2048) return 1736 + (n - 1792);
    if (n < 2176) return 1992 + (n - 2048);
    if (n < 2304) return 2120 + (n - 2176);
    if (n < 2560) return 2248 + (n - 2304);
    if (n < 2816) return 2520 + (n - 2560);
    if (n < 3072) { const int m = n - 2816; return 2776 + (m >> 5) * 32 + map_rope(m & 31, 8); }
    if (n < 3328) { const int m = n - 3072; return 3032 + (m >> 5) * 32 + map_rope(m & 31, 8); }
    return 3288 + (n - 3328);
}
template <bool PERMUTE>
__device__ __forceinline__ void transpose_item(const float* W, int K, int Nsrc, int Nout, bf16* WT, LAS float* scr, int item, int lane) {
    const int nblk = Nout / 32, kb = item / nblk, nb = item % nblk, k0 = 64 * kb, n0 = 32 * nb;
    const int nn = n0 + (lane & 31); const int src = PERMUTE ? win_src(nn) : nn;
#pragma unroll 8
    for (int i = 0; i < 32; ++i) { const int kk = 2 * i + (lane >> 5); scr[kk * 33 + (lane & 31)] = (src >= 0) ? W[(size_t)(k0 + kk) * Nsrc + src] : 0.f; }
    LDS_FENCE();
    const int c = lane & 7;
#pragma unroll
    for (int j = 0; j < 4; ++j) { const int n = (lane >> 3) + 8 * j; const LAS float* s = scr + (8 * c) * 33 + n;
        u32x4 o; o.x = cvtpk(s[0 * 33], s[1 * 33]); o.y = cvtpk(s[2 * 33], s[3 * 33]); o.z = cvtpk(s[4 * 33], s[5 * 33]); o.w = cvtpk(s[6 * 33], s[7 * 33]);
        *(u32x4*)(WT + (size_t)(n0 + n) * K + k0 + 8 * c) = o; }
    LDS_FENCE();
}

__device__ __forceinline__ void transpose_item_f8(const float* W, int K, int N, unsigned char* WT, LAS float* scr, int item, int lane) {
    const int nblk = N / 32, kb = item / nblk, nb = item % nblk, k0 = 64 * kb, n0 = 32 * nb;
#pragma unroll 8
    for (int i = 0; i < 32; ++i) { const int kk = 2 * i + (lane >> 5); scr[kk * 33 + (lane & 31)] = W[(size_t)(k0 + kk) * N + n0 + (lane & 31)]; }
    LDS_FENCE();
    const int c = lane & 7;
#pragma unroll
    for (int j = 0; j < 4; ++j) { const int n = (lane >> 3) + 8 * j; const LAS float* s = scr + (8 * c) * 33 + n;
        float v[8];
#pragma unroll
        for (int e = 0; e < 8; ++e) v[e] = fminf(fmaxf(s[e * 33] * W2_SCALE, -448.f), 448.f);
        u32x2 o; o.x = pk4_fp8(v[0], v[1], v[2], v[3]); o.y = pk4_fp8(v[4], v[5], v[6], v[7]);
        *(u32x2*)(WT + (size_t)(n0 + n) * K + k0 + 8 * c) = o; }
    LDS_FENCE();
}

#ifndef ROWS_IN_FLIGHT
#define ROWS_IN_FLIGHT 2
#endif
__device__ __forceinline__ size_t x1_off(int m) { return (size_t)(m & (M / 2 - 1)) * D; }
template <bool HAS_RES, bool DO_H, bool XIN_BF, bool XOUT_BF>
__device__ __forceinline__ void rowpass(const float* xin, float* xout, bf16* xa, bf16* xb, const bf16* y2, const float* ss, const float* gpost, const float* gate,
                                        const float* gpre, const float* scale, const float* shift, bf16* hout, int gw, int ngw, int lane) {
    constexpr int NR = ROWS_IN_FLIGHT;
    const int wpb = ngw / BATCH;
    if (wpb * BATCH != ngw || wpb == 0) return;
    const int b = gw / wpb, j0 = gw - b * wpb;
    f32x4 gpo[4], gat[4], gpr[4], scl[4], shf[4];
#pragma unroll
    for (int j = 0; j < 4; ++j) {
        const int c = 4 * lane + 256 * j;
        if (HAS_RES) { gpo[j] = *(const f32x4*)(gpost + c); gat[j] = *(const f32x4*)(gate + (size_t)b * 6144 + c); }
        if (DO_H) { gpr[j] = *(const f32x4*)(gpre + c); scl[j] = *(const f32x4*)(scale + (size_t)b * 6144 + c) + 1.0f; shf[j] = *(const f32x4*)(shift + (size_t)b * 6144 + c); }
    }
    for (int r0 = j0; r0 < T; r0 += NR * wpb) {
        int mm[NR]; bool live[NR];
#pragma unroll
        for (int u = 0; u < NR; ++u) { live[u] = (u == 0) || (r0 + u * wpb < T); mm[u] = b * T + (live[u] ? r0 + u * wpb : r0); }
        f32x4 v[NR][4]; float rstd[NR];
#pragma unroll
        for (int u = 0; u < NR; ++u)
#pragma unroll
            for (int j = 0; j < 4; ++j) {
                if (XIN_BF) { const u32x2 t = *(const u32x2*)((mm[u] < M / 2 ? xa : xb) + x1_off(mm[u]) + 4 * lane + 256 * j); v[u][j] = (f32x4){bflo(t.x), bfhi(t.x), bflo(t.y), bfhi(t.y)}; }
                else v[u][j] = *(const f32x4*)(xin + (size_t)mm[u] * D + 4 * lane + 256 * j);
            }
        if (HAS_RES) {
            u32x2 yy[NR][4];
#pragma unroll
            for (int u = 0; u < NR; ++u) {
                const float* sp = ss + (size_t)mm[u] * 16;
                const f32x4 s0 = *(const f32x4*)(sp), s1 = *(const f32x4*)(sp + 4), s2 = *(const f32x4*)(sp + 8), s3 = *(const f32x4*)(sp + 12);
                const float s = ((s0[0] + s0[1]) + (s0[2] + s0[3])) + ((s1[0] + s1[1]) + (s1[2] + s1[3])) + ((s2[0] + s2[1]) + (s2[2] + s2[3])) + ((s3[0] + s3[1]) + (s3[2] + s3[3]));
                rstd[u] = 1.0f / sqrtf(s * (1.f / D) + EPS);
#pragma unroll
                for (int j = 0; j < 4; ++j) yy[u][j] = *(const u32x2*)(y2 + (size_t)mm[u] * D + 4 * lane + 256 * j);
            }
#pragma unroll
            for (int u = 0; u < NR; ++u)
#pragma unroll
                for (int j = 0; j < 4; ++j) {
                    const int c = 4 * lane + 256 * j;
                    const f32x4 yv = {bflo(yy[u][j].x), bfhi(yy[u][j].x), bflo(yy[u][j].y), bfhi(yy[u][j].y)};
                    v[u][j] = v[u][j] + gat[j] * (yv * rstd[u] * gpo[j]);
                    if (live[u]) {
                        if (XOUT_BF) { u32x2 w; w.x = cvtpk(v[u][j][0], v[u][j][1]); w.y = cvtpk(v[u][j][2], v[u][j][3]); *(u32x2*)((mm[u] < M / 2 ? xa : xb) + x1_off(mm[u]) + c) = w; }
                        else *(f32x4*)(xout + (size_t)mm[u] * D + c) = v[u][j];
                    }
                }
        }
        if (DO_H) {
            float q[NR];
#pragma unroll
            for (int u = 0; u < NR; ++u) { q[u] = 0.f;
#pragma unroll
                for (int j = 0; j < 4; ++j) q[u] += (v[u][j][0] * v[u][j][0] + v[u][j][1] * v[u][j][1]) + (v[u][j][2] * v[u][j][2] + v[u][j][3] * v[u][j][3]); }
#pragma unroll
            for (int u = 0; u < NR; ++u) q[u] = wave_sum(q[u]);
#pragma unroll
            for (int u = 0; u < NR; ++u) {
                const float rstd2 = 1.0f / sqrtf(q[u] * (1.f / D) + EPS);
#pragma unroll
                for (int j = 0; j < 4; ++j) {
                    const int c = 4 * lane + 256 * j;
                    const f32x4 h = (v[u][j] * rstd2 * gpr[j]) * scl[j] + shf[j];
                    u32x2 w; w.x = cvtpk(h[0], h[1]); w.y = cvtpk(h[2], h[3]);
                    if (live[u]) *(u32x2*)(hout + (size_t)mm[u] * D + c) = w;
                }
            }
        }
    }
}

__device__ __forceinline__ void store_pair16(const u32x2 a, const u32x2 b, bf16* p) {
    const auto r0 = __builtin_amdgcn_permlane32_swap(a.x, b.x, false, false), r1 = __builtin_amdgcn_permlane32_swap(a.y, b.y, false, false);
    u32x4 o; o.x = r0[0]; o.y = r1[0]; o.z = r0[1]; o.w = r1[1];
    *(u32x4*)p = o;
}
__device__ __forceinline__ void load_rows16(const bf16* p, int hh, u32x4 (&raw)[4]) {
#pragma unroll
    for (int me = 0; me < 2; ++me)
#pragma unroll
        for (int gp = 0; gp < 4; gp += 2) raw[me * 2 + (gp >> 1)] = *(const u32x4*)(p + (4 * me + gp + hh) * PXC);
}
__device__ __forceinline__ void unpack_pair16(const u32x4 raw, u32x2& ga, u32x2& gb) {
    const auto r0 = __builtin_amdgcn_permlane32_swap(raw.x, raw.z, false, false), r1 = __builtin_amdgcn_permlane32_swap(raw.y, raw.w, false, false);
    ga.x = r0[0]; ga.y = r1[0]; gb.x = r0[1]; gb.y = r1[1];
}
__device__ __forceinline__ void load_gains(const float* gptr, int hh, f32x4 (&gain)[8]) {
#pragma unroll
    for (int me = 0; me < 2; ++me)
#pragma unroll
        for (int g = 0; g < 4; ++g) gain[me * 4 + g] = *(const f32x4*)(gptr + 32 * me + 8 * g + 4 * hh);
}
template <bool GATE, bool FASTSILU>
__device__ __forceinline__ void headnorm_pair(const f32x16& resme, int me, int gp, int hh, float rstd, const f32x4 (&gain)[8], const u32x4 graw, bf16* outp) {
    u32x2 ga, gb, w[2];
    if (GATE) unpack_pair16(graw, ga, gb);
#pragma unroll
    for (int k = 0; k < 2; ++k) {
        const int g = gp + k;
        const f32x4 gv = gain[me * 4 + g];
        float o[4];
#pragma unroll
        for (int j = 0; j < 4; ++j) o[j] = resme[4 * g + j] * rstd * gv[j];
        if (GATE) {
            const u32x2 gg = k ? gb : ga;
            const float z[4] = {bflo(gg.x), bfhi(gg.x), bflo(gg.y), bfhi(gg.y)};
#pragma unroll
            for (int j = 0; j < 4; ++j) o[j] *= FASTSILU ? z[j] * __builtin_amdgcn_rcpf(1.f + __builtin_amdgcn_exp2f(-z[j] * LOG2E)) : z[j] / (1.f + __expf(-z[j]));
        }
        w[k].x = cvtpk(o[0], o[1]); w[k].y = cvtpk(o[2], o[3]);
    }
    store_pair16(w[0], w[1], outp + 32 * me + 8 * gp + 8 * hh);
}
template <bool CENTER, bool GATE>
__device__ __forceinline__ void headnorm_store(f32x16 (&res)[2], int hh_in, const float* gptr, const bf16* gateptr, float oscale, bf16* outp) {
    int hh = hh_in; asm volatile("" : "+v"(hh));
    f32x4 gain[8]; load_gains(gptr, hh, gain);
    u32x4 graw[4];
    if (GATE) load_rows16(gateptr, hh, graw);
    if (CENTER) {
        float s = 0.f;
#pragma unroll
        for (int me = 0; me < 2; ++me)
#pragma unroll
            for (int i = 0; i < 16; ++i) s += res[me][i];
        s = half_sum(s);
        const float mean = s * (1.f / 64.f);
#pragma unroll
        for (int me = 0; me < 2; ++me)
#pragma unroll
            for (int i = 0; i < 16; ++i) res[me][i] -= mean;
    }
    float q = 0.f;
#pragma unroll
    for (int me = 0; me < 2; ++me)
#pragma unroll
        for (int i = 0; i < 16; ++i) q += res[me][i] * res[me][i];
    q = half_sum(q);
    const float rstd = oscale / sqrtf(q * (1.f / 64.f) + EPS);
#pragma unroll
    for (int me = 0; me < 2; ++me)
#pragma unroll
        for (int gp = 0; gp < 4; gp += 2) headnorm_pair<GATE, false>(res[me], me, gp, hh, rstd, gain, GATE ? graw[me * 2 + (gp >> 1)] : (u32x4){0u, 0u, 0u, 0u}, outp);
}

#ifndef ATTN_PREFETCH
#define ATTN_PREFETCH 1
#endif
#ifndef ATTN_SB
#define ATTN_SB 0
#endif
template <bool CENTER>
__device__ __forceinline__ void headnorm_store_g(f32x16 (&res)[2], int hh_in, const float* gptr, const u32x4 (&graw)[4], float oscale, bf16* outp) {
    int hh = hh_in; asm volatile("" : "+v"(hh));
    f32x4 gain[8]; load_gains(gptr, hh, gain);
    if (CENTER) {
        float s = 0.f;
#pragma unroll
        for (int me = 0; me < 2; ++me)
#pragma unroll
            for (int i = 0; i < 16; ++i) s += res[me][i];
        s = half_sum(s);
        const float mean = s * (1.f / 64.f);
#pragma unroll
        for (int me = 0; me < 2; ++me)
#pragma unroll
            for (int i = 0; i < 16; ++i) res[me][i] -= mean;
    }
    float q = 0.f;
#pragma unroll
    for (int me = 0; me < 2; ++me)
#pragma unroll
        for (int i = 0; i < 16; ++i) q += res[me][i] * res[me][i];
    q = half_sum(q);
    const float rstd = oscale / sqrtf(q * (1.f / 64.f) + EPS);
#pragma unroll
    for (int me = 0; me < 2; ++me)
#pragma unroll
        for (int gp = 0; gp < 4; gp += 2) headnorm_pair<true, true>(res[me], me, gp, hh, rstd, gain, graw[me * 2 + (gp >> 1)], outp);
}

constexpr int ATTN_BUF = 64 * 144 + 8192;
template <int NC, int DK, bool MASKED>
__device__ __forceinline__ void attn_core(LAS unsigned char* lds, const bf16* kbase, const bf16* vbase, const bf16* qrow, int nt_block, int nt_wave,
                                          const u64* mrow, f32x16 (&o)[NC][2], float (&lsum)[NC], int tid, int lane) {
    static_assert((NC == 2 && !MASKED) || (NC == 1 && MASKED), "two maps unmasked (differential) or one map masked (DSA)");
    constexpr int KST = DK / 16;
    constexpr float THR = 14.f;
    const int r = lane & 31, hh = lane >> 5;
    bf16x8 qf[NC][KST];
#pragma unroll
    for (int cc = 0; cc < NC; ++cc)
#pragma unroll
        for (int s = 0; s < KST; ++s) qf[cc][s] = ldg16(qrow + ((cc * DK + 16 * s) / 8 + hh) * PXC);
    float negm[NC];
#pragma unroll
    for (int cc = 0; cc < NC; ++cc) { negm[cc] = 0.f; lsum[cc] = 0.f; o[cc][0] = zero16(); o[cc][1] = zero16(); }
    const int krow_ = tid >> 3, kch = tid & 7;
    const int ksw = krow_ * 144 + kch * 16, vsw = 64 * 144 + (kch >> 2) * 4096 + krow_ * 64 + (kch & 3) * 16;
    const int kfo = r * 144 + hh * 16;
    const int vto = (int)(tr_base_perm(lds + 64 * 144, lane) - lds);
    const bf16* kp = kbase + (kch * 64 + krow_) * 8; const bf16* vp = vbase + (kch * 64 + krow_) * 8;
    bf16x8 kreg = ldg16(kp), vreg = ldg16(vp);
    *(LAS bf16x8*)(lds + ksw) = kreg; *(LAS bf16x8*)(lds + vsw) = vreg;
    if (nt_block > 1) { kreg = ldg16(kp + PX_TILE_STRIDE); vreg = ldg16(vp + PX_TILE_STRIDE); }
    __syncthreads();
    for (int t = 0; t < nt_block; ++t) {
        LAS unsigned char* const buf = lds + (t & 1) * ATTN_BUF;
        if (t < nt_wave) {
            const LAS unsigned char* const kfb = buf + kfo; const LAS unsigned char* const vtb = buf + vto;
            if constexpr (NC == 2) {
                bf16x8 vf[2][4];
                vf[0][0] = ld_tr_perm<0, 0>(vtb); vf[0][1] = ld_tr_perm<0, 16>(vtb); vf[0][2] = ld_tr_perm<0, 32>(vtb); vf[0][3] = ld_tr_perm<0, 48>(vtb);
                vf[1][0] = ld_tr_perm<1, 0>(vtb); vf[1][1] = ld_tr_perm<1, 16>(vtb); vf[1][2] = ld_tr_perm<1, 32>(vtb); vf[1][3] = ld_tr_perm<1, 48>(vtb);
                f32x16 sa[2][2];
                if (__builtin_amdgcn_ballot_w64(negm[0] != 0.f || negm[1] != 0.f) == 0ull) {
#pragma unroll
                    for (int cc = 0; cc < 2; ++cc)
#pragma unroll
                        for (int kt = 0; kt < 2; ++kt) {
                            sa[cc][kt] = mfma32(*(const LAS bf16x8*)(kfb + (32 * kt * 144 + (cc * DK) * 2)), qf[cc][0], zero16());
#pragma unroll
                            for (int s = 1; s < KST; ++s) sa[cc][kt] = mfma32(*(const LAS bf16x8*)(kfb + (32 * kt * 144 + (cc * DK + 16 * s) * 2)), qf[cc][s], sa[cc][kt]);
                        }
                } else {
#pragma unroll
                    for (int cc = 0; cc < 2; ++cc)
#pragma unroll
                        for (int kt = 0; kt < 2; ++kt) {
                            f32x16 c0;
#pragma unroll
                            for (int i = 0; i < 16; ++i) c0[i] = negm[cc];
                            sa[cc][kt] = mfma32(*(const LAS bf16x8*)(kfb + (32 * kt * 144 + (cc * DK) * 2)), qf[cc][0], c0);
#pragma unroll
                            for (int s = 1; s < KST; ++s) sa[cc][kt] = mfma32(*(const LAS bf16x8*)(kfb + (32 * kt * 144 + (cc * DK + 16 * s) * 2)), qf[cc][s], sa[cc][kt]);
                        }
                }
#pragma unroll
                for (int cc = 0; cc < 2; ++cc) {
                    float tmax = sa[cc][0][0];
#pragma unroll
                    for (int i = 1; i < 16; ++i) tmax = fmaxf(tmax, sa[cc][0][i]);
#pragma unroll
                    for (int i = 0; i < 16; ++i) tmax = fmaxf(tmax, sa[cc][1][i]);
                    if (__builtin_amdgcn_ballot_w64(tmax > THR || (t == 0 && tmax < -24.f)) != 0ull) {
                        const float hm = half_max(tmax);
                        tmax = (hm > THR) ? hm : ((t == 0 && hm < -24.f) ? fmaxf(hm, -64.f) : 0.f);
                        const float alpha = __builtin_amdgcn_exp2f(-tmax);
                        negm[cc] -= tmax; lsum[cc] *= alpha;
#pragma unroll
                        for (int i = 0; i < 16; ++i) { o[cc][0][i] *= alpha; o[cc][1][i] *= alpha; sa[cc][0][i] -= tmax; sa[cc][1][i] -= tmax; }
                    }
                    float ps = 0.f;
#pragma unroll
                    for (int kt = 0; kt < 2; ++kt)
#pragma unroll
                        for (int i = 0; i < 16; ++i) { const float p = __builtin_amdgcn_exp2f(sa[cc][kt][i]); sa[cc][kt][i] = p; ps += p; }
                    lsum[cc] += ps;
                    const bf16x8 p00 = pack8<0>(sa[cc][0]), p01 = pack8<1>(sa[cc][0]), p10 = pack8<0>(sa[cc][1]), p11 = pack8<1>(sa[cc][1]);
                    o[cc][0] = mfma32(vf[0][0], p00, o[cc][0]); o[cc][0] = mfma32(vf[0][1], p01, o[cc][0]);
                    o[cc][0] = mfma32(vf[0][2], p10, o[cc][0]); o[cc][0] = mfma32(vf[0][3], p11, o[cc][0]);
                    o[cc][1] = mfma32(vf[1][0], p00, o[cc][1]); o[cc][1] = mfma32(vf[1][1], p01, o[cc][1]);
                    o[cc][1] = mfma32(vf[1][2], p10, o[cc][1]); o[cc][1] = mfma32(vf[1][3], p11, o[cc][1]);
                }
            } else {
                const u64 mw = mrow[t];
                bf16x8 vf[2][4];
                vf[0][0] = ld_tr_perm<0, 0>(vtb); vf[0][1] = ld_tr_perm<0, 16>(vtb); vf[0][2] = ld_tr_perm<0, 32>(vtb); vf[0][3] = ld_tr_perm<0, 48>(vtb);
                vf[1][0] = ld_tr_perm<1, 0>(vtb); vf[1][1] = ld_tr_perm<1, 16>(vtb); vf[1][2] = ld_tr_perm<1, 32>(vtb); vf[1][3] = ld_tr_perm<1, 48>(vtb);
                f32x16 sa[2];
#pragma unroll
                for (int kt = 0; kt < 2; ++kt) {
                    const unsigned m32 = (unsigned)(mw >> (32 * kt + 4 * hh));
#pragma unroll
                    for (int i = 0; i < 16; ++i) {
                        const int sel = __builtin_amdgcn_sbfe((int)m32, (i & 3) + 8 * (i >> 2), 1);
                        sa[kt][i] = __int_as_float((sel & __float_as_int(negm[0])) | (~sel & (int)0xF149F2CAu));
                    }
#pragma unroll
                    for (int s = 0; s < KST; ++s) sa[kt] = mfma32(*(const LAS bf16x8*)(kfb + (32 * kt * 144 + (16 * s) * 2)), qf[0][s], sa[kt]);
                }
#pragma unroll
                for (int kt = 0; kt < 2; ++kt) {
                    float tmax = sa[kt][0];
#pragma unroll
                    for (int i = 1; i < 16; ++i) tmax = fmaxf(tmax, sa[kt][i]);
                    if ((t == 0 && kt == 0) || __builtin_amdgcn_ballot_w64(tmax > THR) != 0ull) {
                        tmax = fmaxf(half_max(tmax), (t == 0 && kt == 0) ? -64.f : 0.f);
                        const float alpha = __builtin_amdgcn_exp2f(-tmax);
                        negm[0] -= tmax; lsum[0] *= alpha;
#pragma unroll
                        for (int i = 0; i < 16; ++i) { o[0][0][i] *= alpha; o[0][1][i] *= alpha; sa[kt][i] -= tmax; if (kt == 0) sa[1][i] -= tmax; }
                    }
                    float ps = 0.f;
#pragma unroll
                    for (int i = 0; i < 16; ++i) { const float p = __builtin_amdgcn_exp2f(sa[kt][i]); sa[kt][i] = p; ps += p; }
                    lsum[0] += ps;
                    const bf16x8 p0 = pack8<0>(sa[kt]), p1 = pack8<1>(sa[kt]);
                    o[0][0] = mfma32(vf[0][2 * kt], p0, o[0][0]); o[0][0] = mfma32(vf[0][2 * kt + 1], p1, o[0][0]);
                    o[0][1] = mfma32(vf[1][2 * kt], p0, o[0][1]); o[0][1] = mfma32(vf[1][2 * kt + 1], p1, o[0][1]);
                }
            }
        }
        if (t + 1 < nt_block) {
            LAS unsigned char* const nb = lds + ((t + 1) & 1) * ATTN_BUF;
            *(LAS bf16x8*)(nb + ksw) = kreg; *(LAS bf16x8*)(nb + vsw) = vreg;
            if (t + 2 < nt_block) { kreg = ldg16(kp + (size_t)(t + 2) * PX_TILE_STRIDE); vreg = ldg16(vp + (size_t)(t + 2) * PX_TILE_STRIDE); }
        }
        __syncthreads();
    }
}

__device__ __forceinline__ void diff_unit(LAS unsigned char* lds, const bf16* proj, bf16* Y, const float* hng, float lam, float lam_init, int b, int h, int qb, int tid, int lane, int wave) {
    const int q0 = 256 * qb, qtok = q0 + 32 * wave + (lane & 31), hh = lane >> 5;
    const size_t tokrow = (size_t)b * T + qtok;
    f32x16 o[2][2]; float ls[2];
    const int nt_block = (q0 + 256) / 64, nt_wave = ((q0 + 32 * wave) >> 6) + 1;
    attn_core<2, 32, false>(lds, proj + PX((size_t)b * T, COL_DK + h * 64), proj + PX((size_t)b * T, COL_DV + h * 64), proj + PX(tokrow, COL_DQ + h * 64), nt_block, nt_wave, nullptr, o, ls, tid, lane);
    const float l0 = half_sum(ls[0]), l1 = half_sum(ls[1]);
    const float i0 = 1.f / l0, i1 = lam / l1;
    f32x16 res[2];
#pragma unroll
    for (int me = 0; me < 2; ++me)
#pragma unroll
        for (int i = 0; i < 16; ++i) res[me][i] = o[0][me][i] * i0 - o[1][me][i] * i1;
    headnorm_store<false, false>(res, hh, hng + 768 + h * 64, nullptr, 1.f - lam_init, Y + tokrow * D + 768 + h * 64);
}
__device__ __forceinline__ void dsa_unit(LAS unsigned char* lds, const bf16* proj, const u64* mask, bf16* Y, const float* hng, int b, int qc, int tid, int lane, int wave) {
    const int head = wave >> 1, qtok = 64 * qc + 32 * (wave & 1) + (lane & 31), hh = lane >> 5;
    const size_t tokrow = (size_t)b * T + qtok;
    f32x16 o[1][2]; float ls[1];
    attn_core<1, 64, true>(lds, proj + PX((size_t)b * T, COL_AK), proj + PX((size_t)b * T, COL_AV), proj + PX(tokrow, COL_AQ + head * 64), qc + 1, qc + 1, mask + tokrow * 64, o, ls, tid, lane);
    const float l0 = half_sum(ls[0]), i0 = 1.f / l0;
    f32x16 res[2];
#pragma unroll
    for (int me = 0; me < 2; ++me)
#pragma unroll
        for (int i = 0; i < 16; ++i) res[me][i] = o[0][me][i] * i0;
    headnorm_store<false, false>(res, hh, hng + head * 64, nullptr, 1.f, Y + tokrow * D + head * 64);
}
#ifndef REP_IDX_MM
#define REP_IDX_MM 1
#endif
__device__ __forceinline__ void count8(int& acc0, int& acc1, float k0, float k1, float k2, float k3, float k4, float k5, float k6, float k7, float cand) {
    unsigned long long m0, m1, m2, m3, m4, m5, m6, m7, dmy;
    asm volatile(
        "v_cmp_ge_f32_e64 %2, %11, %19\n\t"
        "v_cmp_ge_f32_e64 %3, %12, %19\n\t"
        "v_cmp_ge_f32_e64 %4, %13, %19\n\t"
        "v_cmp_ge_f32_e64 %5, %14, %19\n\t"
        "v_cmp_ge_f32_e64 %6, %15, %19\n\t"
        "v_cmp_ge_f32_e64 %7, %16, %19\n\t"
        "v_cmp_ge_f32_e64 %8, %17, %19\n\t"
        "v_cmp_ge_f32_e64 %9, %18, %19\n\t"
        "v_addc_co_u32_e64 %0, %10, %0, 0, %2\n\t"
        "v_addc_co_u32_e64 %1, %10, %1, 0, %3\n\t"
        "v_addc_co_u32_e64 %0, %10, %0, 0, %4\n\t"
        "v_addc_co_u32_e64 %1, %10, %1, 0, %5\n\t"
        "v_addc_co_u32_e64 %0, %10, %0, 0, %6\n\t"
        "v_addc_co_u32_e64 %1, %10, %1, 0, %7\n\t"
        "v_addc_co_u32_e64 %0, %10, %0, 0, %8\n\t"
        "v_addc_co_u32_e64 %1, %10, %1, 0, %9"
        : "+v"(acc0), "+v"(acc1), "=&s"(m0), "=&s"(m1), "=&s"(m2), "=&s"(m3), "=&s"(m4), "=&s"(m5), "=&s"(m6), "=&s"(m7), "=&s"(dmy)
        : "v"(k0), "v"(k1), "v"(k2), "v"(k3), "v"(k4), "v"(k5), "v"(k6), "v"(k7), "v"(cand));
}
__device__ __forceinline__ float key_to_float(unsigned k) { return __uint_as_float((k & 0x80000000u) ? (k & 0x7fffffffu) : ~k); }
#define DPP_F(v, ctrl) __int_as_float(__builtin_amdgcn_update_dpp(0, __float_as_int(v), (ctrl), 0xF, 0xF, true))
__device__ __forceinline__ float wave_max_f(float v) {
    v = fmaxf(v, DPP_F(v, 0xB1)); v = fmaxf(v, DPP_F(v, 0x4E)); v = fmaxf(v, DPP_F(v, 0x141)); v = fmaxf(v, DPP_F(v, 0x140));
    const float a = __int_as_float(__builtin_amdgcn_readlane(__float_as_int(v), 0)), b = __int_as_float(__builtin_amdgcn_readlane(__float_as_int(v), 16));
    const float c = __int_as_float(__builtin_amdgcn_readlane(__float_as_int(v), 32)), d = __int_as_float(__builtin_amdgcn_readlane(__float_as_int(v), 48));
    return fmaxf(fmaxf(a, b), fmaxf(c, d));
}
__device__ __forceinline__ float wave_min_f(float v) { return -wave_max_f(-v); }
__device__ __forceinline__ unsigned wave_incl_scan(unsigned v) {
    v += (unsigned)__builtin_amdgcn_update_dpp(0, (int)v, 0x111, 0xF, 0xF, false);
    v += (unsigned)__builtin_amdgcn_update_dpp(0, (int)v, 0x112, 0xF, 0xF, false);
    v += (unsigned)__builtin_amdgcn_update_dpp(0, (int)v, 0x114, 0xF, 0xF, false);
    v += (unsigned)__builtin_amdgcn_update_dpp(0, (int)v, 0x118, 0xF, 0xF, false);
    v += (unsigned)__builtin_amdgcn_update_dpp(0, (int)v, 0x142, 0xA, 0xF, false);
    v += (unsigned)__builtin_amdgcn_update_dpp(0, (int)v, 0x143, 0xC, 0xF, false);
    return v;
}
template <int NG>
__device__ __forceinline__ bool topk_hist(const float (&x)[64], LAS unsigned* H, LAS float* LIST, float& tf, bool& found, int lane) {
    float g0 = x[0], g1 = x[1], g2 = x[2], g3 = x[3];
#pragma unroll
    for (int i = 4; i < 8 * NG; i += 4) { g0 = fmaxf(g0, x[i]); g1 = fmaxf(g1, x[i + 1]); g2 = fmaxf(g2, x[i + 2]); g3 = fmaxf(g3, x[i + 3]); }
    const float hi = wave_max_f(fmaxf(fmaxf(g0, g1), fmaxf(g2, g3))), lo = wave_min_f(fminf(fminf(g0, g1), fminf(g2, g3)));
    if (!(hi > lo) || !(lo > -3.0e38f) || !(hi < 3.0e38f)) return false;
    const float s4 = 16124.f / (hi - lo), hs4 = __builtin_fmaf(hi, s4, 0.25f);
    if (!(s4 < 1.0e30f)) return false;
#pragma unroll
    for (int k = 0; k < 16; ++k) *(LAS u32x4*)(H + 4 * (lane + 64 * k)) = (u32x4){0u, 0u, 0u, 0u};
    const float dummy = (float)(16128 + 4 * lane);
    const unsigned hbase = (unsigned)(__UINTPTR_TYPE__)H;
#pragma unroll
    for (int i = 0; i < 8 * NG; ++i) {
        const float t4 = __builtin_fmaf(x[i], -s4, hs4);
        __hip_atomic_fetch_add((LAS unsigned*)(__UINTPTR_TYPE__)(((unsigned)fminf(t4, dummy) & ~3u) | hbase), 1u, __ATOMIC_RELAXED, __HIP_MEMORY_SCOPE_WORKGROUP);
    }
    LDS_FENCE();
    const LAS unsigned* hp = H + 63 * lane;
    unsigned tot = 0u;
#pragma unroll
    for (int jb = 0; jb < 64; jb += 16) {
        unsigned hv[16];
#pragma unroll
        for (int j = 0; j < 16; ++j) hv[j] = (jb + j < 63) ? hp[jb + j] : 0u;
        __builtin_amdgcn_sched_barrier(0);
#pragma unroll
        for (int j = 0; j < 16; j += 2) tot += hv[j] + hv[j + 1];
        __builtin_amdgcn_sched_barrier(0);
    }
    const unsigned P = wave_incl_scan(tot);
    if (__builtin_amdgcn_readlane((int)P, 63) < 256) return false;
    const int Ls = __builtin_ctzll(__builtin_amdgcn_ballot_w64(P >= 256u));
    const unsigned basec = (unsigned)__builtin_amdgcn_readlane((int)(P - tot), Ls);
    const unsigned h = (lane < 63) ? H[63 * Ls + lane] : 0u;
    const unsigned Q = wave_incl_scan(h);
    const int js = __builtin_ctzll(__builtin_amdgcn_ballot_w64(basec + Q >= 256u));
    const int cab = (int)basec + __builtin_amdgcn_readlane((int)(Q - h), js), nB = __builtin_amdgcn_readlane((int)h, js);
    const int B = 63 * Ls + js, need = 256 - cab;
    const float lo4 = 4.f * (float)B;
    int ncand = 0;
#pragma unroll
    for (int g = 0; g < NG; ++g) {
        u64 m[8], any = 0ull;
#pragma unroll
        for (int k = 0; k < 8; ++k) { const float t4 = __builtin_fmaf(x[8 * g + k], -s4, hs4); m[k] = __builtin_amdgcn_ballot_w64(__float_as_uint(t4 - lo4) < 0x40800000u); any |= m[k]; }
        if (any != 0ull) {
#pragma unroll
            for (int k = 0; k < 8; ++k) if (m[k] != 0ull) {
                const int pos = ncand + (int)__builtin_amdgcn_mbcnt_hi((unsigned)(m[k] >> 32), __builtin_amdgcn_mbcnt_lo((unsigned)m[k], 0u));
                if (((m[k] >> lane) & 1ull) && pos < 256) LIST[pos] = x[8 * g + k];
                ncand += __builtin_popcountll(m[k]);
            }
        }
    }
    if (ncand != nB || ncand > 64 || need < 1 || need > ncand) return false;
    LDS_FENCE();
    const float c = (lane < ncand) ? LIST[lane] : -__builtin_inff();
    int G = 0, GE = 0;
    for (int i = 0; i < ncand; ++i) { const float v = LIST[i]; G += (v > c) ? 1 : 0; GE += (v >= c) ? 1 : 0; }
    const u64 ok = __builtin_amdgcn_ballot_w64(lane < ncand && G < need && need <= GE);
    if (ok == 0ull) return false;
    const int j0 = __builtin_ctzll(ok);
    tf = __int_as_float(__builtin_amdgcn_readlane(__float_as_int(c), j0));
    found = (__builtin_amdgcn_readlane(GE, j0) == need);
    return true;
}
template <int NG>
__device__ __forceinline__ void topk_search(const float (&x)[64], LAS unsigned* H, LAS float* LIST, float& tf, bool& found, u64& myword, int lane_o) {
    found = false;
    if (!topk_hist<NG>(x, H, LIST, tf, found, lane_o)) {
    unsigned Tk = 0u; found = false;
    for (int bit = 31; bit >= 0; --bit) {
        const unsigned cand = Tk | (1u << bit);
        const float cf = key_to_float(cand);
        int cl = 0, cl2 = 0;
#pragma unroll
        for (int g = 0; g < NG; ++g) count8(cl, cl2, x[8 * g], x[8 * g + 1], x[8 * g + 2], x[8 * g + 3], x[8 * g + 4], x[8 * g + 5], x[8 * g + 6], x[8 * g + 7], cf);
        const int cnt = wave_sum_i(cl + cl2);
        if (cnt >= 256) { Tk = cand; if (cnt == 256) { found = true; break; } }
    }
    tf = key_to_float(Tk);
    }
    if (found) {
#pragma unroll
        for (int i = 0; i < 8 * NG; ++i) {
            const u64 w = __ballot(x[i] >= tf);
            if (lane_o == i) myword = w;
            if ((i & 3) == 3) __builtin_amdgcn_sched_barrier(0);
        }
    }
}
__device__ __forceinline__ void indexer_unit(LAS unsigned char* lds, const bf16* proj, const bf16* kip, u64* mask, int b, int g8, int lane, int wave) {
    const int q0 = g8 * 8, qc = q0 >> 6, L = 64 * (qc + 1), nr = qc + 1;
    u64* mout = mask + ((size_t)b * T + q0 + wave) * 64;
    if (L <= 256) { u64 ones = ~0ull; asm volatile("" : "+v"(ones)); if (lane < nr) mout[lane] = ones; return; }
    LAS float* SCR = (LAS float*)lds;
    const int r = lane & 31, hh = lane >> 5;
    bf16x8 af[2][4]; float wv[2][2][8];
    {
        const int a_ = r >> 4, b_ = (r >> 3) & 1, c_ = (r >> 2) & 1, d_ = r & 3;
#pragma unroll
        for (int mi = 0; mi < 2; ++mi) {
            const bf16* qp = proj + PX((size_t)b * T + q0 + 4 * mi + 2 * a_ + c_, COL_AQI + (4 * b_ + d_) * 64) + hh * PXC;
#pragma unroll
            for (int s = 0; s < 4; ++s) af[mi][s] = ldg16(qp + 2 * s * PXC);
#pragma unroll
            for (int a = 0; a < 2; ++a) {
                const u32x4 w4 = *(const u32x4*)(proj + PX((size_t)b * T + q0 + 4 * mi + 2 * a + hh, COL_AWI));
                wv[mi][a][0] = bflo(w4.x); wv[mi][a][1] = bfhi(w4.x); wv[mi][a][2] = bflo(w4.y); wv[mi][a][3] = bfhi(w4.y);
                wv[mi][a][4] = bflo(w4.z); wv[mi][a][5] = bfhi(w4.z); wv[mi][a][6] = bflo(w4.w); wv[mi][a][7] = bfhi(w4.w);
            }
        }
    }
    const bf16* kb = kip + (size_t)b * (T / 32) * 2048 + lane * 8;
    const int ntl = L / 32;
    for (int rep_mm = 0; rep_mm < REP_IDX_MM; ++rep_mm) {
    bf16x8 b0[4], b1[4], b2[4];
#pragma unroll
    for (int s = 0; s < 4; ++s) { b0[s] = ldg16(kb + (size_t)wave * 2048 + s * 512); b1[s] = b0[s]; b2[s] = b0[s]; }
    if (wave + 8 < ntl) {
#pragma unroll
        for (int s = 0; s < 4; ++s) b1[s] = ldg16(kb + (size_t)(wave + 8) * 2048 + s * 512);
    }
    if (wave + 16 < ntl) {
#pragma unroll
        for (int s = 0; s < 4; ++s) b2[s] = ldg16(kb + (size_t)(wave + 16) * 2048 + s * 512);
    }
    auto tile = [&](int kt, bf16x8 (&bq)[4]) {
#pragma unroll
        for (int mi = 0; mi < 2; ++mi) {
            f32x16 acc = zero16();
#pragma unroll
            for (int s = 0; s < 4; ++s) acc = mfma32(af[mi][s], bq[s], acc);
#pragma unroll
            for (int a = 0; a < 2; ++a) {
                float sc = 0.f;
#pragma unroll
                for (int h8 = 0; h8 < 8; ++h8) { const int ri = __float_as_int(acc[8 * a + h8]); sc = __builtin_fmaf(__int_as_float(ri > 0 ? ri : 0), wv[mi][a][h8], sc); }
                SCR[(4 * mi + 2 * a + hh) * 4096 + 32 * kt + r] = sc;
            }
        }
        if (kt + 24 < ntl) {
#pragma unroll
            for (int s = 0; s < 4; ++s) bq[s] = ldg16(kb + (size_t)(kt + 24) * 2048 + s * 512);
        }
    };
    for (int kt = wave; kt < ntl; kt += 24) {
        tile(kt, b0);
        if (kt + 8 < ntl) tile(kt + 8, b1);
        if (kt + 16 < ntl) tile(kt + 16, b2);
    }
    }
    {
        LAS float* padrow = SCR + wave * 4096;
        const int Lp = ((nr + 7) & ~7) * 64;
        for (int c = L + lane; c < Lp; c += 64) padrow[c] = -__builtin_inff();
    }
    __syncthreads();
    const LAS float* myrow = SCR + wave * 4096;
    float x[64];
#pragma unroll
    for (int g = 0; g < 8; ++g) {
        if (8 * g < nr) {
#pragma unroll
            for (int i = 0; i < 8; ++i) x[8 * g + i] = myrow[64 * (8 * g + i) + lane];
        } else {
#pragma unroll
            for (int i = 0; i < 8; ++i) x[8 * g + i] = -__builtin_inff();
        }
    }
    float tf = 0.f; bool found = false; u64 myword = 0ull;
    LAS unsigned* HH = (LAS unsigned*)(SCR + wave * 4096); LAS float* LIST = (LAS float*)(lds + 131072 + wave * 2048);
    int lane_o = lane; asm volatile("" : "+v"(lane_o));
    switch ((nr + 7) >> 3) {
        case 1: topk_search<1>(x, HH, LIST, tf, found, myword, lane_o); break;
        case 2: topk_search<2>(x, HH, LIST, tf, found, myword, lane_o); break;
        case 3: topk_search<3>(x, HH, LIST, tf, found, myword, lane_o); break;
        case 4: topk_search<4>(x, HH, LIST, tf, found, myword, lane_o); break;
        case 5: topk_search<5>(x, HH, LIST, tf, found, myword, lane_o); break;
        case 6: topk_search<6>(x, HH, LIST, tf, found, myword, lane_o); break;
        case 7: topk_search<7>(x, HH, LIST, tf, found, myword, lane_o); break;
        default: topk_search<8>(x, HH, LIST, tf, found, myword, lane_o); break;
    }
    if (!found) {
        int cgt = 0;
#pragma unroll
        for (int i = 0; i < 64; ++i) { cgt += __popcll(__ballot(x[i] > tf)); if ((i & 3) == 3) __builtin_amdgcn_sched_barrier(0); }
        int need = 256 - cgt;
        float tf2 = tf; asm volatile("" : "+v"(tf2));
#pragma unroll
        for (int i = 0; i < 64; ++i) {
            u64 w = __ballot(x[i] > tf2);
            u64 e = __ballot(x[i] == tf2);
            if (need > 0 && e != 0ull) {
                const int c = __popcll(e);
                if (c <= need) { w |= e; need -= c; }
                else { for (int t2 = 0; t2 < need; ++t2) { const u64 low = e & (0ull - e); w |= low; e ^= low; } need = 0; }
            }
            if (lane_o == i) myword = w;
            if ((i & 3) == 3) __builtin_amdgcn_sched_barrier(0);
        }
    }
    if (lane < nr) mout[lane] = myword;
    __syncthreads();
}

__device__ __forceinline__ float ret_log2g(int h) { return log2f(1.f - exp2f(-5.f - (float)h)); }
template <bool SCALE>
__device__ __forceinline__ void stage_img64(LAS unsigned char* img, const bf16* proj, size_t tok0, int col, int lane, float scale) {
    const bf16* vp = proj + PX(tok0 + lane, col);
#pragma unroll
    for (int ch = 0; ch < 8; ++ch) {
        bf16x8 vv = ldg16(vp + ch * PXC);
        if (SCALE) { u32x4 w; w.x = cvtpk(bf2f(vv[0]) * scale, bf2f(vv[1]) * scale); w.y = cvtpk(bf2f(vv[2]) * scale, bf2f(vv[3]) * scale); w.z = cvtpk(bf2f(vv[4]) * scale, bf2f(vv[5]) * scale); w.w = cvtpk(bf2f(vv[6]) * scale, bf2f(vv[7]) * scale); vv = __builtin_bit_cast(bf16x8, w); }
        *(LAS bf16x8*)(img + (ch >> 2) * 4096 + lane * 64 + (ch & 3) * 16) = vv;
    }
}
__device__ __forceinline__ void ret_state_unit(LAS unsigned char* wl, const bf16* proj, float* UB, int b, int c, int h, int lane) {
    LAS unsigned char* VI = wl; LAS unsigned char* KI = wl + 8192;
    const size_t tok0 = (size_t)b * T + 64 * c;
    const int r = lane & 31, hh = lane >> 5;
    stage_img64<false>(VI, proj, tok0, COL_BV + h * 64, lane, 1.f);
    stage_img64<true>(KI, proj, tok0, COL_BK + h * 64, lane, exp2f((63.f - (float)lane) * ret_log2g(h)));
    LDS_FENCE();
    const LAS unsigned char* const vnb = tr_base_nat(VI, lane); const LAS unsigned char* const knb = tr_base_nat(KI, lane);
    float* ub = UB + (size_t)((b * NCH + c) * 4 + h) * 4096;
    f32x16 acc[2][2];
#pragma unroll
    for (int me = 0; me < 2; ++me)
#pragma unroll
        for (int nd = 0; nd < 2; ++nd) acc[me][nd] = zero16();
#define RS_STEP(K0) do { const bf16x8 a0 = ld_tr_nat<0, K0>(vnb), a1 = ld_tr_nat<1, K0>(vnb), b0_ = ld_tr_nat<0, K0>(knb), b1_ = ld_tr_nat<1, K0>(knb); \
        acc[0][0] = mfma32(a0, b0_, acc[0][0]); acc[0][1] = mfma32(a0, b1_, acc[0][1]); acc[1][0] = mfma32(a1, b0_, acc[1][0]); acc[1][1] = mfma32(a1, b1_, acc[1][1]); } while (0)
    RS_STEP(0); RS_STEP(16); RS_STEP(32); RS_STEP(48);
#undef RS_STEP
#pragma unroll
    for (int me = 0; me < 2; ++me)
#pragma unroll
        for (int nd = 0; nd < 2; ++nd)
#pragma unroll
            for (int i = 0; i < 16; ++i) ub[(32 * me + crow(i, hh)) * 64 + 32 * nd + r] = acc[me][nd][i];
    LDS_FENCE();
}
__device__ __forceinline__ void ret_out_unit(LAS unsigned char* wl, const bf16* proj, const bf16* RB, const float* hng, bf16* Y, int b, int c, int h, int lane_in) {
    int lane = lane_in; asm volatile("" : "+v"(lane));
    LAS unsigned char* VI = wl;
    const size_t tok0 = (size_t)b * T + 64 * c;
    const int r = lane & 31, hh = lane >> 5;
    bf16x8 vrow[8], kf[2][4], qf[2][4], rbf[2][4];
    {
        const bf16* vp = proj + PX(tok0 + lane, COL_BV + h * 64);
#pragma unroll
        for (int ch = 0; ch < 8; ++ch) vrow[ch] = ldg16(vp + ch * PXC);
        const bf16* rb = RB + (size_t)((b * NCH + c) * 4 + h) * 4096;
#pragma unroll
        for (int mi = 0; mi < 2; ++mi)
#pragma unroll
            for (int s = 0; s < 4; ++s) {
                kf[mi][s] = ldg16(proj + PX(tok0 + 32 * mi + r, COL_BK + h * 64) + (2 * s + hh) * PXC);
                if (mi == 0) qf[0][s] = ldg16(proj + PX(tok0 + r, COL_BQ + h * 64) + (2 * s + hh) * PXC);
                rbf[mi][s] = ldg16(rb + (32 * mi + r) * 64 + 16 * s + 8 * hh);
            }
    }
#pragma unroll
    for (int ch = 0; ch < 8; ++ch) *(LAS bf16x8*)(VI + (ch >> 2) * 4096 + lane * 64 + (ch & 3) * 16) = vrow[ch];
    LDS_FENCE();
    const LAS unsigned char* const vtb = tr_base_perm(VI, lane);
    const float lg = ret_log2g(h);
#pragma unroll
    for (int ni = 0; ni < 2; ++ni) {
        const int i_ = 32 * ni + r;
        u32x4 gt[4];
        load_rows16(proj + PX(tok0 + i_, COL_BG + h * 64), hh, gt);
        if (ni == 0) {
#pragma unroll
            for (int s = 0; s < 4; ++s) qf[1][s] = ldg16(proj + PX(tok0 + 32 + r, COL_BQ + h * 64) + (2 * s + hh) * PXC);
        }
        f32x16 out[2];
#pragma unroll
        for (int me = 0; me < 2; ++me) {
            out[me] = zero16();
#pragma unroll
            for (int s = 0; s < 4; ++s) out[me] = mfma32(rbf[me][s], qf[ni][s], out[me]);
        }
        const float xi = __builtin_amdgcn_exp2f((float)(i_ + 1) * lg);
#pragma unroll
        for (int me = 0; me < 2; ++me)
#pragma unroll
            for (int i = 0; i < 16; ++i) out[me][i] *= xi;
#pragma unroll
        for (int mi = 0; mi < 2; ++mi) {
            f32x16 x = zero16();
#pragma unroll
            for (int s = 0; s < 4; ++s) x = mfma32(kf[mi][s], qf[ni][s], x);
#pragma unroll
            for (int i = 0; i < 16; ++i) { const int j_ = 32 * mi + crow(i, hh); x[i] *= __builtin_amdgcn_exp2f(fabsf((float)(i_ - j_)) * lg); }
            const bf16x8 p0 = pack8<0>(x), p1 = pack8<1>(x);
            if (mi == 0) {
                out[0] = mfma32(ld_tr_perm<0, 0>(vtb), p0, out[0]); out[0] = mfma32(ld_tr_perm<0, 16>(vtb), p1, out[0]);
                out[1] = mfma32(ld_tr_perm<1, 0>(vtb), p0, out[1]); out[1] = mfma32(ld_tr_perm<1, 16>(vtb), p1, out[1]);
            } else {
                out[0] = mfma32(ld_tr_perm<0, 32>(vtb), p0, out[0]); out[0] = mfma32(ld_tr_perm<0, 48>(vtb), p1, out[0]);
                out[1] = mfma32(ld_tr_perm<1, 32>(vtb), p0, out[1]); out[1] = mfma32(ld_tr_perm<1, 48>(vtb), p1, out[1]);
            }
        }
        headnorm_store_g<true>(out, hh, hng + 256 + h * 64, gt, 1.f, Y + (tok0 + i_) * D + 256 + h * 64);
    }
    LDS_FENCE();
}

__device__ __forceinline__ void gla_cumsum(LAS float* BL, const bf16* proj, const float* wa2, const float* ba, size_t tok0, int h, int lane) {
    const int k = lane & 31, hh = lane >> 5;
    bf16x8 wf;
    {
        float w[8];
#pragma unroll
        for (int j = 0; j < 8; ++j) w[j] = wa2[(8 * hh + j) * 128 + h * 32 + k];
        u32x4 p; p.x = cvtpk(w[0], w[1]); p.y = cvtpk(w[2], w[3]); p.z = cvtpk(w[4], w[5]); p.w = cvtpk(w[6], w[7]);
        wf = __builtin_bit_cast(bf16x8, p);
    }
    const float bias = ba[h * 32 + k];
    const int tau = 16 * ((k >> 2) & 1) + 4 * (k >> 3) + (k & 3);
    f32x16 z[2];
#pragma unroll
    for (int mi = 0; mi < 2; ++mi) {
        const bf16x8 af = ldg16(proj + PX(tok0 + 32 * mi + tau, COL_CA) + hh * PXC);
        f32x16 c0;
#pragma unroll
        for (int i = 0; i < 16; ++i) c0[i] = bias;
        z[mi] = mfma32(af, wf, c0);
    }
    float tot[2];
#pragma unroll
    for (int mi = 0; mi < 2; ++mi) {
        float run = 0.f;
#pragma unroll
        for (int i = 0; i < 16; ++i) {
            const float e = __builtin_amdgcn_exp2f(fminf(-z[mi][i] * LOG2E, 120.f));
            run -= __builtin_amdgcn_logf(1.f + e) * (1.f / 16.f);
            z[mi][i] = run;
        }
        tot[mi] = run;
    }
    const float oth0 = __int_as_float(__builtin_amdgcn_ds_bpermute((lane ^ 32) << 2, __float_as_int(tot[0])));
    const float oth1 = __int_as_float(__builtin_amdgcn_ds_bpermute((lane ^ 32) << 2, __float_as_int(tot[1])));
    const float off0 = hh ? oth0 : 0.f, off1 = tot[0] + oth0 + (hh ? oth1 : 0.f);
#pragma unroll
    for (int i = 0; i < 16; ++i) { BL[(16 * hh + i) * 33 + k] = z[0][i] + off0; BL[(32 + 16 * hh + i) * 33 + k] = z[1][i] + off1; }
    LDS_FENCE();
}
__device__ __forceinline__ float clamp_exp(float x) { return __builtin_amdgcn_exp2f(fminf(fmaxf(x, -115.f), 115.f)); }
__device__ __forceinline__ void gla_state_unit(LAS unsigned char* wl, const bf16* proj, const float* wa2, const float* ba, float* UC, float* GC, int b, int c, int h, int lane) {
    LAS float* BL = (LAS float*)wl; LAS unsigned char* VI = wl; LAS unsigned char* KI = wl + 9216;
    const size_t tok0 = (size_t)b * T + 64 * c;
    const int r = lane & 31, hh = lane >> 5;
    gla_cumsum(BL, proj, wa2, ba, tok0, h, lane);
    {
        const bf16* kp = proj + PX(tok0 + lane, COL_CK + h * 32);
#pragma unroll
        for (int ch = 0; ch < 4; ++ch) { const bf16x8 kv = ldg16(kp + ch * PXC);
            float x[8];
#pragma unroll
            for (int i = 0; i < 8; ++i) { const int kk = 8 * ch + i; x[i] = bf2f(kv[i]) * clamp_exp(BL[63 * 33 + kk] - BL[lane * 33 + kk]); }
            u32x4 w; w.x = cvtpk(x[0], x[1]); w.y = cvtpk(x[2], x[3]); w.z = cvtpk(x[4], x[5]); w.w = cvtpk(x[6], x[7]);
            *(LAS u32x4*)(KI + lane * 64 + ch * 16) = w; }
        if (lane < 32) GC[(size_t)((b * NCH + c) * 4 + h) * 32 + lane] = clamp_exp(BL[63 * 33 + lane]);
    }
    LDS_FENCE();
    stage_img64<false>(VI, proj, tok0, COL_CV + h * 64, lane, 1.f);
    LDS_FENCE();
    const LAS unsigned char* const vnb = tr_base_nat(VI, lane); const LAS unsigned char* const knb = tr_base_nat(KI, lane);
    float* uc = UC + (size_t)((b * NCH + c) * 4 + h) * 2048;
    f32x16 acc[2]; acc[0] = zero16(); acc[1] = zero16();
#define GS_STEP(K0) do { const bf16x8 a0 = ld_tr_nat<0, K0>(vnb), a1 = ld_tr_nat<1, K0>(vnb), b0_ = ld_tr_nat<0, K0>(knb); acc[0] = mfma32(a0, b0_, acc[0]); acc[1] = mfma32(a1, b0_, acc[1]); } while (0)
    GS_STEP(0); GS_STEP(16); GS_STEP(32); GS_STEP(48);
#undef GS_STEP
#pragma unroll
    for (int me = 0; me < 2; ++me)
#pragma unroll
        for (int i = 0; i < 16; ++i) uc[(32 * me + crow(i, hh)) * 32 + r] = acc[me][i];
    LDS_FENCE();
}
__device__ __forceinline__ void gla_frag(const bf16x8 v, const LAS float* bl, bf16x8& fp, bf16x8& fm) {
    float xp[8], xm[8];
#pragma unroll
    for (int j = 0; j < 8; ++j) { const float x = bf2f(v[j]), bb = bl[j]; xp[j] = x * clamp_exp(bb); xm[j] = x * clamp_exp(-bb); }
    u32x4 a, c;
    a.x = cvtpk(xp[0], xp[1]); a.y = cvtpk(xp[2], xp[3]); a.z = cvtpk(xp[4], xp[5]); a.w = cvtpk(xp[6], xp[7]);
    c.x = cvtpk(xm[0], xm[1]); c.y = cvtpk(xm[2], xm[3]); c.z = cvtpk(xm[4], xm[5]); c.w = cvtpk(xm[6], xm[7]);
    fp = __builtin_bit_cast(bf16x8, a); fm = __builtin_bit_cast(bf16x8, c);
}
__device__ __forceinline__ void gla_out_unit(LAS unsigned char* wl, const bf16* proj, const float* wa2, const float* ba, const bf16* SCB, const float* hng, bf16* Y, int b, int c, int h, int lane_in) {
    int lane = lane_in; asm volatile("" : "+v"(lane));
    LAS unsigned char* VI = wl; LAS float* BL = (LAS float*)(wl + 9216);
    const size_t tok0 = (size_t)b * T + 64 * c;
    const int r = lane & 31, hh = lane >> 5;
    bf16x8 vrow[8], kraw[2][2], qraw[2][2], stf[2][2];
    {
        const bf16* vp = proj + PX(tok0 + lane, COL_CV + h * 64);
#pragma unroll
        for (int ch = 0; ch < 8; ++ch) vrow[ch] = ldg16(vp + ch * PXC);
        const bf16* sc = SCB + (size_t)((b * NCH + c) * 4 + h) * 2048;
#pragma unroll
        for (int mi = 0; mi < 2; ++mi)
#pragma unroll
            for (int s = 0; s < 2; ++s) {
                kraw[mi][s] = ldg16(proj + PX(tok0 + 32 * mi + r, COL_CK + h * 32) + (2 * s + hh) * PXC);
                if (mi == 0) qraw[0][s] = ldg16(proj + PX(tok0 + r, COL_CQ + h * 32) + (2 * s + hh) * PXC);
                stf[mi][s] = ldg16(sc + (32 * mi + r) * 32 + 16 * s + 8 * hh);
            }
    }
    gla_cumsum(BL, proj, wa2, ba, tok0, h, lane);
#pragma unroll
    for (int ch = 0; ch < 8; ++ch) *(LAS bf16x8*)(VI + (ch >> 2) * 4096 + lane * 64 + (ch & 3) * 16) = vrow[ch];
    LDS_FENCE();
    const LAS unsigned char* const vtb = tr_base_perm(VI, lane);
    bf16x8 kp_[2][2], km_[2][2];
#pragma unroll
    for (int mi = 0; mi < 2; ++mi)
#pragma unroll
        for (int s = 0; s < 2; ++s) gla_frag(kraw[mi][s], BL + (32 * mi + r) * 33 + 16 * s + 8 * hh, kp_[mi][s], km_[mi][s]);
#pragma unroll
    for (int ni = 0; ni < 2; ++ni) {
        const int t_ = 32 * ni + r;
        if (ni == 0) {
#pragma unroll
            for (int s = 0; s < 2; ++s) qraw[1][s] = ldg16(proj + PX(tok0 + 32 + r, COL_CQ + h * 32) + (2 * s + hh) * PXC);
        }
        bf16x8 qp_[2], qm_[2];
#pragma unroll
        for (int s = 0; s < 2; ++s) gla_frag(qraw[ni][s], BL + t_ * 33 + 16 * s + 8 * hh, qp_[s], qm_[s]);
        f32x16 out[2];
#pragma unroll
        for (int me = 0; me < 2; ++me) {
            out[me] = zero16();
#pragma unroll
            for (int s = 0; s < 2; ++s) out[me] = mfma32(stf[me][s], qp_[s], out[me]);
        }
#pragma unroll
        for (int mi = 0; mi < 2; ++mi) {
            f32x16 x;
            if (mi < ni) {
                x = zero16();
#pragma unroll
                for (int s = 0; s < 2; ++s) x = mfma32(km_[mi][s], qp_[s], x);
            } else if (mi > ni) {
                x = zero16();
#pragma unroll
                for (int s = 0; s < 2; ++s) x = mfma32(kp_[mi][s], qm_[s], x);
            } else {
                f32x16 x1 = zero16(), x2 = zero16();
#pragma unroll
                for (int s = 0; s < 2; ++s) { x1 = mfma32(km_[mi][s], qp_[s], x1); x2 = mfma32(kp_[mi][s], qm_[s], x2); }
#pragma unroll
                for (int i = 0; i < 16; ++i) x[i] = (crow(i, hh) <= r) ? x1[i] : x2[i];
            }
            const bf16x8 p0 = pack8<0>(x), p1 = pack8<1>(x);
            if (mi == 0) {
                out[0] = mfma32(ld_tr_perm<0, 0>(vtb), p0, out[0]); out[0] = mfma32(ld_tr_perm<0, 16>(vtb), p1, out[0]);
                out[1] = mfma32(ld_tr_perm<1, 0>(vtb), p0, out[1]); out[1] = mfma32(ld_tr_perm<1, 16>(vtb), p1, out[1]);
            } else {
                out[0] = mfma32(ld_tr_perm<0, 32>(vtb), p0, out[0]); out[0] = mfma32(ld_tr_perm<0, 48>(vtb), p1, out[0]);
                out[1] = mfma32(ld_tr_perm<1, 32>(vtb), p0, out[1]); out[1] = mfma32(ld_tr_perm<1, 48>(vtb), p1, out[1]);
            }
        }
        headnorm_store<true, true>(out, hh, hng + 512 + h * 64, proj + PX(tok0 + t_, COL_CG + h * 64), 1.f, Y + (tok0 + t_) * D + 512 + h * 64);
    }
    LDS_FENCE();
}

#ifndef EN_P0
#define EN_P0 1
#endif
#ifndef EN_ROW
#define EN_ROW 1
#endif
#ifndef EN_G0
#define EN_G0 1
#endif
#ifndef EN_M1
#define EN_M1 1
#endif
#ifndef EN_M2
#define EN_M2 1
#endif
#ifndef EN_M3
#define EN_M3 1
#endif
#ifndef EN_G1
#define EN_G1 1
#endif
#ifndef EN_G2
#define EN_G2 1
#endif
#ifndef EN_G3
#define EN_G3 1
#endif
#ifndef EN_M1A
#define EN_M1A 1
#endif
#ifndef EN_M1A2
#define EN_M1A2 1
#endif
#ifndef EN_M1B
#define EN_M1B 1
#endif
#ifndef EN_M1C
#define EN_M1C 1
#endif
#ifndef EN_M3A
#define EN_M3A 1
#endif
#ifndef EN_M3B
#define EN_M3B 1
#endif
struct Args { const void* in[20]; float* out; unsigned char* ws; int ph_lo, ph_hi; };
#ifndef MK_ALIGN
#define MK_ALIGN true
#endif
#ifndef MK_SP2
#define MK_SP2 true
#endif

#ifndef REP_M1A
#define REP_M1A 1
#endif
#ifndef REP_M1B
#define REP_M1B 1
#endif
#ifndef REP_M1C
#define REP_M1C 1
#endif
#ifndef REP_M2A
#define REP_M2A 1
#endif
#ifndef REP_M2B
#define REP_M2B 1
#endif
#ifndef REP_M3
#define REP_M3 1
#endif
#ifndef REP_G
#define REP_G 1
#endif
#ifndef EN_SEAM
#define EN_SEAM 1
#endif
#ifndef NLAYER_LOOP
#define NLAYER_LOOP 2
#endif
__device__ __forceinline__ unsigned long long karg_raw(int idx) {
    const __attribute__((address_space(4))) unsigned char* k = (const __attribute__((address_space(4))) unsigned char*)__builtin_amdgcn_kernarg_segment_ptr();
    const unsigned long long v = *(const volatile __attribute__((address_space(4))) unsigned long long*)(k + 8 * idx);
    const unsigned lo = __builtin_amdgcn_readfirstlane((unsigned)v), hi = __builtin_amdgcn_readfirstlane((unsigned)(v >> 32));
    return ((unsigned long long)hi << 32) | lo;
}
template <class Tp> __device__ __forceinline__ Tp* kptr(int idx) { return (Tp*)(GAS Tp*)karg_raw(idx); }
#define KIN(idx) kptr<const float>(idx)
#define KWS() kptr<unsigned char>(21)
#define KOUT() kptr<float>(20)

__global__ void __launch_bounds__(NTHREADS, 2) mk_fwd(Args args) {
    extern __shared__ __attribute__((aligned(16))) unsigned char lds_raw[];
    LAS unsigned char* lds = (LAS unsigned char*)lds_raw;
    const int G = gridDim.x, bx = blockIdx.x;
    const int wave_s = __builtin_amdgcn_readfirstlane(threadIdx.x >> 6);
#define PHASE_IDS int tid; asm volatile("v_mbcnt_lo_u32_b32 %0, -1, 0\n\tv_mbcnt_hi_u32_b32 %0, -1, %0\n\tv_lshl_add_u32 %0, %1, 6, %0" : "=&v"(tid) : "s"(wave_s)); const int lane = tid & 63, wave = __builtin_amdgcn_readfirstlane(tid >> 6); const int gw = bx * NWAVES + wave, ngw = G * NWAVES; (void)gw; (void)ngw; (void)lane;

    for (int u = threadIdx.x; u < (LDS_BYTES - LDSCTL_OFF) / 4; u += NTHREADS) ((LAS unsigned*)(lds + LDSCTL_OFF))[u] = 0u;
    __syncthreads();
    const int lo = args.ph_lo, hi = args.ph_hi;
    if (hi - lo > 1) (void)xcd_barrier_post((unsigned*)(KWS() + WS_CTL) + CW_BAR, (volatile LAS unsigned*)(lds + LDSCTL_OFF));
#define IN(k) (lo <= (k) && (k) < hi)
#define SEAM(k) do { if (EN_SEAM && IN(k) && IN((k) + 1)) { XcdBarrier b_; b_.bar = (unsigned*)(KWS() + WS_CTL) + CW_BAR; b_.x = xb_xcc_id(); b_.st = (volatile LAS unsigned*)(lds + LDSCTL_OFF); xcd_barrier(b_); } } while (0)

    if (EN_P0 && IN(0)) {
        PHASE_IDS
        unsigned char* ws = KWS();
        LAS float* scr = (LAS float*)(lds + wave * 8448);
        constexpr int I_IN = (D / 64) * (NPROJ / 32), I_OUT = (D / 64) * (D / 32), I_1 = (D / 64) * (FF / 32), I_2 = (FF / 64) * (D / 32), I_L = I_IN + I_OUT + I_1 + I_2;
        {
            LAS float* condT = (LAS float*)lds;
            LAS float* part = (LAS float*)(lds + 65536);
            const float* c_in = KIN(1); const float* mod_w = KIN(3); const float* mod_b = KIN(4); float* MOD = (float*)(ws + WS_MOD);
            for (int i = tid; i < BATCH * D; i += NTHREADS) { const int b = i >> 10, k = i & 1023; const float v = c_in[i]; condT[k * 16 + b] = v / (1.f + expf(-v)); }
            __syncthreads();
            for (int cg = bx; cg < 256; cg += G) {
                const int l = cg >> 7, jj = 48 * (cg & 127) + (lane < 48 ? lane : 0);
                float acc[16];
#pragma unroll
                for (int b = 0; b < 16; ++b) acc[b] = 0.f;
                const float* wp = mod_w + ((size_t)l * D + 128 * wave) * 6144 + jj;
#pragma unroll 16
                for (int k = 0; k < 128; ++k) {
                    const float w = wp[(size_t)k * 6144];
                    const LAS float* cp = condT + (128 * wave + k) * 16;
                    const f32x4 c0 = *(const LAS f32x4*)(cp), c1 = *(const LAS f32x4*)(cp + 4), c2 = *(const LAS f32x4*)(cp + 8), c3 = *(const LAS f32x4*)(cp + 12);
#pragma unroll
                    for (int b = 0; b < 4; ++b) { acc[b] += c0[b] * w; acc[4 + b] += c1[b] * w; acc[8 + b] += c2[b] * w; acc[12 + b] += c3[b] * w; }
                }
                if (lane < 48) {
#pragma unroll
                    for (int b = 0; b < 16; ++b) part[(wave * 16 + b) * 48 + lane] = acc[b];
                }
                __syncthreads();
                for (int o = tid; o < 768; o += NTHREADS) {
                    const int b = o / 48, cc = o % 48, j = 48 * (cg & 127) + cc;
                    float s = mod_b[l * 6144 + j];
#pragma unroll
                    for (int w8 = 0; w8 < 8; ++w8) s += part[(w8 * 16 + b) * 48 + cc];
                    MOD[(size_t)(l * 16 + b) * 6144 + j] = s;
                }
                __syncthreads();
            }
        }
        const float* w_in = KIN(9); const float* w_out = KIN(17); const float* mlp_w1 = KIN(18); const float* mlp_w2 = KIN(19);
        for (int it = gw; it < 2 * I_L; it += ngw) {
            const int l = it / I_L; int rr = it % I_L;
            unsigned char* wl = ws + WS_W + (size_t)l * W_LAYER;
            if (rr < I_IN) { transpose_item<true>(w_in + (size_t)l * D * NPROJ_SRC, D, NPROJ_SRC, NPROJ, (bf16*)(wl + W_IN), scr, rr, lane); continue; } rr -= I_IN;
            if (rr < I_OUT) { transpose_item<false>(w_out + (size_t)l * D * D, D, D, D, (bf16*)(wl + W_OUT), scr, rr, lane); continue; } rr -= I_OUT;
            if (rr < I_1) { transpose_item<false>(mlp_w1 + (size_t)l * D * FF, D, FF, FF, (bf16*)(wl + W_1), scr, rr, lane); continue; } rr -= I_1;
            transpose_item_f8(mlp_w2 + (size_t)l * FF * D, FF, D, wl + W_2, scr, rr, lane);
        }
    }
    SEAM(0);
    if (EN_ROW && IN(1)) { PHASE_IDS unsigned char* ws = KWS(); const float* MOD = (const float*)(ws + WS_MOD);
        rowpass<false, true, false, false>(KIN(0), nullptr, nullptr, nullptr, nullptr, nullptr, nullptr, nullptr, KIN(5), MOD + 1 * D, MOD + 0 * D, (bf16*)(ws + WS_H), gw, ngw, lane); }
    SEAM(1);

    for (int l = 0; l < NLAYER_LOOP; ++l) {
        const int pb = 2 + 9 * l;
        if (EN_G0 && IN(pb + 0)) for (int rep = 0; rep < REP_G; ++rep) {
            unsigned char* ws = KWS();
            pg8::Gemm g{(const bf16*)(ws + WS_H), (const bf16*)(ws + WS_W + (size_t)l * W_LAYER + W_IN), M, NPROJ, D}; pg8::StaticOrder S; S.init(M, NPROJ, G, bx);
            EpiProj E{(bf16*)(ws + WS_PROJ), kptr<const int>(2), (bf16*)(ws + WS_KIP)};
            { PHASE_IDS pg8::gemm_phase<EpiProj, pg8::StaticOrder, MK_ALIGN, MK_SP2>(lds, g, S, E, tid); }
        }
        SEAM(pb + 0);
        if (EN_M1 && IN(pb + 1)) {
            for (int rep = 0; rep < REP_M1A; ++rep) {
                PHASE_IDS
                unsigned char* ws = KWS(); const bf16* PROJ = (const bf16*)(ws + WS_PROJ);
                float* UB = (float*)(ws + WS_UB); float* UC = (float*)(ws + WS_UC); float* GC = (float*)(ws + WS_GC);
                const float* gla_wa2 = KIN(10) + l * 16 * 128; const float* gla_ba = KIN(11) + l * 128;
                if (EN_M1A) for (int wu = gw; wu < 4096; wu += ngw) { const int b = wu >> 8, c = (wu >> 2) & 63, h = wu & 3; ret_state_unit(lds + wave * 18432, PROJ, UB, b, c, h, lane); }
                __builtin_amdgcn_sched_barrier(0);
                if (EN_M1A2) for (int wu = gw; wu < 4096; wu += ngw) { const int b = wu >> 8, c = (wu >> 2) & 63, h = wu & 3; gla_state_unit(lds + wave * 18432, PROJ, gla_wa2, gla_ba, UC, GC, b, c, h, lane); }
            }
            __syncthreads();
            if (EN_M1B) for (int rep = 0; rep < REP_M1B; ++rep) {
                PHASE_IDS
                unsigned char* ws = KWS(); const bf16* PROJ = (const bf16*)(ws + WS_PROJ);
                const float lam_init = 0.8f - 0.6f * expf(-0.3f * (float)l);
                float a1 = 0.f, a2 = 0.f;
                if (lane < 32) { a1 = KIN(12)[l * 32 + lane] * KIN(13)[l * 32 + lane]; a2 = KIN(14)[l * 32 + lane] * KIN(15)[l * 32 + lane]; }
                const float lam = expf(wave_sum(a1)) - expf(wave_sum(a2)) + lam_init;
                bf16* Y = (bf16*)(ws + WS_Y); const float* hng = KIN(16) + l * D;
                for (int i = bx; i < 1024; i += G) {
                    const int bh = i & 63, slot = i >> 6, qb = slot ^ ((slot & 4) ? 3 : 0);
                    diff_unit(lds, PROJ, Y, hng, lam, lam_init, bh >> 2, bh & 3, qb, tid, lane, wave);
                }
            }
            if (EN_M1C) for (int rep = 0; rep < REP_M1C; ++rep) {
                PHASE_IDS
                unsigned char* ws = KWS(); const bf16* PROJ = (const bf16*)(ws + WS_PROJ);
                u64* MASK = (u64*)(ws + WS_MASK);
                for (int i = bx; i < 8192; i += G) {
                    const int b = i & 15, slot = i >> 4, g8 = slot ^ ((slot & 16) ? 15 : 0);
                    indexer_unit(lds, PROJ, (const bf16*)(ws + WS_KIP), MASK, b, g8, lane, wave);
                }
            }
        }
        SEAM(pb + 1);
        if (EN_M2 && IN(pb + 2)) {
            for (int rep = 0; rep < REP_M2A; ++rep) {
                PHASE_IDS
                unsigned char* ws = KWS();
                const float* UB = (const float*)(ws + WS_UB); bf16* RB = (bf16*)(ws + WS_RB);
                for (int e2 = bx * NTHREADS + tid; e2 < 16 * 4 * 2048; e2 += G * NTHREADS) {
                    const int b = e2 >> 13, h = (e2 >> 11) & 3, ed = (e2 & 2047) * 2;
                    const float g64 = exp2f(64.f * ret_log2g(h));
                    float rs0 = 0.f, rs1 = 0.f;
                    for (int c0 = 0; c0 < NCH; c0 += 32) {
                        f32x2_t uu[32];
#pragma unroll
                        for (int c = 0; c < 32; ++c) uu[c] = *(const f32x2_t*)(UB + (size_t)((b * NCH + c0 + c) * 4 + h) * 4096 + ed);
#pragma unroll
                        for (int c = 0; c < 32; ++c) { *(unsigned*)(RB + (size_t)((b * NCH + c0 + c) * 4 + h) * 4096 + ed) = cvtpk(rs0, rs1); rs0 = g64 * rs0 + uu[c][0]; rs1 = g64 * rs1 + uu[c][1]; }
                    }
                }
                const float* UC = (const float*)(ws + WS_UC); const float* GC = (const float*)(ws + WS_GC); bf16* SCB = (bf16*)(ws + WS_SCB);
                for (int e2 = bx * NTHREADS + tid; e2 < 16 * 4 * 1024; e2 += G * NTHREADS) {
                    const int b = e2 >> 12, h = (e2 >> 10) & 3, dk = (e2 & 1023) * 2, k = dk & 31;
                    float st0 = 0.f, st1 = 0.f;
                    for (int c0 = 0; c0 < NCH; c0 += 16) {
                        f32x2_t uu[16], gg[16];
#pragma unroll
                        for (int c = 0; c < 16; ++c) { const size_t u0 = (size_t)((b * NCH + c0 + c) * 4 + h); uu[c] = *(const f32x2_t*)(UC + u0 * 2048 + dk); gg[c] = *(const f32x2_t*)(GC + u0 * 32 + k); }
#pragma unroll
                        for (int c = 0; c < 16; ++c) { const size_t u0 = (size_t)((b * NCH + c0 + c) * 4 + h); *(unsigned*)(SCB + u0 * 2048 + dk) = cvtpk(st0, st1); st0 = gg[c][0] * st0 + uu[c][0]; st1 = gg[c][1] * st1 + uu[c][1]; }
                    }
                }
            }
            __syncthreads();
            for (int rep = 0; rep < REP_M2B; ++rep) {
                PHASE_IDS
                unsigned char* ws = KWS();
                const bf16* PROJ = (const bf16*)(ws + WS_PROJ); const u64* MASK = (const u64*)(ws + WS_MASK); bf16* Y = (bf16*)(ws + WS_Y); const float* hng = KIN(16) + l * D;
                for (int i = bx; i < 1024; i += G) {
                    const int b = i & 15, slot = i >> 4, qc = slot ^ ((slot & 16) ? 15 : 0);
                    dsa_unit(lds, PROJ, MASK, Y, hng, b, qc, tid, lane, wave);
                }
            }
        }
        SEAM(pb + 2);
        if (EN_M3 && IN(pb + 3)) for (int rep = 0; rep < REP_M3; ++rep) {
            PHASE_IDS
            unsigned char* ws = KWS();
            const bf16* PROJ = (const bf16*)(ws + WS_PROJ); bf16* Y = (bf16*)(ws + WS_Y); const float* hng = KIN(16) + l * D;
            const bf16* RB = (const bf16*)(ws + WS_RB); const bf16* SCB = (const bf16*)(ws + WS_SCB);
            const float* gla_wa2 = KIN(10) + l * 16 * 128; const float* gla_ba = KIN(11) + l * 128;
            if (EN_M3A) for (int wu = gw; wu < 4096; wu += ngw) { const int b = wu >> 8, c = (wu >> 2) & 63, h = wu & 3; ret_out_unit(lds + wave * 18432, PROJ, RB, hng, Y, b, c, h, lane); }
            __builtin_amdgcn_sched_barrier(0);
            if (EN_M3B) for (int wu = gw; wu < 4096; wu += ngw) { const int b = wu >> 8, c = (wu >> 2) & 63, h = wu & 3; gla_out_unit(lds + wave * 18432, PROJ, gla_wa2, gla_ba, SCB, hng, Y, b, c, h, lane); }
            __syncthreads();
        }
        SEAM(pb + 3);
        if (EN_G1 && IN(pb + 4)) for (int rep = 0; rep < REP_G; ++rep) {
            unsigned char* ws = KWS();
            pg8::Gemm g{(const bf16*)(ws + WS_Y), (const bf16*)(ws + WS_W + (size_t)l * W_LAYER + W_OUT), M, D, D}; pg8::StaticOrder S; S.init(M, D, G, bx);
            EpiY2 E{(bf16*)(ws + WS_Y2), (float*)(ws + WS_SS), 1.f};
            { PHASE_IDS pg8::gemm_phase<EpiY2, pg8::StaticOrder, MK_ALIGN, MK_SP2>(lds, g, S, E, tid); }
        }
        SEAM(pb + 4);
        if (EN_ROW && IN(pb + 5)) {
            PHASE_IDS
            unsigned char* ws = KWS(); const float* modl = (const float*)(ws + WS_MOD) + (size_t)l * 16 * 6144; float* out = KOUT();
            rowpass<true, true, false, true>(l == 0 ? KIN(0) : (const float*)out, nullptr, (bf16*)(ws + WS_X1A), (bf16*)(ws + WS_X1B), (const bf16*)(ws + WS_Y2), (const float*)(ws + WS_SS), KIN(6) + l * D, modl + 2 * D, KIN(7) + l * D, modl + 4 * D, modl + 3 * D, (bf16*)(ws + WS_H), gw, ngw, lane);
        }
        SEAM(pb + 5);
        if (EN_G2 && IN(pb + 6)) for (int rep = 0; rep < REP_G; ++rep) {
            unsigned char* ws = KWS();
            pg8::Gemm g{(const bf16*)(ws + WS_H), (const bf16*)(ws + WS_W + (size_t)l * W_LAYER + W_1), M, FF, D}; pg8::StaticOrder S; S.init(M, FF, G, bx);
            EpiRelu2F8 E{ws + WS_U};
            { PHASE_IDS pg8::gemm_phase<EpiRelu2F8, pg8::StaticOrder, MK_ALIGN, MK_SP2>(lds, g, S, E, tid); }
        }
        SEAM(pb + 6);
        if (EN_G3 && IN(pb + 7)) for (int rep = 0; rep < REP_G; ++rep) {
            unsigned char* ws = KWS();
            pg8::Gemm g{(const bf16*)(ws + WS_U), (const bf16*)(ws + WS_W + (size_t)l * W_LAYER + W_2), M, D, FF / 2}; pg8::StaticOrder S; S.init(M, D, G, bx);
            EpiY2 E{(bf16*)(ws + WS_Y2), (float*)(ws + WS_SS), 1.f / (U_SCALE * W2_SCALE)};
            { PHASE_IDS pg8::gemm_phase<EpiY2, pg8::StaticOrder, MK_ALIGN, MK_SP2, true>(lds, g, S, E, tid); }
        }
        SEAM(pb + 7);
        if (EN_ROW && IN(pb + 8)) {
            PHASE_IDS
            unsigned char* ws = KWS(); const float* MOD = (const float*)(ws + WS_MOD); const float* modl = MOD + (size_t)l * 16 * 6144; float* out = KOUT();
            if (l == 0) rowpass<true, true, true, false>(nullptr, out, (bf16*)(ws + WS_X1A), (bf16*)(ws + WS_X1B), (const bf16*)(ws + WS_Y2), (const float*)(ws + WS_SS), KIN(8) + l * D, modl + 5 * D, KIN(5) + D, MOD + (size_t)16 * 6144 + 1 * D, MOD + (size_t)16 * 6144 + 0 * D, (bf16*)(ws + WS_H), gw, ngw, lane);
            else rowpass<true, false, true, false>(nullptr, out, (bf16*)(ws + WS_X1A), (bf16*)(ws + WS_X1B), (const bf16*)(ws + WS_Y2), (const float*)(ws + WS_SS), KIN(8) + l * D, modl + 5 * D, nullptr, nullptr, nullptr, nullptr, gw, ngw, lane);
        }
        SEAM(pb + 8);
    }
#undef IN
#undef SEAM
}

#ifndef MK_N_LAUNCHES
#define MK_N_LAUNCHES 1
#endif
extern "C" void kernel_launch(void* const* d_in, const int* in_sizes, int n_in, void* d_out, int out_size, void* d_ws, size_t ws_size, hipStream_t stream) {
    static int grid = 0;
    if (grid == 0) {
        if (n_in != 20 || out_size != M * D || ws_size < WS_END) { fprintf(stderr, "kernel_launch: unexpected problem (n_in %d, out %d, ws %zu)\n", n_in, out_size, ws_size); grid = -1; return; }
        int dev = 0, cus = 0, per_cu = 0;
        if (hipGetDevice(&dev) != hipSuccess || hipDeviceGetAttribute(&cus, hipDeviceAttributeMultiprocessorCount, dev) != hipSuccess) { grid = -1; return; }
        if (hipFuncSetAttribute((const void*)mk_fwd, hipFuncAttributeMaxDynamicSharedMemorySize, LDS_BYTES) != hipSuccess) { fprintf(stderr, "kernel_launch: hipFuncSetAttribute failed\n"); grid = -1; return; }
        if (hipOccupancyMaxActiveBlocksPerMultiprocessor(&per_cu, (const void*)mk_fwd, NTHREADS, LDS_BYTES) != hipSuccess || per_cu < 1) fprintf(stderr, "kernel_launch: occupancy query says %d\n", per_cu);
        (void)hipGetLastError();
        grid = cus;
    }
    if (grid < 0) return;
    (void)hipMemsetAsync((char*)d_ws + WS_CTL, 0, CTL_ZERO_BYTES, stream);
    Args a{};
    for (int i = 0; i < 20; ++i) a.in[i] = d_in[i];
    a.out = (float*)d_out; a.ws = (unsigned char*)d_ws;
    if (MK_N_LAUNCHES == 1) { a.ph_lo = 0; a.ph_hi = NPHASES; hipLaunchKernelGGL(mk_fwd, dim3(grid), dim3(NTHREADS), LDS_BYTES, stream, a); }
    else for (int p = 0; p < NPHASES; ++p) { a.ph_lo = p; a.ph_hi = p + 1; hipLaunchKernelGGL(mk_fwd, dim3(grid), dim3(NTHREADS), LDS_BYTES, stream, a); }
}
```

```cpp
#include <hip/hip_runtime.h>
#include <cstdio>
#include <cstdint>
namespace pg8 {
#define PG8_LAS __attribute__((address_space(3)))
typedef unsigned short bf16_t;
typedef short bf16x8 __attribute__((ext_vector_type(8)));
typedef float f32x4 __attribute__((ext_vector_type(4)));
typedef unsigned u32x4 __attribute__((ext_vector_type(4)));
typedef int i32x4 __attribute__((ext_vector_type(4)));
typedef int i32x8 __attribute__((ext_vector_type(8)));
__device__ __forceinline__ i32x8 cat8(bf16x8 lo, bf16x8 hi) { return __builtin_shufflevector(__builtin_bit_cast(i32x4, lo), __builtin_bit_cast(i32x4, hi), 0, 1, 2, 3, 4, 5, 6, 7); }
constexpr int BM = 256, BK = 64, HALF = 128, HTB = HALF * BK * 2  , STAGE_BYTES = 8 * HTB, NXCD = 8, WGM = 8;

__host__ __device__ __forceinline__ int lds_byte(int r, int c) { const int st = (r >> 4) * 2 + (c >> 5), rr = r & 15, cc = c & 31, ob = rr * 64 + cc * 2; return st * 1024 + (ob ^ (((ob >> 9) & 1) << 5)); }
__host__ __device__ __forceinline__ void stage_rc(int b, int& R, int& C) { const int st = b / 1024, sb = b % 1024, swz = sb ^ (((sb >> 9) & 1) << 5); R = (st >> 1) * 16 + swz / 64; C = (st & 1) * 32 + (swz % 64) / 2; }
__host__ __device__ __forceinline__ int perm32(int rho) { const int n = rho >> 4, i = rho & 15; return 8 * (i >> 2) + 4 * n + (i & 3); }

struct Unit { int pm, pn; };
struct Gemm { const bf16_t* A; const bf16_t* Bt; int M, N, K; };

struct StaticOrder {
    int nM, nN, nwg, G, c;
    __host__ __device__ void init(int M, int N, int G_, int c_) { nM = M / BM; nN = N / BM; nwg = nM * nN; G = G_; c = c_; }
    __host__ __device__ bool next(int i, Unit& u) const {
        const long L = (long)i * G + c; if (L >= nwg) return false;
        int wgid = (int)L; { const int q = nwg / NXCD, r = nwg % NXCD, xcd = wgid % NXCD, off = wgid / NXCD; wgid = (xcd < r ? xcd * (q + 1) : r * (q + 1) + (xcd - r) * q) + off; }
        const int nig = WGM * nN, gid = wgid / nig, fm = gid * WGM, gsz = (nM - fm) < WGM ? (nM - fm) : WGM;
        u.pm = fm + ((wgid % nig) % gsz); u.pn = (wgid % nig) / gsz; return true;
    }
    __device__ __forceinline__ void a_ready(const Unit&) const {}
    __device__ __forceinline__ void done(const Unit&) const {}
};

template <class Epi, class Sched, bool ALIGN_EPI = false, bool SP2 = false, bool F8 = false, bool I8 = false>
__device__ __forceinline__ void gemm_phase(PG8_LAS unsigned char* lds, const Gemm g, const Sched& S, const Epi& E, int tid_in) {
    int tid_o = tid_in; asm volatile("" : "+v"(tid_o));
    const int tid = tid_o, wid = __builtin_amdgcn_readfirstlane(tid >> 6), lane = tid & 63, wr = wid >> 2, wc = wid & 3, fr = lane & 15, fq = lane >> 4;
    const int K = g.K, nt = K / BK;
    unsigned voffA[2], voffB[2];
#pragma unroll
    for (int i = 0; i < 2; ++i) { int R, C; stage_rc(tid * 16 + i * 8192, R, C); const int Rb = Epi::PERM ? ((R & ~31) + perm32(R & 31)) : R;
        voffA[i] = (unsigned)(R * K + C) * 2u; voffB[i] = (unsigned)(Rb * K + C) * 2u; }
    const size_t kstep = (size_t)(BK * 2);
    const size_t hstep = (size_t)HALF * K * 2;
    const size_t tstep = 2 * hstep;
    const unsigned ldsw = (unsigned)wid * 1024u;
    const int aoff = lds_byte(wr * 64 + fr, fq * 8), boff = lds_byte(wc * 32 + fr, fq * 8);
#define PG8_SA(b, h) (((b) * 2 + (h)) * HTB)
#define PG8_SB(b, h) ((4 + (b) * 2 + (h)) * HTB)
#define PG8_STAGE(bufoff, gbase, voff) do { _Pragma("unroll") for (int _i = 0; _i < 2; ++_i) \
        __builtin_amdgcn_global_load_lds((const unsigned*)((const char*)(gbase) + (voff)[_i]), (PG8_LAS unsigned*)(lds + (bufoff) + ldsw + _i * 8192), 16, 0, 0); } while (0)
#define PG8_LDA(dst, b, h) do { _Pragma("unroll") for (int m = 0; m < 4; ++m) _Pragma("unroll") for (int k = 0; k < 2; ++k) dst[m][k] = *(const PG8_LAS bf16x8*)(lds + PG8_SA(b, h) + aoff + m * 2048 + k * 1024); } while (0)
#define PG8_LDB(dst, b, h) do { _Pragma("unroll") for (int n = 0; n < 2; ++n) _Pragma("unroll") for (int k = 0; k < 2; ++k) dst[n][k] = *(const PG8_LAS bf16x8*)(lds + PG8_SB(b, h) + boff + n * 2048 + k * 1024); } while (0)
#define PG8_MMA(ai, bj, At, Bt) do { __builtin_amdgcn_s_setprio(1); if constexpr (F8) { _Pragma("unroll") for (int m = 0; m < 4; ++m) _Pragma("unroll") for (int n = 0; n < 2; ++n) \
        acc[ai][bj][m][n] = __builtin_amdgcn_mfma_scale_f32_16x16x128_f8f6f4(cat8(Bt[n][0], Bt[n][1]), cat8(At[m][0], At[m][1]), acc[ai][bj][m][n], 0, 0, 0, 0, 0, 0); } else if constexpr (I8) { \
        _Pragma("unroll") for (int m = 0; m < 4; ++m) _Pragma("unroll") for (int n = 0; n < 2; ++n) _Pragma("unroll") for (int k = 0; k < 2; ++k) \
        acc[ai][bj][m][n] = __builtin_bit_cast(f32x4, __builtin_amdgcn_mfma_i32_16x16x64_i8(__builtin_bit_cast(i32x4, Bt[n][k]), __builtin_bit_cast(i32x4, At[m][k]), __builtin_bit_cast(i32x4, acc[ai][bj][m][n]), 0, 0, 0)); } else { \
        _Pragma("unroll") for (int m = 0; m < 4; ++m) _Pragma("unroll") for (int n = 0; n < 2; ++n) _Pragma("unroll") for (int k = 0; k < 2; ++k) \
        acc[ai][bj][m][n] = __builtin_amdgcn_mfma_f32_16x16x32_bf16(Bt[n][k], At[m][k], acc[ai][bj][m][n], 0, 0, 0); } __builtin_amdgcn_s_setprio(0); } while (0)
#define PG8_WAIT_V(n) asm volatile("s_waitcnt vmcnt(" #n ")" ::: "memory")
#define PG8_WAIT_L(n) asm volatile("s_waitcnt lgkmcnt(" #n ")" ::: "memory")
#define PG8_BAR __builtin_amdgcn_s_barrier()
#define PG8_SCHED __builtin_amdgcn_sched_barrier(0)
    Unit cur, nxt; int ui = 0;
    if (!S.next(0, cur)) return;
    f32x4 acc[2][2][4][2];
#pragma unroll
    for (int a = 0; a < 2; ++a)
#pragma unroll
        for (int b = 0; b < 2; ++b)
#pragma unroll
            for (int m = 0; m < 4; ++m)
#pragma unroll
                for (int n = 0; n < 2; ++n) acc[a][b][m][n] = (f32x4){0.f, 0.f, 0.f, 0.f};
    bf16x8 At[4][2], B0[2][2], B1[2][2];
    const char* cA = (const char*)g.A + (size_t)cur.pm * tstep; const char* cB = (const char*)g.Bt + (size_t)cur.pn * tstep;
    S.a_ready(cur);
    if constexpr (SP2) {
        PG8_STAGE(PG8_SB(0, 0), cB, voffB); PG8_STAGE(PG8_SB(0, 1), cB + hstep, voffB); PG8_STAGE(PG8_SA(0, 0), cA, voffA); PG8_STAGE(PG8_SA(0, 1), cA + hstep, voffA);
        if (wr == 1) PG8_BAR;
        PG8_WAIT_V(2); PG8_BAR;
        PG8_STAGE(PG8_SB(1, 0), cB + kstep, voffB); PG8_STAGE(PG8_SA(1, 0), cA + kstep, voffA); PG8_STAGE(PG8_SB(1, 1), cB + hstep + kstep, voffB);
        PG8_WAIT_V(6); PG8_BAR;
    } else {
        PG8_STAGE(PG8_SB(0, 0), cB, voffB); PG8_STAGE(PG8_SA(0, 0), cA, voffA); PG8_STAGE(PG8_SB(0, 1), cB + hstep, voffB); PG8_STAGE(PG8_SA(0, 1), cA + hstep, voffA);
        if (wr == 1) PG8_BAR;
        PG8_WAIT_V(4); PG8_BAR;
        PG8_STAGE(PG8_SB(1, 0), cB + kstep, voffB); PG8_STAGE(PG8_SA(1, 0), cA + kstep, voffA); PG8_STAGE(PG8_SB(1, 1), cB + hstep + kstep, voffB);
        PG8_WAIT_V(6); PG8_BAR;
    }
    for (;;) {
        const bool has_next = S.next(ui + 1, nxt);
        const char* nA = has_next ? (const char*)g.A + (size_t)nxt.pm * tstep : cA; const char* nB = has_next ? (const char*)g.Bt + (size_t)nxt.pn * tstep : cB;
        for (int t = 0; t < nt; t += 2) {
            if constexpr (F8) asm volatile("" : "+v"(voffA[0]), "+v"(voffA[1]), "+v"(voffB[0]), "+v"(voffB[1]));
            const bool last = (t == nt - 2);
            const char* a1 = cA + (size_t)(t + 1) * kstep;
            const char* a2 = last ? nA : cA + (size_t)(t + 2) * kstep; const char* b2 = last ? nB : cB + (size_t)(t + 2) * kstep;
            const char* a3 = a2 + kstep; const char* b3 = b2 + kstep;
            if (last && has_next) S.a_ready(nxt);
            if constexpr (SP2) {
            PG8_LDB(B0, 0, 0); PG8_LDB(B1, 0, 1); PG8_SCHED; PG8_LDA(At, 0, 0); PG8_STAGE(PG8_SA(1, 1), a1 + hstep, voffA);
            PG8_WAIT_V(8); PG8_WAIT_L(0); PG8_BAR; PG8_MMA(0, 0, At, B0); PG8_MMA(0, 1, At, B1); PG8_BAR; PG8_SCHED;
            PG8_LDA(At, 0, 1); PG8_STAGE(PG8_SB(0, 0), b2, voffB); PG8_STAGE(PG8_SB(0, 1), b2 + hstep, voffB); PG8_STAGE(PG8_SA(0, 0), a2, voffA);
            PG8_WAIT_V(8); PG8_WAIT_L(0); PG8_BAR; PG8_MMA(1, 0, At, B0); PG8_MMA(1, 1, At, B1); PG8_BAR; PG8_SCHED;
            PG8_LDB(B0, 1, 0); PG8_LDB(B1, 1, 1); PG8_SCHED; PG8_LDA(At, 1, 0); PG8_STAGE(PG8_SA(0, 1), a2 + hstep, voffA);
            PG8_WAIT_V(8); PG8_WAIT_L(0); PG8_BAR; PG8_MMA(0, 0, At, B0); PG8_MMA(0, 1, At, B1); PG8_BAR; PG8_SCHED;
            PG8_LDA(At, 1, 1); PG8_STAGE(PG8_SB(1, 0), b3, voffB); PG8_STAGE(PG8_SB(1, 1), b3 + hstep, voffB); PG8_STAGE(PG8_SA(1, 0), a3, voffA);
            PG8_WAIT_V(8); PG8_WAIT_L(0); PG8_BAR; PG8_MMA(1, 0, At, B0); PG8_MMA(1, 1, At, B1); PG8_BAR; PG8_SCHED;
            } else {
            PG8_LDB(B0, 0, 0); PG8_SCHED; PG8_LDA(At, 0, 0); PG8_STAGE(PG8_SA(1, 1), a1 + hstep, voffA);
            PG8_WAIT_L(8); PG8_BAR; PG8_WAIT_L(0); PG8_MMA(0, 0, At, B0); PG8_BAR; PG8_SCHED;
            PG8_LDB(B1, 0, 1); PG8_STAGE(PG8_SB(0, 0), b2, voffB);
            PG8_BAR; PG8_WAIT_L(0); PG8_MMA(0, 1, At, B1); PG8_BAR;
            PG8_LDA(At, 0, 1); PG8_STAGE(PG8_SA(0, 0), a2, voffA);
            PG8_BAR; PG8_WAIT_L(0); PG8_MMA(1, 0, At, B0); PG8_BAR; PG8_SCHED;
            PG8_STAGE(PG8_SB(0, 1), b2 + hstep, voffB);
            PG8_WAIT_V(6); PG8_BAR; PG8_MMA(1, 1, At, B1); PG8_BAR;
            PG8_LDB(B0, 1, 0); PG8_SCHED; PG8_LDA(At, 1, 0); PG8_STAGE(PG8_SA(0, 1), a2 + hstep, voffA);
            PG8_WAIT_L(8); PG8_BAR; PG8_WAIT_L(0); PG8_MMA(0, 0, At, B0); PG8_BAR; PG8_SCHED;
            PG8_LDB(B1, 1, 1); PG8_STAGE(PG8_SB(1, 0), b3, voffB);
            PG8_BAR; PG8_WAIT_L(0); PG8_MMA(0, 1, At, B1); PG8_BAR;
            PG8_LDA(At, 1, 1); PG8_STAGE(PG8_SA(1, 0), a3, voffA);
            PG8_BAR; PG8_WAIT_L(0); PG8_MMA(1, 0, At, B0); PG8_BAR; PG8_SCHED;
            PG8_STAGE(PG8_SB(1, 1), b3 + hstep, voffB);
            PG8_WAIT_V(6); PG8_BAR; PG8_MMA(1, 1, At, B1); PG8_BAR;
            }
        }
        if constexpr (ALIGN_EPI) { if (wr == 0) PG8_BAR; }
        if constexpr (!Epi::AFTER_DRAIN) {
            if constexpr (F8) { int le; asm volatile("v_mbcnt_lo_u32_b32 %0, -1, 0\n\tv_mbcnt_hi_u32_b32 %0, -1, %0" : "=v"(le)); E(acc, cur, wr, wc, le & 15, le >> 4); }
            else E(acc, cur, wr, wc, fr, fq);
            S.done(cur); }
        if (!has_next) break;
#pragma unroll
        for (int a = 0; a < 2; ++a)
#pragma unroll
            for (int b = 0; b < 2; ++b)
#pragma unroll
                for (int m = 0; m < 4; ++m)
#pragma unroll
                    for (int n = 0; n < 2; ++n) acc[a][b][m][n] = (f32x4){0.f, 0.f, 0.f, 0.f};
        cur = nxt; cA = nA; cB = nB; ++ui;
        if constexpr (ALIGN_EPI) { if (wr == 1) PG8_BAR; }
    }
    PG8_WAIT_V(0);
    if constexpr (!ALIGN_EPI) { if (wr == 0) PG8_BAR; }
    PG8_BAR;
    if constexpr (Epi::AFTER_DRAIN) { E.fused(acc, cur, wr, wc, fr, fq, lds, wid, lane); S.done(cur); }
#undef PG8_SA
#undef PG8_SB
#undef PG8_STAGE
#undef PG8_LDA
#undef PG8_LDB
#undef PG8_MMA
#undef PG8_WAIT_V
#undef PG8_WAIT_L
#undef PG8_BAR
#undef PG8_SCHED
}
}
#define LAS __attribute__((address_space(3)))
#define XB_TMO      128
#define XB_XCNT(j)  (256  + 64 * (j))
#define XB_XSUB(j)  (1280 + 64 * (j))
#define XB_XGEN(j)  (2304 + 64 * (j))
#define XB_TOP      3328
#define XB_TOPGEN   3392
#define XCD_BAR_WORDS 3456
#define XB_SPIN_CAP (1u << 18)

__device__ __forceinline__ unsigned xb_ld(unsigned* p)              { return __hip_atomic_load(p, __ATOMIC_RELAXED, __HIP_MEMORY_SCOPE_AGENT); }
__device__ __forceinline__ unsigned xb_add(unsigned* p, unsigned v) { return __hip_atomic_fetch_add(p, v, __ATOMIC_RELAXED, __HIP_MEMORY_SCOPE_AGENT); }
__device__ __forceinline__ unsigned xb_xcc_id() { return (unsigned)__builtin_amdgcn_s_getreg((3 << 11) | 20) & 0xFu; }
#define XB_SPIN(cond, bar) do { unsigned _sp = 0; while (cond) { __builtin_amdgcn_s_sleep(1); \
    if ((++_sp & 255u) == 0u) { if (xb_ld(&(bar)[XB_TMO])) break; if (_sp > XB_SPIN_CAP) { atomicAdd(&(bar)[XB_TMO], 1u); break; } } } } while (0)

struct XcdBarrier {
    unsigned* bar; unsigned x;
    volatile LAS unsigned* st;
};

__device__ __forceinline__ XcdBarrier xcd_barrier_post(unsigned* bar, volatile LAS unsigned* st) {
    XcdBarrier b; b.bar = bar; b.x = xb_xcc_id(); b.st = st;
    if (threadIdx.x == 0) (void)xb_add(&bar[XB_XCNT(b.x)], 1u);
    return b;
}
__device__ __forceinline__ void xcd_barrier_complete(unsigned* bar, unsigned x, unsigned& nloc, unsigned& nx) {
    const unsigned G = gridDim.x * gridDim.y * gridDim.z;
    unsigned sum, cnt, mine, sp = 0u;
    for (;;) {
        sum = 0u; cnt = 0u; mine = 0u;
#pragma unroll
        for (unsigned j = 0; j < 16; ++j) { const unsigned c = xb_ld(&bar[XB_XCNT(j)]); sum += c; cnt += (c > 0u) ? 1u : 0u; mine = (j == x) ? c : mine; }
        if (sum == G) break;
        __builtin_amdgcn_s_sleep(1);
        if ((++sp & 255u) == 0u) { if (xb_ld(&bar[XB_TMO])) break; if (sp > XB_SPIN_CAP) { atomicAdd(&bar[XB_TMO], 1u); break; } }
    }
    nloc = mine > 0u ? mine : 1u; nx = cnt > 0u ? cnt : 1u;
}

__device__ __forceinline__ void xcd_barrier(const XcdBarrier& b) {
    asm volatile("s_waitcnt vmcnt(0)" ::: "memory");
    __syncthreads();
    if (threadIdx.x == 0) {
        unsigned* bar = b.bar;
        __builtin_amdgcn_s_waitcnt(0);
        unsigned nloc = b.st[0], nx = b.st[1];
        if (nloc == 0u) { xcd_barrier_complete(bar, b.x, nloc, nx); b.st[0] = nloc; b.st[1] = nx; }
        const unsigned old = xb_add(&bar[XB_XSUB(b.x)], 1u);
        const unsigned gen = old / nloc;
        if (old + 1u == (gen + 1u) * nloc) {
            __builtin_amdgcn_fence(__ATOMIC_RELEASE, "agent");
            asm volatile("s_waitcnt vmcnt(0)" ::: "memory");
            const unsigned og = xb_add(&bar[XB_TOP], 1u);
            const unsigned tg = og / nx;
            if (og + 1u == (tg + 1u) * nx) xb_add(&bar[XB_TOPGEN], 1u);
            else XB_SPIN(xb_ld(&bar[XB_TOPGEN]) == tg, bar);
            __builtin_amdgcn_fence(__ATOMIC_ACQUIRE, "agent");
            xb_add(&bar[XB_XGEN(b.x)], 1u);
            asm volatile("s_waitcnt vmcnt(0)" ::: "memory");
        } else {
            XB_SPIN(xb_ld(&bar[XB_XGEN(b.x)]) == gen, bar);
            __builtin_amdgcn_fence(__ATOMIC_ACQUIRE, "agent");
            asm volatile("s_waitcnt vmcnt(0)" ::: "memory");
        }
    }
    __syncthreads();
}

constexpr int BATCH = 16, T = 4096, D = 1024, M = BATCH * T, NPROJ = 3584, NPROJ_SRC = 3544, FF = 4096, NCH = T / 64;
constexpr float EPS = 1e-6f;
constexpr float LOG2E = 1.44269504089f, INV2PI = 0.15915494309189535f;
constexpr float LOG2_5E5 = 18.931568569324174f, LOG2_1E4 = 13.287712379549449f;
constexpr int COL_AQ = 0, COL_AK = 256, COL_AV = 320, COL_AKI = 384, COL_CA = 448, COL_AWI = 464, COL_AQI = 512,
              COL_BQ = 1024, COL_BK = 1280, COL_BV = 1536, COL_BG = 1792, COL_CQ = 2048, COL_CK = 2176, COL_CV = 2304, COL_CG = 2560,
              COL_DQ = 2816, COL_DK = 3072, COL_DV = 3328;

constexpr size_t MiB = 1u << 20;
constexpr size_t WS_CTL = 0, CTL_ZERO_BYTES = 1 * MiB;
constexpr size_t WS_MOD = 1 * MiB;
constexpr size_t WS_SS = 2 * MiB;
constexpr size_t WS_GC = 6 * MiB;
constexpr size_t WS_W = 8 * MiB, W_LAYER = 25 * MiB, W_IN = 0, W_OUT = 7 * MiB, W_1 = 9 * MiB, W_2 = 17 * MiB;
constexpr size_t WS_H = 64 * MiB;
constexpr size_t WS_MASK = WS_H, WS_SCB = WS_H + 32 * MiB;
constexpr size_t WS_PROJ = 192 * MiB;
constexpr size_t WS_Y = 640 * MiB;
constexpr size_t WS_Y2 = 768 * MiB;
constexpr size_t WS_UB = WS_Y2, WS_RB = WS_Y2 + 64 * MiB, WS_UC = WS_Y2 + 96 * MiB;
constexpr size_t WS_U = WS_PROJ;
constexpr size_t WS_KIP = 896 * MiB;
constexpr size_t WS_X1A = 904 * MiB, WS_X1B = 704 * MiB;
constexpr size_t WS_END = 968 * MiB;
constexpr int CW_TMO = 0, CW_BAR = 4096, CW_W1MAX = 16;
constexpr size_t WS_HS = 7 * MiB;

constexpr int SCRATCH_BYTES = 147456;
constexpr int LDSCTL_OFF = SCRATCH_BYTES, LDS_BYTES = SCRATCH_BYTES + 1024;
constexpr int NWAVES = 8, NTHREADS = 512;
constexpr int NPHASES = 20;

__host__ __device__ __forceinline__ size_t PX(size_t tok, int col) { return ((tok >> 6) * (NPROJ / 64) + (size_t)(col >> 6)) * 4096 + ((size_t)((col & 63) >> 3) * 64 + (tok & 63)) * 8 + (size_t)(col & 7); }
constexpr int PXC = 512;
constexpr size_t PX_TILE_STRIDE = (size_t)(NPROJ / 64) * 4096;
#define GAS __attribute__((address_space(1)))
#define LAS __attribute__((address_space(3)))
typedef unsigned short bf16;
typedef short bf16x8 __attribute__((ext_vector_type(8)));
typedef short s16x4 __attribute__((ext_vector_type(4)));
typedef float f32x4 __attribute__((ext_vector_type(4)));
typedef float f32x16 __attribute__((ext_vector_type(16)));
typedef unsigned u32x4 __attribute__((ext_vector_type(4)));
typedef unsigned u32x2 __attribute__((ext_vector_type(2)));
typedef float f32x2_t __attribute__((ext_vector_type(2)));
typedef __bf16 bf16x2_t __attribute__((ext_vector_type(2)));
typedef unsigned long long u64;

__device__ __forceinline__ unsigned cvtpk(float lo, float hi) { f32x2_t v = {lo, hi}; bf16x2_t b = __builtin_convertvector(v, bf16x2_t); return __builtin_bit_cast(unsigned, b); }
__device__ __forceinline__ bf16 f2bf(float f) { return (bf16)(cvtpk(f, 0.f) & 0xffffu); }
__device__ __forceinline__ float bf2f(short b) { return __uint_as_float(((unsigned)(unsigned short)b) << 16); }
__device__ __forceinline__ float bflo(unsigned w) { return __uint_as_float(w << 16); }
__device__ __forceinline__ float bfhi(unsigned w) { return __uint_as_float(w & 0xffff0000u); }
__device__ __forceinline__ bf16x8 ldg16(const bf16* p) { return *(const bf16x8*)p; }
__device__ __forceinline__ f32x16 mfma32(bf16x8 a, bf16x8 b, f32x16 c) { return __builtin_amdgcn_mfma_f32_32x32x16_bf16(a, b, c, 0, 0, 0); }
__device__ __forceinline__ int crow(int reg, int hh) { return (reg & 3) + 8 * (reg >> 2) + 4 * hh; }
__device__ __forceinline__ f32x16 zero16() { f32x16 z;
#pragma unroll
    for (int i = 0; i < 16; ++i) z[i] = 0.f; return z; }
#define LDS_FENCE() asm volatile("s_waitcnt lgkmcnt(0)" ::: "memory")
template <int S> __device__ __forceinline__ bf16x8 pack8(const f32x16& x) {
    u32x4 p; p.x = cvtpk(x[8 * S + 0], x[8 * S + 1]); p.y = cvtpk(x[8 * S + 2], x[8 * S + 3]); p.z = cvtpk(x[8 * S + 4], x[8 * S + 5]); p.w = cvtpk(x[8 * S + 6], x[8 * S + 7]);
    return __builtin_bit_cast(bf16x8, p);
}
typedef short v4i16_t __attribute__((ext_vector_type(4)));
__device__ __forceinline__ s16x4 vtr(const LAS unsigned char* p) { return __builtin_bit_cast(s16x4, __builtin_amdgcn_ds_read_tr16_b64_v4i16((LAS v4i16_t*)p)); }
__device__ __forceinline__ const LAS unsigned char* tr_base_perm(const LAS unsigned char* img, int lane) { return img + (4 * (lane >> 5) + ((lane & 15) >> 2)) * 64 + (16 * ((lane >> 4) & 1) + 4 * (lane & 3)) * 2; }
__device__ __forceinline__ const LAS unsigned char* tr_base_nat(const LAS unsigned char* img, int lane) { return img + (8 * (lane >> 5) + ((lane & 15) >> 2)) * 64 + (16 * ((lane >> 4) & 1) + 4 * (lane & 3)) * 2; }
template <int HALF, int K0> __device__ __forceinline__ bf16x8 ld_tr_perm(const LAS unsigned char* pb) {
    const s16x4 lo = vtr(pb + (HALF * 4096 + K0 * 64)), hi = vtr(pb + (HALF * 4096 + (K0 + 8) * 64));
    return __builtin_shufflevector(lo, hi, 0, 1, 2, 3, 4, 5, 6, 7);
}
template <int HALF, int K0> __device__ __forceinline__ bf16x8 ld_tr_nat(const LAS unsigned char* nb) {
    const s16x4 lo = vtr(nb + (HALF * 4096 + K0 * 64)), hi = vtr(nb + (HALF * 4096 + (K0 + 4) * 64));
    return __builtin_shufflevector(lo, hi, 0, 1, 2, 3, 4, 5, 6, 7);
}
template <int XM> __device__ __forceinline__ float swz_xor(float v) { return __int_as_float(__builtin_amdgcn_ds_swizzle(__float_as_int(v), (XM << 10) | 0x1f)); }
__device__ __forceinline__ float half_sum(float v) { const auto rr = __builtin_amdgcn_permlane32_swap(__float_as_uint(v), __float_as_uint(v), false, false); return __uint_as_float(rr[0]) + __uint_as_float(rr[1]); }
__device__ __forceinline__ float half_max(float v) { const auto rr = __builtin_amdgcn_permlane32_swap(__float_as_uint(v), __float_as_uint(v), false, false); return fmaxf(__uint_as_float(rr[0]), __uint_as_float(rr[1])); }
__device__ __forceinline__ int wave_sum_i(int v) {
    v += __builtin_amdgcn_update_dpp(0, v, 0xB1, 0xF, 0xF, true);
    v += __builtin_amdgcn_update_dpp(0, v, 0x4E, 0xF, 0xF, true);
    v += __builtin_amdgcn_update_dpp(0, v, 0x141, 0xF, 0xF, true);
    v += __builtin_amdgcn_update_dpp(0, v, 0x140, 0xF, 0xF, true);
    return __builtin_amdgcn_readlane(v, 0) + __builtin_amdgcn_readlane(v, 16) + __builtin_amdgcn_readlane(v, 32) + __builtin_amdgcn_readlane(v, 48);
}
__device__ __forceinline__ float wave_sum(float v) {
    v += swz_xor<1>(v); v += swz_xor<2>(v); v += swz_xor<4>(v); v += swz_xor<8>(v); v += swz_xor<16>(v);
    return half_sum(v);
}

struct EpiProj {
    static constexpr bool PERM = true, AFTER_DRAIN = false;
    bf16* O; const int* pos; bf16* KIP;
    __device__ __forceinline__ void operator()(const pg8::f32x4 (&acc)[2][2][4][2], const pg8::Unit& u, int wr, int wc, int fr, int fq) const {
        const int pn = u.pn;
        int mode = 0; float sc0 = 1.f, sc1 = 1.f; bool act = false;
        if (pn == 0) { mode = 1; sc0 = sc1 = 0.125f * LOG2E; act = true; }
        else if (pn == 1) { mode = 1; act = (wc < 2); if (wc == 2 && fq == 2) sc1 = 0.04419417382415922f; }
        else if (pn == 2 || pn == 3) { mode = 1; act = true; }
        else if (pn == 4) { mode = 2; sc0 = sc1 = 0.125f; act = true; }
        else if (pn == 5) { mode = 2; act = true; }
        else if (pn == 8) { sc0 = 0.17677669529663687f; }
        else if (pn == 11) { mode = 3; sc0 = sc1 = 0.17677669529663687f * LOG2E; act = true; }
        else if (pn == 12) { mode = 3; act = true; }
        float inv[2][2]; bool lane_act = false;
#pragma unroll
        for (int n = 0; n < 2; ++n)
#pragma unroll
            for (int p = 0; p < 2; ++p) {
                float e = 0.f;
                if (mode == 1) e = -(float)(4 * fq + 2 * n + p) * (LOG2_5E5 / 8.f);
                else if (mode == 2) e = -(float)(16 * (wc & 1) + 4 * fq + 2 * n + p) * (LOG2_1E4 / 32.f);
                else if (mode == 3) e = -(float)(2 * n + p) * (LOG2_5E5 / 4.f);
                inv[n][p] = exp2f(e);
            }
        if (mode == 1) lane_act = act && ((wc & 1) == 0) && (fq < 2);
        else if (mode == 2) lane_act = act;
        else if (mode == 3) lane_act = act && (fq == 0);
        const int row0 = u.pm * 256 + wr * 64 + fr;
        const int col0 = pn * 256 + wc * 32 + 8 * fq;
#pragma unroll
        for (int ai = 0; ai < 2; ++ai)
#pragma unroll
            for (int m = 0; m < 4; ++m) {
                const int row = row0 + ai * 128 + m * 16;
                float cs[2][2], sn[2][2];
                if (lane_act) {
                    const float pf = (float)pos[row];
#pragma unroll
                    for (int n = 0; n < 2; ++n)
#pragma unroll
                        for (int p = 0; p < 2; ++p) {
                            const float ang = pf * inv[n][p];
                            const float rv = __builtin_fmaf(ang, INV2PI, -__builtin_rintf(ang * INV2PI));
                            sn[n][p] = __builtin_amdgcn_sinf(rv); cs[n][p] = __builtin_amdgcn_cosf(rv);
                        }
                } else {
#pragma unroll
                    for (int n = 0; n < 2; ++n)
#pragma unroll
                        for (int p = 0; p < 2; ++p) { sn[n][p] = 0.f; cs[n][p] = 1.f; }
                }

#pragma unroll
                for (int bj = 0; bj < 2; ++bj) {
                    const float sc = bj ? sc1 : sc0;
                    pg8::f32x4 v0 = acc[ai][bj][m][0], v1 = acc[ai][bj][m][1];
                    float o[8];
                    o[0] = v0[0] * cs[0][0] - v0[1] * sn[0][0]; o[1] = v0[0] * sn[0][0] + v0[1] * cs[0][0];
                    o[2] = v0[2] * cs[0][1] - v0[3] * sn[0][1]; o[3] = v0[2] * sn[0][1] + v0[3] * cs[0][1];
                    o[4] = v1[0] * cs[1][0] - v1[1] * sn[1][0]; o[5] = v1[0] * sn[1][0] + v1[1] * cs[1][0];
                    o[6] = v1[2] * cs[1][1] - v1[3] * sn[1][1]; o[7] = v1[2] * sn[1][1] + v1[3] * cs[1][1];
                    u32x4 w; w.x = cvtpk(o[0] * sc, o[1] * sc); w.y = cvtpk(o[2] * sc, o[3] * sc); w.z = cvtpk(o[4] * sc, o[5] * sc); w.w = cvtpk(o[6] * sc, o[7] * sc);
                    *(u32x4*)(O + PX((size_t)row, col0 + bj * 128)) = w;
                    if (bj == 1 && pn == 1 && wc < 2)
                        *(u32x4*)(KIP + (size_t)(row >> 5) * 2048 + ((4 * wc + fq) * 32 + (row & 31)) * 8) = w;
                }
                asm volatile("" ::: "memory");
            }
    }
};
struct EpiY2 {
    static constexpr bool PERM = true, AFTER_DRAIN = false;
    bf16* O; float* SS; float osc;
    __device__ __forceinline__ void operator()(const pg8::f32x4 (&acc)[2][2][4][2], const pg8::Unit& u, int wr, int wc, int fr, int fq) const {
        const int row0 = u.pm * 256 + wr * 64 + fr, col0 = u.pn * 256 + wc * 32 + 8 * fq;
#pragma unroll
        for (int ai = 0; ai < 2; ++ai)
#pragma unroll
            for (int m = 0; m < 4; ++m) {
                const int row = row0 + ai * 128 + m * 16; float ss = 0.f;
                bf16* rowp = O + (size_t)row * D + col0;
#pragma unroll
                for (int bj = 0; bj < 2; ++bj) {
                    const pg8::f32x4 v0 = acc[ai][bj][m][0] * osc, v1 = acc[ai][bj][m][1] * osc;
                    ss += (v0[0] * v0[0] + v0[1] * v0[1]) + (v0[2] * v0[2] + v0[3] * v0[3]) + (v1[0] * v1[0] + v1[1] * v1[1]) + (v1[2] * v1[2] + v1[3] * v1[3]);
                    u32x4 w; w.x = cvtpk(v0[0], v0[1]); w.y = cvtpk(v0[2], v0[3]); w.z = cvtpk(v1[0], v1[1]); w.w = cvtpk(v1[2], v1[3]);
                    *(u32x4*)(rowp + bj * 128) = w;
                }
                ss += swz_xor<16>(ss); ss = half_sum(ss);
                if (fq == 0) SS[(size_t)row * 16 + u.pn * 4 + wc] = ss;
            }
    }
};
constexpr float U_SCALE = 4.f, W2_SCALE = 256.f;
__device__ __forceinline__ unsigned pk4_fp8(float a, float b, float c, float d) {
    int w = __builtin_amdgcn_cvt_pk_fp8_f32(a, b, 0, false); w = __builtin_amdgcn_cvt_pk_fp8_f32(c, d, w, true); return (unsigned)w;
}
struct EpiRelu2F8 {
    static constexpr bool PERM = true, AFTER_DRAIN = false;
    unsigned char* O;
    __device__ __forceinline__ void operator()(const pg8::f32x4 (&acc)[2][2][4][2], const pg8::Unit& u, int wr, int wc, int fr, int fq) const {
        const int row0 = u.pm * 256 + wr * 64 + fr, col0 = u.pn * 256 + wc * 32 + 8 * fq;
#pragma unroll
        for (int ai = 0; ai < 2; ++ai)
#pragma unroll
            for (int m = 0; m < 4; ++m) {
                unsigned char* rowp = O + (size_t)(row0 + ai * 128 + m * 16) * FF + col0;
#pragma unroll
                for (int bj = 0; bj < 2; ++bj) {
                    pg8::f32x4 v0 = acc[ai][bj][m][0], v1 = acc[ai][bj][m][1];
#pragma unroll
                    for (int j = 0; j < 4; ++j) { const float a = fmaxf(v0[j], 0.f), b = fmaxf(v1[j], 0.f); v0[j] = fminf(a * a * U_SCALE, 448.f); v1[j] = fminf(b * b * U_SCALE, 448.f); }
                    u32x2 w; w.x = pk4_fp8(v0[0], v0[1], v0[2], v0[3]); w.y = pk4_fp8(v1[0], v1[1], v1[2], v1[3]);
                    *(u32x2*)(rowp + bj * 128) = w;
                }
            }
    }
};
struct EpiRelu2I8 {
    static constexpr bool PERM = true, AFTER_DRAIN = false;
    unsigned char* O; const float* HS; const unsigned* WMAX;
    __device__ __forceinline__ void operator()(const pg8::f32x4 (&acc)[2][2][4][2], const pg8::Unit& u, int wr, int wc, int fr, int fq) const {
        const int row0 = u.pm * 256 + wr * 64 + fr, col0 = u.pn * 256 + wc * 32 + 8 * fq;
        const float sw = __uint_as_float(*WMAX) * (1.f / 127.f);
        float rs[2][4];
#pragma unroll
        for (int ai = 0; ai < 2; ++ai)
#pragma unroll
            for (int m = 0; m < 4; ++m) rs[ai][m] = HS[row0 + ai * 128 + m * 16];
#pragma unroll
        for (int ai = 0; ai < 2; ++ai)
#pragma unroll
            for (int m = 0; m < 4; ++m) {
                unsigned char* rowp = O + (size_t)(row0 + ai * 128 + m * 16) * FF + col0;
                const float sc = rs[ai][m] * sw;
#pragma unroll
                for (int bj = 0; bj < 2; ++bj) {
                    const pg8::f32x4 a0 = acc[ai][bj][m][0], a1 = acc[ai][bj][m][1];
                    float v0[4], v1[4];
#pragma unroll
                    for (int j = 0; j < 4; ++j) { const float a = fmaxf((float)__float_as_int(a0[j]) * sc, 0.f), b = fmaxf((float)__float_as_int(a1[j]) * sc, 0.f); v0[j] = fminf(a * a * U_SCALE, 448.f); v1[j] = fminf(b * b * U_SCALE, 448.f); }
                    u32x2 w; w.x = pk4_fp8(v0[0], v0[1], v0[2], v0[3]); w.y = pk4_fp8(v1[0], v1[1], v1[2], v1[3]);
                    *(u32x2*)(rowp + bj * 128) = w;
                }
            }
    }
};
struct EpiRelu2 {
    static constexpr bool PERM = true, AFTER_DRAIN = false;
    bf16* O;
    __device__ __forceinline__ void operator()(const pg8::f32x4 (&acc)[2][2][4][2], const pg8::Unit& u, int wr, int wc, int fr, int fq) const {
        const int row0 = u.pm * 256 + wr * 64 + fr, col0 = u.pn * 256 + wc * 32 + 8 * fq;
#pragma unroll
        for (int ai = 0; ai < 2; ++ai)
#pragma unroll
            for (int m = 0; m < 4; ++m) {
                bf16* rowp = O + (size_t)(row0 + ai * 128 + m * 16) * FF + col0;
#pragma unroll
                for (int bj = 0; bj < 2; ++bj) {
                    pg8::f32x4 v0 = acc[ai][bj][m][0], v1 = acc[ai][bj][m][1];
#pragma unroll
                    for (int j = 0; j < 4; ++j) { const float a = fmaxf(v0[j], 0.f), b = fmaxf(v1[j], 0.f); v0[j] = a * a; v1[j] = b * b; }
                    u32x4 w; w.x = cvtpk(v0[0], v0[1]); w.y = cvtpk(v0[2], v0[3]); w.z = cvtpk(v1[0], v1[1]); w.w = cvtpk(v1[2], v1[3]);
                    *(u32x4*)(rowp + bj * 128) = w;
                }
            }
    }
};

__device__ __forceinline__ int map_rope(int j, int R) { return (j < R) ? ((j >> 1) + (j & 1) * (R >> 1)) : j; }
__device__ __forceinline__ int win_src(int n) {
    if (n < 256) return (n >> 6) * 64 + map_rope(n & 63, 16);
    if (n < 320) return 256 + map_rope(n - 256, 16);
    if (n < 384) return 320 + (n - 320);
    if (n < 448) return 896 + map_rope(n - 384, 16);
    if (n < 464) return 2504 + (n - 448);
    if (n < 472) return 960 + (n - 464);
    if (n < 512) return -1;
    if (n < 1024) { const int m = n - 512; return 384 + (m >> 6) * 64 + map_rope(m & 63, 16); }
    if (n < 1280) { const int m = n - 1024; return 968 + (m >> 6) * 64 + map_rope(m & 63, 64); }
    if (n < 1536) { const int m = n - 1280; return 1224 + (m >> 6) * 64 + map_rope(m & 63, 64); }
    if (n < 1792) return 1480 + (n - 1536);
    if (n < 2048) return 1736 + (n - 1792);
    if (n < 2176) return 1992 + (n - 2048);
    if (n < 2304) return 2120 + (n - 2176);
    if (n < 2560) return 2248 + (n - 2304);
    if (n < 2816) return 2520 + (n - 2560);
    if (n < 3072) { const int m = n - 2816; return 2776 + (m >> 5) * 32 + map_rope(m & 31, 8); }
    if (n < 3328) { const int m = n - 3072; return 3032 + (m >> 5) * 32 + map_rope(m & 31, 8); }
    return 3288 + (n - 3328);
}
template <bool PERMUTE>
__device__ __forceinline__ void transpose_item(const float* W, int K, int Nsrc, int Nout, bf16* WT, LAS float* scr, int item, int lane) {
    const int nblk = Nout / 32, kb = item / nblk, nb = item % nblk, k0 = 64 * kb, n0 = 32 * nb;
    const int nn = n0 + (lane & 31); const int src = PERMUTE ? win_src(nn) : nn;
#pragma unroll 8
    for (int i = 0; i < 32; ++i) { const int kk = 2 * i + (lane >> 5); scr[kk * 33 + (lane & 31)] = (src >= 0) ? W[(size_t)(k0 + kk) * Nsrc + src] : 0.f; }
    LDS_FENCE();
    const int c = lane & 7;
#pragma unroll
    for (int j = 0; j < 4; ++j) { const int n = (lane >> 3) + 8 * j; const LAS float* s = scr + (8 * c) * 33 + n;
        u32x4 o; o.x = cvtpk(s[0 * 33], s[1 * 33]); o.y = cvtpk(s[2 * 33], s[3 * 33]); o.z = cvtpk(s[4 * 33], s[5 * 33]); o.w = cvtpk(s[6 * 33], s[7 * 33]);
        *(u32x4*)(WT + (size_t)(n0 + n) * K + k0 + 8 * c) = o; }
    LDS_FENCE();
}

__device__ __forceinline__ void transpose_item_i8(const float* W, int K, int N, unsigned char* WT, LAS float* scr, int item, int lane, float inv) {
    const int nblk = N / 32, kb = item / nblk, nb = item % nblk, k0 = 64 * kb, n0 = 32 * nb;
#pragma unroll 8
    for (int i = 0; i < 32; ++i) { const int kk = 2 * i + (lane >> 5); scr[kk * 33 + (lane & 31)] = W[(size_t)(k0 + kk) * N + n0 + (lane & 31)]; }
    LDS_FENCE();
    const int c = lane & 7;
#pragma unroll
    for (int j = 0; j < 4; ++j) { const int n = (lane >> 3) + 8 * j; const LAS float* s = scr + (8 * c) * 33 + n;
        unsigned o[2];
#pragma unroll
        for (int hwd = 0; hwd < 2; ++hwd) {
            const int q0 = (int)__builtin_rintf(s[(4 * hwd + 0) * 33] * inv), q1 = (int)__builtin_rintf(s[(4 * hwd + 1) * 33] * inv), q2 = (int)__builtin_rintf(s[(4 * hwd + 2) * 33] * inv), q3 = (int)__builtin_rintf(s[(4 * hwd + 3) * 33] * inv);
            o[hwd] = (unsigned)(q0 & 255) | ((unsigned)(q1 & 255) << 8) | ((unsigned)(q2 & 255) << 16) | ((unsigned)q3 << 24);
        }
        u32x2 ov; ov.x = o[0]; ov.y = o[1];
        *(u32x2*)(WT + (size_t)(n0 + n) * K + k0 + 8 * c) = ov; }
    LDS_FENCE();
}
__device__ __forceinline__ void transpose_item_f8(const float* W, int K, int N, unsigned char* WT, LAS float* scr, int item, int lane) {
    const int nblk = N / 32, kb = item / nblk, nb = item % nblk, k0 = 64 * kb, n0 = 32 * nb;
#pragma unroll 8
    for (int i = 0; i < 32; ++i) { const int kk = 2 * i + (lane >> 5); scr[kk * 33 + (lane & 31)] = W[(size_t)(k0 + kk) * N + n0 + (lane & 31)]; }
    LDS_FENCE();
    const int c = lane & 7;
#pragma unroll
    for (int j = 0; j < 4; ++j) { const int n = (lane >> 3) + 8 * j; const LAS float* s = scr + (8 * c) * 33 + n;
        float v[8];
#pragma unroll
        for (int e = 0; e < 8; ++e) v[e] = fminf(fmaxf(s[e * 33] * W2_SCALE, -448.f), 448.f);
        u32x2 o; o.x = pk4_fp8(v[0], v[1], v[2], v[3]); o.y = pk4_fp8(v[4], v[5], v[6], v[7]);
        *(u32x2*)(WT + (size_t)(n0 + n) * K + k0 + 8 * c) = o; }
    LDS_FENCE();
}

#ifndef ROWS_IN_FLIGHT
#define ROWS_IN_FLIGHT 2
#endif
__device__ __forceinline__ size_t x1_off(int m) { return (size_t)(m & (M / 2 - 1)) * D; }
__device__ __forceinline__ float wave_max(float v) {
    v = fmaxf(v, swz_xor<1>(v)); v = fmaxf(v, swz_xor<2>(v)); v = fmaxf(v, swz_xor<4>(v)); v = fmaxf(v, swz_xor<8>(v)); v = fmaxf(v, swz_xor<16>(v));
    return half_max(v);
}
template <bool HAS_RES, bool DO_H, bool XIN_BF, bool XOUT_BF, bool H_I8 = false>
__device__ __forceinline__ void rowpass(const float* xin, float* xout, bf16* xa, bf16* xb, const bf16* y2, const float* ss, const float* gpost, const float* gate,
                                        const float* gpre, const float* scale, const float* shift, bf16* hout, int gw, int ngw, int lane, float* hs = nullptr) {
    constexpr int NR = ROWS_IN_FLIGHT;
    const int wpb = ngw / BATCH;
    if (wpb * BATCH != ngw || wpb == 0) return;
    const int b = gw / wpb, j0 = gw - b * wpb;
    f32x4 gpo[4], gat[4], gpr[4], scl[4], shf[4];
#pragma unroll
    for (int j = 0; j < 4; ++j) {
        const int c = 4 * lane + 256 * j;
        if (HAS_RES) { gpo[j] = *(const f32x4*)(gpost + c); gat[j] = *(const f32x4*)(gate + (size_t)b * 6144 + c); }
        if (DO_H) { gpr[j] = *(const f32x4*)(gpre + c); scl[j] = *(const f32x4*)(scale + (size_t)b * 6144 + c) + 1.0f; shf[j] = *(const f32x4*)(shift + (size_t)b * 6144 + c); }
    }
    for (int r0 = j0; r0 < T; r0 += NR * wpb) {
        int mm[NR]; bool live[NR];
#pragma unroll
        for (int u = 0; u < NR; ++u) { live[u] = (u == 0) || (r0 + u * wpb < T); mm[u] = b * T + (live[u] ? r0 + u * wpb : r0); }
        f32x4 v[NR][4]; float rstd[NR];
#pragma unroll
        for (int u = 0; u < NR; ++u)
#pragma unroll
            for (int j = 0; j < 4; ++j) {
                if (XIN_BF) { const u32x2 t = *(const u32x2*)((mm[u] < M / 2 ? xa : xb) + x1_off(mm[u]) + 4 * lane + 256 * j); v[u][j] = (f32x4){bflo(t.x), bfhi(t.x), bflo(t.y), bfhi(t.y)}; }
                else v[u][j] = *(const f32x4*)(xin + (size_t)mm[u] * D + 4 * lane + 256 * j);
            }
        if (HAS_RES) {
            u32x2 yy[NR][4];
#pragma unroll
            for (int u = 0; u < NR; ++u) {
                const float* sp = ss + (size_t)mm[u] * 16;
                const f32x4 s0 = *(const f32x4*)(sp), s1 = *(const f32x4*)(sp + 4), s2 = *(const f32x4*)(sp + 8), s3 = *(const f32x4*)(sp + 12);
                const float s = ((s0[0] + s0[1]) + (s0[2] + s0[3])) + ((s1[0] + s1[1]) + (s1[2] + s1[3])) + ((s2[0] + s2[1]) + (s2[2] + s2[3])) + ((s3[0] + s3[1]) + (s3[2] + s3[3]));
                rstd[u] = 1.0f / sqrtf(s * (1.f / D) + EPS);
#pragma unroll
                for (int j = 0; j < 4; ++j) yy[u][j] = *(const u32x2*)(y2 + (size_t)mm[u] * D + 4 * lane + 256 * j);
            }
#pragma unroll
            for (int u = 0; u < NR; ++u)
#pragma unroll
                for (int j = 0; j < 4; ++j) {
                    const int c = 4 * lane + 256 * j;
                    const f32x4 yv = {bflo(yy[u][j].x), bfhi(yy[u][j].x), bflo(yy[u][j].y), bfhi(yy[u][j].y)};
                    v[u][j] = v[u][j] + gat[j] * (yv * rstd[u] * gpo[j]);
                    if (live[u]) {
                        if (XOUT_BF) { u32x2 w; w.x = cvtpk(v[u][j][0], v[u][j][1]); w.y = cvtpk(v[u][j][2], v[u][j][3]); *(u32x2*)((mm[u] < M / 2 ? xa : xb) + x1_off(mm[u]) + c) = w; }
                        else *(f32x4*)(xout + (size_t)mm[u] * D + c) = v[u][j];
                    }
                }
        }
        if (DO_H) {
            float q[NR];
#pragma unroll
            for (int u = 0; u < NR; ++u) { q[u] = 0.f;
#pragma unroll
                for (int j = 0; j < 4; ++j) q[u] += (v[u][j][0] * v[u][j][0] + v[u][j][1] * v[u][j][1]) + (v[u][j][2] * v[u][j][2] + v[u][j][3] * v[u][j][3]); }
#pragma unroll
            for (int u = 0; u < NR; ++u) q[u] = wave_sum(q[u]);
#pragma unroll
            for (int u = 0; u < NR; ++u) {
                const float rstd2 = 1.0f / sqrtf(q[u] * (1.f / D) + EPS);
                if (H_I8) {
                    f32x4 hq[4]; float am = 0.f;
#pragma unroll
                    for (int j = 0; j < 4; ++j) { hq[j] = (v[u][j] * rstd2 * gpr[j]) * scl[j] + shf[j]; am = fmaxf(am, fmaxf(fmaxf(fabsf(hq[j][0]), fabsf(hq[j][1])), fmaxf(fabsf(hq[j][2]), fabsf(hq[j][3])))); }
                    am = fmaxf(wave_max(am), 1.0e-20f);
                    const float inv = 127.f / am;
                    unsigned char* hb = (unsigned char*)hout + (size_t)mm[u] * D + 4 * lane;
#pragma unroll
                    for (int j = 0; j < 4; ++j) {
                        const int q0 = (int)__builtin_rintf(hq[j][0] * inv), q1 = (int)__builtin_rintf(hq[j][1] * inv), q2 = (int)__builtin_rintf(hq[j][2] * inv), q3 = (int)__builtin_rintf(hq[j][3] * inv);
                        const unsigned w = (unsigned)(q0 & 255) | ((unsigned)(q1 & 255) << 8) | ((unsigned)(q2 & 255) << 16) | ((unsigned)q3 << 24);
                        if (live[u]) *(unsigned*)(hb + 256 * j) = w;
                    }
                    if (live[u] && lane == 0) hs[mm[u]] = am * (1.f / 127.f);
                } else {
#pragma unroll
                for (int j = 0; j < 4; ++j) {
                    const int c = 4 * lane + 256 * j;
                    const f32x4 h = (v[u][j] * rstd2 * gpr[j]) * scl[j] + shf[j];
                    u32x2 w; w.x = cvtpk(h[0], h[1]); w.y = cvtpk(h[2], h[3]);
                    if (live[u]) *(u32x2*)(hout + (size_t)mm[u] * D + c) = w;
                }
                }
            }
        }
    }
}

__device__ __forceinline__ void store_pair16(const u32x2 a, const u32x2 b, bf16* p) {
    const auto r0 = __builtin_amdgcn_permlane32_swap(a.x, b.x, false, false), r1 = __builtin_amdgcn_permlane32_swap(a.y, b.y, false, false);
    u32x4 o; o.x = r0[0]; o.y = r1[0]; o.z = r0[1]; o.w = r1[1];
    *(u32x4*)p = o;
}
__device__ __forceinline__ void load_rows16(const bf16* p, int hh, u32x4 (&raw)[4]) {
#pragma unroll
    for (int me = 0; me < 2; ++me)
#pragma unroll
        for (int gp = 0; gp < 4; gp += 2) raw[me * 2 + (gp >> 1)] = *(const u32x4*)(p + (4 * me + gp + hh) * PXC);
}
__device__ __forceinline__ void unpack_pair16(const u32x4 raw, u32x2& ga, u32x2& gb) {
    const auto r0 = __builtin_amdgcn_permlane32_swap(raw.x, raw.z, false, false), r1 = __builtin_amdgcn_permlane32_swap(raw.y, raw.w, false, false);
    ga.x = r0[0]; ga.y = r1[0]; gb.x = r0[1]; gb.y = r1[1];
}
__device__ __forceinline__ void load_gains(const float* gptr, int hh, f32x4 (&gain)[8]) {
#pragma unroll
    for (int me = 0; me < 2; ++me)
#pragma unroll
        for (int g = 0; g < 4; ++g) gain[me * 4 + g] = *(const f32x4*)(gptr + 32 * me + 8 * g + 4 * hh);
}
template <bool GATE, bool FASTSILU>
__device__ __forceinline__ void headnorm_pair(const f32x16& resme, int me, int gp, int hh, float rstd, const f32x4 (&gain)[8], const u32x4 graw, bf16* outp) {
    u32x2 ga, gb, w[2];
    if (GATE) unpack_pair16(graw, ga, gb);
#pragma unroll
    for (int k = 0; k < 2; ++k) {
        const int g = gp + k;
        const f32x4 gv = gain[me * 4 + g];
        float o[4];
#pragma unroll
        for (int j = 0; j < 4; ++j) o[j] = resme[4 * g + j] * rstd * gv[j];
        if (GATE) {
            const u32x2 gg = k ? gb : ga;
            const float z[4] = {bflo(gg.x), bfhi(gg.x), bflo(gg.y), bfhi(gg.y)};
#pragma unroll
            for (int j = 0; j < 4; ++j) o[j] *= FASTSILU ? z[j] * __builtin_amdgcn_rcpf(1.f + __builtin_amdgcn_exp2f(-z[j] * LOG2E)) : z[j] / (1.f + __expf(-z[j]));
        }
        w[k].x = cvtpk(o[0], o[1]); w[k].y = cvtpk(o[2], o[3]);
    }
    store_pair16(w[0], w[1], outp + 32 * me + 8 * gp + 8 * hh);
}
template <bool CENTER, bool GATE>
__device__ __forceinline__ void headnorm_store(f32x16 (&res)[2], int hh_in, const float* gptr, const bf16* gateptr, float oscale, bf16* outp) {
    int hh = hh_in; asm volatile("" : "+v"(hh));
    f32x4 gain[8]; load_gains(gptr, hh, gain);
    u32x4 graw[4];
    if (GATE) load_rows16(gateptr, hh, graw);
    if (CENTER) {
        float s = 0.f;
#pragma unroll
        for (int me = 0; me < 2; ++me)
#pragma unroll
            for (int i = 0; i < 16; ++i) s += res[me][i];
        s = half_sum(s);
        const float mean = s * (1.f / 64.f);
#pragma unroll
        for (int me = 0; me < 2; ++me)
#pragma unroll
            for (int i = 0; i < 16; ++i) res[me][i] -= mean;
    }
    float q = 0.f;
#pragma unroll
    for (int me = 0; me < 2; ++me)
#pragma unroll
        for (int i = 0; i < 16; ++i) q += res[me][i] * res[me][i];
    q = half_sum(q);
    const float rstd = oscale / sqrtf(q * (1.f / 64.f) + EPS);
#pragma unroll
    for (int me = 0; me < 2; ++me)
#pragma unroll
        for (int gp = 0; gp < 4; gp += 2) headnorm_pair<GATE, false>(res[me], me, gp, hh, rstd, gain, GATE ? graw[me * 2 + (gp >> 1)] : (u32x4){0u, 0u, 0u, 0u}, outp);
}

#ifndef ATTN_PREFETCH
#define ATTN_PREFETCH 1
#endif
#ifndef ATTN_SB
#define ATTN_SB 0
#endif
template <bool CENTER>
__device__ __forceinline__ void headnorm_store_g(f32x16 (&res)[2], int hh_in, const float* gptr, const u32x4 (&graw)[4], float oscale, bf16* outp) {
    int hh = hh_in; asm volatile("" : "+v"(hh));
    f32x4 gain[8]; load_gains(gptr, hh, gain);
    if (CENTER) {
        float s = 0.f;
#pragma unroll
        for (int me = 0; me < 2; ++me)
#pragma unroll
            for (int i = 0; i < 16; ++i) s += res[me][i];
        s = half_sum(s);
        const float mean = s * (1.f / 64.f);
#pragma unroll
        for (int me = 0; me < 2; ++me)
#pragma unroll
            for (int i = 0; i < 16; ++i) res[me][i] -= mean;
    }
    float q = 0.f;
#pragma unroll
    for (int me = 0; me < 2; ++me)
#pragma unroll
        for (int i = 0; i < 16; ++i) q += res[me][i] * res[me][i];
    q = half_sum(q);
    const float rstd = oscale / sqrtf(q * (1.f / 64.f) + EPS);
#pragma unroll
    for (int me = 0; me < 2; ++me)
#pragma unroll
        for (int gp = 0; gp < 4; gp += 2) headnorm_pair<true, true>(res[me], me, gp, hh, rstd, gain, graw[me * 2 + (gp >> 1)], outp);
}

constexpr int ATTN_BUF = 64 * 144 + 8192;
template <int NC, int DK, bool MASKED>
__device__ __forceinline__ void attn_core(LAS unsigned char* lds, const bf16* kbase, const bf16* vbase, const bf16* qrow, int nt_block, int nt_wave,
                                          const u64* mrow, f32x16 (&o)[NC][2], float (&lsum)[NC], int tid, int lane) {
    static_assert((NC == 2 && !MASKED) || (NC == 1 && MASKED), "two maps unmasked (differential) or one map masked (DSA)");
    constexpr int KST = DK / 16;
    constexpr float THR = 14.f;
    const int r = lane & 31, hh = lane >> 5;
    bf16x8 qf[NC][KST];
#pragma unroll
    for (int cc = 0; cc < NC; ++cc)
#pragma unroll
        for (int s = 0; s < KST; ++s) qf[cc][s] = ldg16(qrow + ((cc * DK + 16 * s) / 8 + hh) * PXC);
    float negm[NC];
#pragma unroll
    for (int cc = 0; cc < NC; ++cc) { negm[cc] = 0.f; lsum[cc] = 0.f; o[cc][0] = zero16(); o[cc][1] = zero16(); }
    const int krow_ = tid >> 3, kch = tid & 7;
    const int ksw = krow_ * 144 + kch * 16, vsw = 64 * 144 + (kch >> 2) * 4096 + krow_ * 64 + (kch & 3) * 16;
    const int kfo = r * 144 + hh * 16;
    const int vto = (int)(tr_base_perm(lds + 64 * 144, lane) - lds);
    const bf16* kp = kbase + (kch * 64 + krow_) * 8; const bf16* vp = vbase + (kch * 64 + krow_) * 8;
    bf16x8 kreg = ldg16(kp), vreg = ldg16(vp);
    *(LAS bf16x8*)(lds + ksw) = kreg; *(LAS bf16x8*)(lds + vsw) = vreg;
    if (nt_block > 1) { kreg = ldg16(kp + PX_TILE_STRIDE); vreg = ldg16(vp + PX_TILE_STRIDE); }
    __syncthreads();
    for (int t = 0; t < nt_block; ++t) {
        LAS unsigned char* const buf = lds + (t & 1) * ATTN_BUF;
        if (t < nt_wave) {
            const LAS unsigned char* const kfb = buf + kfo; const LAS unsigned char* const vtb = buf + vto;
            if constexpr (NC == 2) {
                bf16x8 vf[2][4];
                vf[0][0] = ld_tr_perm<0, 0>(vtb); vf[0][1] = ld_tr_perm<0, 16>(vtb); vf[0][2] = ld_tr_perm<0, 32>(vtb); vf[0][3] = ld_tr_perm<0, 48>(vtb);
                vf[1][0] = ld_tr_perm<1, 0>(vtb); vf[1][1] = ld_tr_perm<1, 16>(vtb); vf[1][2] = ld_tr_perm<1, 32>(vtb); vf[1][3] = ld_tr_perm<1, 48>(vtb);
                f32x16 sa[2][2];
                if (__builtin_amdgcn_ballot_w64(negm[0] != 0.f || negm[1] != 0.f) == 0ull) {
#pragma unroll
                    for (int cc = 0; cc < 2; ++cc)
#pragma unroll
                        for (int kt = 0; kt < 2; ++kt) {
                            sa[cc][kt] = mfma32(*(const LAS bf16x8*)(kfb + (32 * kt * 144 + (cc * DK) * 2)), qf[cc][0], zero16());
#pragma unroll
                            for (int s = 1; s < KST; ++s) sa[cc][kt] = mfma32(*(const LAS bf16x8*)(kfb + (32 * kt * 144 + (cc * DK + 16 * s) * 2)), qf[cc][s], sa[cc][kt]);
                        }
                } else {
#pragma unroll
                    for (int cc = 0; cc < 2; ++cc)
#pragma unroll
                        for (int kt = 0; kt < 2; ++kt) {
                            f32x16 c0;
#pragma unroll
                            for (int i = 0; i < 16; ++i) c0[i] = negm[cc];
                            sa[cc][kt] = mfma32(*(const LAS bf16x8*)(kfb + (32 * kt * 144 + (cc * DK) * 2)), qf[cc][0], c0);
#pragma unroll
                            for (int s = 1; s < KST; ++s) sa[cc][kt] = mfma32(*(const LAS bf16x8*)(kfb + (32 * kt * 144 + (cc * DK + 16 * s) * 2)), qf[cc][s], sa[cc][kt]);
                        }
                }
#pragma unroll
                for (int cc = 0; cc < 2; ++cc) {
                    float tmax = sa[cc][0][0];
#pragma unroll
                    for (int i = 1; i < 16; ++i) tmax = fmaxf(tmax, sa[cc][0][i]);
#pragma unroll
                    for (int i = 0; i < 16; ++i) tmax = fmaxf(tmax, sa[cc][1][i]);
                    if (__builtin_amdgcn_ballot_w64(tmax > THR || (t == 0 && tmax < -24.f)) != 0ull) {
                        const float hm = half_max(tmax);
                        tmax = (hm > THR) ? hm : ((t == 0 && hm < -24.f) ? fmaxf(hm, -64.f) : 0.f);
                        const float alpha = __builtin_amdgcn_exp2f(-tmax);
                        negm[cc] -= tmax; lsum[cc] *= alpha;
#pragma unroll
                        for (int i = 0; i < 16; ++i) { o[cc][0][i] *= alpha; o[cc][1][i] *= alpha; sa[cc][0][i] -= tmax; sa[cc][1][i] -= tmax; }
                    }
                    float ps = 0.f;
#pragma unroll
                    for (int kt = 0; kt < 2; ++kt)
#pragma unroll
                        for (int i = 0; i < 16; ++i) { const float p = __builtin_amdgcn_exp2f(sa[cc][kt][i]); sa[cc][kt][i] = p; ps += p; }
                    lsum[cc] += ps;
                    const bf16x8 p00 = pack8<0>(sa[cc][0]), p01 = pack8<1>(sa[cc][0]), p10 = pack8<0>(sa[cc][1]), p11 = pack8<1>(sa[cc][1]);
                    o[cc][0] = mfma32(vf[0][0], p00, o[cc][0]); o[cc][0] = mfma32(vf[0][1], p01, o[cc][0]);
                    o[cc][0] = mfma32(vf[0][2], p10, o[cc][0]); o[cc][0] = mfma32(vf[0][3], p11, o[cc][0]);
                    o[cc][1] = mfma32(vf[1][0], p00, o[cc][1]); o[cc][1] = mfma32(vf[1][1], p01, o[cc][1]);
                    o[cc][1] = mfma32(vf[1][2], p10, o[cc][1]); o[cc][1] = mfma32(vf[1][3], p11, o[cc][1]);
                }
            } else {
                const u64 mw = mrow[t];
                bf16x8 vf[2][4];
                vf[0][0] = ld_tr_perm<0, 0>(vtb); vf[0][1] = ld_tr_perm<0, 16>(vtb); vf[0][2] = ld_tr_perm<0, 32>(vtb); vf[0][3] = ld_tr_perm<0, 48>(vtb);
                vf[1][0] = ld_tr_perm<1, 0>(vtb); vf[1][1] = ld_tr_perm<1, 16>(vtb); vf[1][2] = ld_tr_perm<1, 32>(vtb); vf[1][3] = ld_tr_perm<1, 48>(vtb);
                f32x16 sa[2];
#pragma unroll
                for (int kt = 0; kt < 2; ++kt) {
                    const unsigned m32 = (unsigned)(mw >> (32 * kt + 4 * hh));
#pragma unroll
                    for (int i = 0; i < 16; ++i) {
                        const int sel = __builtin_amdgcn_sbfe((int)m32, (i & 3) + 8 * (i >> 2), 1);
                        sa[kt][i] = __int_as_float((sel & __float_as_int(negm[0])) | (~sel & (int)0xF149F2CAu));
                    }
#pragma unroll
                    for (int s = 0; s < KST; ++s) sa[kt] = mfma32(*(const LAS bf16x8*)(kfb + (32 * kt * 144 + (16 * s) * 2)), qf[0][s], sa[kt]);
                }
#pragma unroll
                for (int kt = 0; kt < 2; ++kt) {
                    float tmax = sa[kt][0];
#pragma unroll
                    for (int i = 1; i < 16; ++i) tmax = fmaxf(tmax, sa[kt][i]);
                    if ((t == 0 && kt == 0) || __builtin_amdgcn_ballot_w64(tmax > THR) != 0ull) {
                        tmax = fmaxf(half_max(tmax), (t == 0 && kt == 0) ? -64.f : 0.f);
                        const float alpha = __builtin_amdgcn_exp2f(-tmax);
                        negm[0] -= tmax; lsum[0] *= alpha;
#pragma unroll
                        for (int i = 0; i < 16; ++i) { o[0][0][i] *= alpha; o[0][1][i] *= alpha; sa[kt][i] -= tmax; if (kt == 0) sa[1][i] -= tmax; }
                    }
                    float ps = 0.f;
#pragma unroll
                    for (int i = 0; i < 16; ++i) { const float p = __builtin_amdgcn_exp2f(sa[kt][i]); sa[kt][i] = p; ps += p; }
                    lsum[0] += ps;
                    const bf16x8 p0 = pack8<0>(sa[kt]), p1 = pack8<1>(sa[kt]);
                    o[0][0] = mfma32(vf[0][2 * kt], p0, o[0][0]); o[0][0] = mfma32(vf[0][2 * kt + 1], p1, o[0][0]);
                    o[0][1] = mfma32(vf[1][2 * kt], p0, o[0][1]); o[0][1] = mfma32(vf[1][2 * kt + 1], p1, o[0][1]);
                }
            }
        }
        if (t + 1 < nt_block) {
            LAS unsigned char* const nb = lds + ((t + 1) & 1) * ATTN_BUF;
            *(LAS bf16x8*)(nb + ksw) = kreg; *(LAS bf16x8*)(nb + vsw) = vreg;
            if (t + 2 < nt_block) { kreg = ldg16(kp + (size_t)(t + 2) * PX_TILE_STRIDE); vreg = ldg16(vp + (size_t)(t + 2) * PX_TILE_STRIDE); }
        }
        __syncthreads();
    }
}

__device__ __forceinline__ void diff_unit(LAS unsigned char* lds, const bf16* proj, bf16* Y, const float* hng, float lam, float lam_init, int b, int h, int qb, int tid, int lane, int wave) {
    const int q0 = 256 * qb, qtok = q0 + 32 * wave + (lane & 31), hh = lane >> 5;
    const size_t tokrow = (size_t)b * T + qtok;
    f32x16 o[2][2]; float ls[2];
    const int nt_block = (q0 + 256) / 64, nt_wave = ((q0 + 32 * wave) >> 6) + 1;
    attn_core<2, 32, false>(lds, proj + PX((size_t)b * T, COL_DK + h * 64), proj + PX((size_t)b * T, COL_DV + h * 64), proj + PX(tokrow, COL_DQ + h * 64), nt_block, nt_wave, nullptr, o, ls, tid, lane);
    const float l0 = half_sum(ls[0]), l1 = half_sum(ls[1]);
    const float i0 = 1.f / l0, i1 = lam / l1;
    f32x16 res[2];
#pragma unroll
    for (int me = 0; me < 2; ++me)
#pragma unroll
        for (int i = 0; i < 16; ++i) res[me][i] = o[0][me][i] * i0 - o[1][me][i] * i1;
    headnorm_store<false, false>(res, hh, hng + 768 + h * 64, nullptr, 1.f - lam_init, Y + tokrow * D + 768 + h * 64);
}
__device__ __forceinline__ void dsa_unit(LAS unsigned char* lds, const bf16* proj, const u64* mask, bf16* Y, const float* hng, int b, int qc, int tid, int lane, int wave) {
    const int head = wave >> 1, qtok = 64 * qc + 32 * (wave & 1) + (lane & 31), hh = lane >> 5;
    const size_t tokrow = (size_t)b * T + qtok;
    f32x16 o[1][2]; float ls[1];
    attn_core<1, 64, true>(lds, proj + PX((size_t)b * T, COL_AK), proj + PX((size_t)b * T, COL_AV), proj + PX(tokrow, COL_AQ + head * 64), qc + 1, qc + 1, mask + tokrow * 64, o, ls, tid, lane);
    const float l0 = half_sum(ls[0]), i0 = 1.f / l0;
    f32x16 res[2];
#pragma unroll
    for (int me = 0; me < 2; ++me)
#pragma unroll
        for (int i = 0; i < 16; ++i) res[me][i] = o[0][me][i] * i0;
    headnorm_store<false, false>(res, hh, hng + head * 64, nullptr, 1.f, Y + tokrow * D + head * 64);
}
#ifndef REP_IDX_MM
#define REP_IDX_MM 1
#endif
__device__ __forceinline__ void count8(int& acc0, int& acc1, float k0, float k1, float k2, float k3, float k4, float k5, float k6, float k7, float cand) {
    unsigned long long m0, m1, m2, m3, m4, m5, m6, m7, dmy;
    asm volatile(
        "v_cmp_ge_f32_e64 %2, %11, %19\n\t"
        "v_cmp_ge_f32_e64 %3, %12, %19\n\t"
        "v_cmp_ge_f32_e64 %4, %13, %19\n\t"
        "v_cmp_ge_f32_e64 %5, %14, %19\n\t"
        "v_cmp_ge_f32_e64 %6, %15, %19\n\t"
        "v_cmp_ge_f32_e64 %7, %16, %19\n\t"
        "v_cmp_ge_f32_e64 %8, %17, %19\n\t"
        "v_cmp_ge_f32_e64 %9, %18, %19\n\t"
        "v_addc_co_u32_e64 %0, %10, %0, 0, %2\n\t"
        "v_addc_co_u32_e64 %1, %10, %1, 0, %3\n\t"
        "v_addc_co_u32_e64 %0, %10, %0, 0, %4\n\t"
        "v_addc_co_u32_e64 %1, %10, %1, 0, %5\n\t"
        "v_addc_co_u32_e64 %0, %10, %0, 0, %6\n\t"
        "v_addc_co_u32_e64 %1, %10, %1, 0, %7\n\t"
        "v_addc_co_u32_e64 %0, %10, %0, 0, %8\n\t"
        "v_addc_co_u32_e64 %1, %10, %1, 0, %9"
        : "+v"(acc0), "+v"(acc1), "=&s"(m0), "=&s"(m1), "=&s"(m2), "=&s"(m3), "=&s"(m4), "=&s"(m5), "=&s"(m6), "=&s"(m7), "=&s"(dmy)
        : "v"(k0), "v"(k1), "v"(k2), "v"(k3), "v"(k4), "v"(k5), "v"(k6), "v"(k7), "v"(cand));
}
__device__ __forceinline__ float key_to_float(unsigned k) { return __uint_as_float((k & 0x80000000u) ? (k & 0x7fffffffu) : ~k); }
#define DPP_F(v, ctrl) __int_as_float(__builtin_amdgcn_update_dpp(0, __float_as_int(v), (ctrl), 0xF, 0xF, true))
__device__ __forceinline__ float wave_max_f(float v) {
    v = fmaxf(v, DPP_F(v, 0xB1)); v = fmaxf(v, DPP_F(v, 0x4E)); v = fmaxf(v, DPP_F(v, 0x141)); v = fmaxf(v, DPP_F(v, 0x140));
    const float a = __int_as_float(__builtin_amdgcn_readlane(__float_as_int(v), 0)), b = __int_as_float(__builtin_amdgcn_readlane(__float_as_int(v), 16));
    const float c = __int_as_float(__builtin_amdgcn_readlane(__float_as_int(v), 32)), d = __int_as_float(__builtin_amdgcn_readlane(__float_as_int(v), 48));
    return fmaxf(fmaxf(a, b), fmaxf(c, d));
}
__device__ __forceinline__ float wave_min_f(float v) { return -wave_max_f(-v); }
__device__ __forceinline__ unsigned wave_incl_scan(unsigned v) {
    v += (unsigned)__builtin_amdgcn_update_dpp(0, (int)v, 0x111, 0xF, 0xF, false);
    v += (unsigned)__builtin_amdgcn_update_dpp(0, (int)v, 0x112, 0xF, 0xF, false);
    v += (unsigned)__builtin_amdgcn_update_dpp(0, (int)v, 0x114, 0xF, 0xF, false);
    v += (unsigned)__builtin_amdgcn_update_dpp(0, (int)v, 0x118, 0xF, 0xF, false);
    v += (unsigned)__builtin_amdgcn_update_dpp(0, (int)v, 0x142, 0xA, 0xF, false);
    v += (unsigned)__builtin_amdgcn_update_dpp(0, (int)v, 0x143, 0xC, 0xF, false);
    return v;
}
template <int NG>
__device__ __forceinline__ bool topk_hist(const float (&x)[64], LAS unsigned* H, LAS float* LIST, float& tf, bool& found, int lane) {
    float g0 = x[0], g1 = x[1], g2 = x[2], g3 = x[3];
#pragma unroll
    for (int i = 4; i < 8 * NG; i += 4) { g0 = fmaxf(g0, x[i]); g1 = fmaxf(g1, x[i + 1]); g2 = fmaxf(g2, x[i + 2]); g3 = fmaxf(g3, x[i + 3]); }
    const float hi = wave_max_f(fmaxf(fmaxf(g0, g1), fmaxf(g2, g3))), lo = wave_min_f(fminf(fminf(g0, g1), fminf(g2, g3)));
    if (!(hi > lo) || !(lo > -3.0e38f) || !(hi < 3.0e38f)) return false;
    const float s4 = 16124.f / (hi - lo), hs4 = __builtin_fmaf(hi, s4, 0.25f);
    if (!(s4 < 1.0e30f)) return false;
#pragma unroll
    for (int k = 0; k < 16; ++k) *(LAS u32x4*)(H + 4 * (lane + 64 * k)) = (u32x4){0u, 0u, 0u, 0u};
    const float dummy = (float)(16128 + 4 * lane);
    const unsigned hbase = (unsigned)(__UINTPTR_TYPE__)H;
#pragma unroll
    for (int i = 0; i < 8 * NG; ++i) {
        const float t4 = __builtin_fmaf(x[i], -s4, hs4);
        __hip_atomic_fetch_add((LAS unsigned*)(__UINTPTR_TYPE__)(((unsigned)fminf(t4, dummy) & ~3u) | hbase), 1u, __ATOMIC_RELAXED, __HIP_MEMORY_SCOPE_WORKGROUP);
    }
    LDS_FENCE();
    const LAS unsigned* hp = H + 63 * lane;
    unsigned tot = 0u;
#pragma unroll
    for (int jb = 0; jb < 64; jb += 16) {
        unsigned hv[16];
#pragma unroll
        for (int j = 0; j < 16; ++j) hv[j] = (jb + j < 63) ? hp[jb + j] : 0u;
        __builtin_amdgcn_sched_barrier(0);
#pragma unroll
        for (int j = 0; j < 16; j += 2) tot += hv[j] + hv[j + 1];
        __builtin_amdgcn_sched_barrier(0);
    }
    const unsigned P = wave_incl_scan(tot);
    if (__builtin_amdgcn_readlane((int)P, 63) < 256) return false;
    const int Ls = __builtin_ctzll(__builtin_amdgcn_ballot_w64(P >= 256u));
    const unsigned basec = (unsigned)__builtin_amdgcn_readlane((int)(P - tot), Ls);
    const unsigned h = (lane < 63) ? H[63 * Ls + lane] : 0u;
    const unsigned Q = wave_incl_scan(h);
    const int js = __builtin_ctzll(__builtin_amdgcn_ballot_w64(basec + Q >= 256u));
    const int cab = (int)basec + __builtin_amdgcn_readlane((int)(Q - h), js), nB = __builtin_amdgcn_readlane((int)h, js);
    const int B = 63 * Ls + js, need = 256 - cab;
    const float lo4 = 4.f * (float)B;
    int ncand = 0;
#pragma unroll
    for (int g = 0; g < NG; ++g) {
        u64 m[8], any = 0ull;
#pragma unroll
        for (int k = 0; k < 8; ++k) { const float t4 = __builtin_fmaf(x[8 * g + k], -s4, hs4); m[k] = __builtin_amdgcn_ballot_w64(__float_as_uint(t4 - lo4) < 0x40800000u); any |= m[k]; }
        if (any != 0ull) {
#pragma unroll
            for (int k = 0; k < 8; ++k) if (m[k] != 0ull) {
                const int pos = ncand + (int)__builtin_amdgcn_mbcnt_hi((unsigned)(m[k] >> 32), __builtin_amdgcn_mbcnt_lo((unsigned)m[k], 0u));
                if (((m[k] >> lane) & 1ull) && pos < 256) LIST[pos] = x[8 * g + k];
                ncand += __builtin_popcountll(m[k]);
            }
        }
    }
    if (ncand != nB || ncand > 64 || need < 1 || need > ncand) return false;
    LDS_FENCE();
    const float c = (lane < ncand) ? LIST[lane] : -__builtin_inff();
    int G = 0, GE = 0;
    for (int i = 0; i < ncand; ++i) { const float v = LIST[i]; G += (v > c) ? 1 : 0; GE += (v >= c) ? 1 : 0; }
    const u64 ok = __builtin_amdgcn_ballot_w64(lane < ncand && G < need && need <= GE);
    if (ok == 0ull) return false;
    const int j0 = __builtin_ctzll(ok);
    tf = __int_as_float(__builtin_amdgcn_readlane(__float_as_int(c), j0));
    found = (__builtin_amdgcn_readlane(GE, j0) == need);
    return true;
}
template <int NG>
__device__ __forceinline__ void topk_search(const float (&x)[64], LAS unsigned* H, LAS float* LIST, float& tf, bool& found, u64& myword, int lane_o) {
    found = false;
    if (!topk_hist<NG>(x, H, LIST, tf, found, lane_o)) {
    unsigned Tk = 0u; found = false;
    for (int bit = 31; bit >= 0; --bit) {
        const unsigned cand = Tk | (1u << bit);
        const float cf = key_to_float(cand);
        int cl = 0, cl2 = 0;
#pragma unroll
        for (int g = 0; g < NG; ++g) count8(cl, cl2, x[8 * g], x[8 * g + 1], x[8 * g + 2], x[8 * g + 3], x[8 * g + 4], x[8 * g + 5], x[8 * g + 6], x[8 * g + 7], cf);
        const int cnt = wave_sum_i(cl + cl2);
        if (cnt >= 256) { Tk = cand; if (cnt == 256) { found = true; break; } }
    }
    tf = key_to_float(Tk);
    }
    if (found) {
#pragma unroll
        for (int i = 0; i < 8 * NG; ++i) {
            const u64 w = __ballot(x[i] >= tf);
            if (lane_o == i) myword = w;
            if ((i & 3) == 3) __builtin_amdgcn_sched_barrier(0);
        }
    }
}
__device__ __forceinline__ void indexer_unit(LAS unsigned char* lds, const bf16* proj, const bf16* kip, u64* mask, int b, int g8, int lane, int wave) {
    const int q0 = g8 * 8, qc = q0 >> 6, L = 64 * (qc + 1), nr = qc + 1;
    u64* mout = mask + ((size_t)b * T + q0 + wave) * 64;
    if (L <= 256) { u64 ones = ~0ull; asm volatile("" : "+v"(ones)); if (lane < nr) mout[lane] = ones; return; }
    LAS float* SCR = (LAS float*)lds;
    const int r = lane & 31, hh = lane >> 5;
    bf16x8 af[2][4]; float wv[2][2][8];
    {
        const int a_ = r >> 4, b_ = (r >> 3) & 1, c_ = (r >> 2) & 1, d_ = r & 3;
#pragma unroll
        for (int mi = 0; mi < 2; ++mi) {
            const bf16* qp = proj + PX((size_t)b * T + q0 + 4 * mi + 2 * a_ + c_, COL_AQI + (4 * b_ + d_) * 64) + hh * PXC;
#pragma unroll
            for (int s = 0; s < 4; ++s) af[mi][s] = ldg16(qp + 2 * s * PXC);
#pragma unroll
            for (int a = 0; a < 2; ++a) {
                const u32x4 w4 = *(const u32x4*)(proj + PX((size_t)b * T + q0 + 4 * mi + 2 * a + hh, COL_AWI));
                wv[mi][a][0] = bflo(w4.x); wv[mi][a][1] = bfhi(w4.x); wv[mi][a][2] = bflo(w4.y); wv[mi][a][3] = bfhi(w4.y);
                wv[mi][a][4] = bflo(w4.z); wv[mi][a][5] = bfhi(w4.z); wv[mi][a][6] = bflo(w4.w); wv[mi][a][7] = bfhi(w4.w);
            }
        }
    }
    const bf16* kb = kip + (size_t)b * (T / 32) * 2048 + lane * 8;
    const int ntl = L / 32;
    for (int rep_mm = 0; rep_mm < REP_IDX_MM; ++rep_mm) {
    bf16x8 b0[4], b1[4], b2[4];
#pragma unroll
    for (int s = 0; s < 4; ++s) { b0[s] = ldg16(kb + (size_t)wave * 2048 + s * 512); b1[s] = b0[s]; b2[s] = b0[s]; }
    if (wave + 8 < ntl) {
#pragma unroll
        for (int s = 0; s < 4; ++s) b1[s] = ldg16(kb + (size_t)(wave + 8) * 2048 + s * 512);
    }
    if (wave + 16 < ntl) {
#pragma unroll
        for (int s = 0; s < 4; ++s) b2[s] = ldg16(kb + (size_t)(wave + 16) * 2048 + s * 512);
    }
    auto tile = [&](int kt, bf16x8 (&bq)[4]) {
#pragma unroll
        for (int mi = 0; mi < 2; ++mi) {
            f32x16 acc = zero16();
#pragma unroll
            for (int s = 0; s < 4; ++s) acc = mfma32(af[mi][s], bq[s], acc);
#pragma unroll
            for (int a = 0; a < 2; ++a) {
                float sc = 0.f;
#pragma unroll
                for (int h8 = 0; h8 < 8; ++h8) { const int ri = __float_as_int(acc[8 * a + h8]); sc = __builtin_fmaf(__int_as_float(ri > 0 ? ri : 0), wv[mi][a][h8], sc); }
                SCR[(4 * mi + 2 * a + hh) * 4096 + 32 * kt + r] = sc;
            }
        }
        if (kt + 24 < ntl) {
#pragma unroll
            for (int s = 0; s < 4; ++s) bq[s] = ldg16(kb + (size_t)(kt + 24) * 2048 + s * 512);
        }
    };
    for (int kt = wave; kt < ntl; kt += 24) {
        tile(kt, b0);
        if (kt + 8 < ntl) tile(kt + 8, b1);
        if (kt + 16 < ntl) tile(kt + 16, b2);
    }
    }
    {
        LAS float* padrow = SCR + wave * 4096;
        const int Lp = ((nr + 7) & ~7) * 64;
        for (int c = L + lane; c < Lp; c += 64) padrow[c] = -__builtin_inff();
    }
    __syncthreads();
    const LAS float* myrow = SCR + wave * 4096;
    float x[64];
#pragma unroll
    for (int g = 0; g < 8; ++g) {
        if (8 * g < nr) {
#pragma unroll
            for (int i = 0; i < 8; ++i) x[8 * g + i] = myrow[64 * (8 * g + i) + lane];
        } else {
#pragma unroll
            for (int i = 0; i < 8; ++i) x[8 * g + i] = -__builtin_inff();
        }
    }
    float tf = 0.f; bool found = false; u64 myword = 0ull;
    LAS unsigned* HH = (LAS unsigned*)(SCR + wave * 4096); LAS float* LIST = (LAS float*)(lds + 131072 + wave * 2048);
    int lane_o = lane; asm volatile("" : "+v"(lane_o));
    switch ((nr + 7) >> 3) {
        case 1: topk_search<1>(x, HH, LIST, tf, found, myword, lane_o); break;
        case 2: topk_search<2>(x, HH, LIST, tf, found, myword, lane_o); break;
        case 3: topk_search<3>(x, HH, LIST, tf, found, myword, lane_o); break;
        case 4: topk_search<4>(x, HH, LIST, tf, found, myword, lane_o); break;
        case 5: topk_search<5>(x, HH, LIST, tf, found, myword, lane_o); break;
        case 6: topk_search<6>(x, HH, LIST, tf, found, myword, lane_o); break;
        case 7: topk_search<7>(x, HH, LIST, tf, found, myword, lane_o); break;
        default: topk_search<8>(x, HH, LIST, tf, found, myword, lane_o); break;
    }
    if (!found) {
        int cgt = 0;
#pragma unroll
        for (int i = 0; i < 64; ++i) { cgt += __popcll(__ballot(x[i] > tf)); if ((i & 3) == 3) __builtin_amdgcn_sched_barrier(0); }
        int need = 256 - cgt;
        float tf2 = tf; asm volatile("" : "+v"(tf2));
#pragma unroll
        for (int i = 0; i < 64; ++i) {
            u64 w = __ballot(x[i] > tf2);
            u64 e = __ballot(x[i] == tf2);
            if (need > 0 && e != 0ull) {
                const int c = __popcll(e);
                if (c <= need) { w |= e; need -= c; }
                else { for (int t2 = 0; t2 < need; ++t2) { const u64 low = e & (0ull - e); w |= low; e ^= low; } need = 0; }
            }
            if (lane_o == i) myword = w;
            if ((i & 3) == 3) __builtin_amdgcn_sched_barrier(0);
        }
    }
    if (lane < nr) mout[lane] = myword;
    __syncthreads();
}

__device__ __forceinline__ float ret_log2g(int h) { return log2f(1.f - exp2f(-5.f - (float)h)); }
template <bool SCALE>
__device__ __forceinline__ void stage_img64(LAS unsigned char* img, const bf16* proj, size_t tok0, int col, int lane, float scale) {
    const bf16* vp = proj + PX(tok0 + lane, col);
#pragma unroll
    for (int ch = 0; ch < 8; ++ch) {
        bf16x8 vv = ldg16(vp + ch * PXC);
        if (SCALE) { u32x4 w; w.x = cvtpk(bf2f(vv[0]) * scale, bf2f(vv[1]) * scale); w.y = cvtpk(bf2f(vv[2]) * scale, bf2f(vv[3]) * scale); w.z = cvtpk(bf2f(vv[4]) * scale, bf2f(vv[5]) * scale); w.w = cvtpk(bf2f(vv[6]) * scale, bf2f(vv[7]) * scale); vv = __builtin_bit_cast(bf16x8, w); }
        *(LAS bf16x8*)(img + (ch >> 2) * 4096 + lane * 64 + (ch & 3) * 16) = vv;
    }
}
__device__ __forceinline__ void ret_state_unit(LAS unsigned char* wl, const bf16* proj, float* UB, int b, int c, int h, int lane) {
    LAS unsigned char* VI = wl; LAS unsigned char* KI = wl + 8192;
    const size_t tok0 = (size_t)b * T + 64 * c;
    const int r = lane & 31, hh = lane >> 5;
    stage_img64<false>(VI, proj, tok0, COL_BV + h * 64, lane, 1.f);
    stage_img64<true>(KI, proj, tok0, COL_BK + h * 64, lane, exp2f((63.f - (float)lane) * ret_log2g(h)));
    LDS_FENCE();
    const LAS unsigned char* const vnb = tr_base_nat(VI, lane); const LAS unsigned char* const knb = tr_base_nat(KI, lane);
    float* ub = UB + (size_t)((b * NCH + c) * 4 + h) * 4096;
    f32x16 acc[2][2];
#pragma unroll
    for (int me = 0; me < 2; ++me)
#pragma unroll
        for (int nd = 0; nd < 2; ++nd) acc[me][nd] = zero16();
#define RS_STEP(K0) do { const bf16x8 a0 = ld_tr_nat<0, K0>(vnb), a1 = ld_tr_nat<1, K0>(vnb), b0_ = ld_tr_nat<0, K0>(knb), b1_ = ld_tr_nat<1, K0>(knb); \
        acc[0][0] = mfma32(a0, b0_, acc[0][0]); acc[0][1] = mfma32(a0, b1_, acc[0][1]); acc[1][0] = mfma32(a1, b0_, acc[1][0]); acc[1][1] = mfma32(a1, b1_, acc[1][1]); } while (0)
    RS_STEP(0); RS_STEP(16); RS_STEP(32); RS_STEP(48);
#undef RS_STEP
#pragma unroll
    for (int me = 0; me < 2; ++me)
#pragma unroll
        for (int nd = 0; nd < 2; ++nd)
#pragma unroll
            for (int i = 0; i < 16; ++i) ub[(32 * me + crow(i, hh)) * 64 + 32 * nd + r] = acc[me][nd][i];
    LDS_FENCE();
}
__device__ __forceinline__ void ret_out_unit(LAS unsigned char* wl, const bf16* proj, const bf16* RB, const float* hng, bf16* Y, int b, int c, int h, int lane_in) {
    int lane = lane_in; asm volatile("" : "+v"(lane));
    LAS unsigned char* VI = wl;
    const size_t tok0 = (size_t)b * T + 64 * c;
    const int r = lane & 31, hh = lane >> 5;
    bf16x8 vrow[8], kf[2][4], qf[2][4], rbf[2][4];
    {
        const bf16* vp = proj + PX(tok0 + lane, COL_BV + h * 64);
#pragma unroll
        for (int ch = 0; ch < 8; ++ch) vrow[ch] = ldg16(vp + ch * PXC);
        const bf16* rb = RB + (size_t)((b * NCH + c) * 4 + h) * 4096;
#pragma unroll
        for (int mi = 0; mi < 2; ++mi)
#pragma unroll
            for (int s = 0; s < 4; ++s) {
                kf[mi][s] = ldg16(proj + PX(tok0 + 32 * mi + r, COL_BK + h * 64) + (2 * s + hh) * PXC);
                if (mi == 0) qf[0][s] = ldg16(proj + PX(tok0 + r, COL_BQ + h * 64) + (2 * s + hh) * PXC);
                rbf[mi][s] = ldg16(rb + (32 * mi + r) * 64 + 16 * s + 8 * hh);
            }
    }
#pragma unroll
    for (int ch = 0; ch < 8; ++ch) *(LAS bf16x8*)(VI + (ch >> 2) * 4096 + lane * 64 + (ch & 3) * 16) = vrow[ch];
    LDS_FENCE();
    const LAS unsigned char* const vtb = tr_base_perm(VI, lane);
    const float lg = ret_log2g(h);
#pragma unroll
    for (int ni = 0; ni < 2; ++ni) {
        const int i_ = 32 * ni + r;
        u32x4 gt[4];
        load_rows16(proj + PX(tok0 + i_, COL_BG + h * 64), hh, gt);
        if (ni == 0) {
#pragma unroll
            for (int s = 0; s < 4; ++s) qf[1][s] = ldg16(proj + PX(tok0 + 32 + r, COL_BQ + h * 64) + (2 * s + hh) * PXC);
        }
        f32x16 out[2];
#pragma unroll
        for (int me = 0; me < 2; ++me) {
            out[me] = zero16();
#pragma unroll
            for (int s = 0; s < 4; ++s) out[me] = mfma32(rbf[me][s], qf[ni][s], out[me]);
        }
        const float xi = __builtin_amdgcn_exp2f((float)(i_ + 1) * lg);
#pragma unroll
        for (int me = 0; me < 2; ++me)
#pragma unroll
            for (int i = 0; i < 16; ++i) out[me][i] *= xi;
#pragma unroll
        for (int mi = 0; mi < 2; ++mi) {
            f32x16 x = zero16();
#pragma unroll
            for (int s = 0; s < 4; ++s) x = mfma32(kf[mi][s], qf[ni][s], x);
#pragma unroll
            for (int i = 0; i < 16; ++i) { const int j_ = 32 * mi + crow(i, hh); x[i] *= __builtin_amdgcn_exp2f(fabsf((float)(i_ - j_)) * lg); }
            const bf16x8 p0 = pack8<0>(x), p1 = pack8<1>(x);
            if (mi == 0) {
                out[0] = mfma32(ld_tr_perm<0, 0>(vtb), p0, out[0]); out[0] = mfma32(ld_tr_perm<0, 16>(vtb), p1, out[0]);
                out[1] = mfma32(ld_tr_perm<1, 0>(vtb), p0, out[1]); out[1] = mfma32(ld_tr_perm<1, 16>(vtb), p1, out[1]);
            } else {
                out[0] = mfma32(ld_tr_perm<0, 32>(vtb), p0, out[0]); out[0] = mfma32(ld_tr_perm<0, 48>(vtb), p1, out[0]);
                out[1] = mfma32(ld_tr_perm<1, 32>(vtb), p0, out[1]); out[1] = mfma32(ld_tr_perm<1, 48>(vtb), p1, out[1]);
            }
        }
        headnorm_store_g<true>(out, hh, hng + 256 + h * 64, gt, 1.f, Y + (tok0 + i_) * D + 256 + h * 64);
    }
    LDS_FENCE();
}

__device__ __forceinline__ void gla_cumsum(LAS float* BL, const bf16* proj, const float* wa2, const float* ba, size_t tok0, int h, int lane) {
    const int k = lane & 31, hh = lane >> 5;
    bf16x8 wf;
    {
        float w[8];
#pragma unroll
        for (int j = 0; j < 8; ++j) w[j] = wa2[(8 * hh + j) * 128 + h * 32 + k];
        u32x4 p; p.x = cvtpk(w[0], w[1]); p.y = cvtpk(w[2], w[3]); p.z = cvtpk(w[4], w[5]); p.w = cvtpk(w[6], w[7]);
        wf = __builtin_bit_cast(bf16x8, p);
    }
    const float bias = ba[h * 32 + k];
    const int tau = 16 * ((k >> 2) & 1) + 4 * (k >> 3) + (k & 3);
    f32x16 z[2];
#pragma unroll
    for (int mi = 0; mi < 2; ++mi) {
        const bf16x8 af = ldg16(proj + PX(tok0 + 32 * mi + tau, COL_CA) + hh * PXC);
        f32x16 c0;
#pragma unroll
        for (int i = 0; i < 16; ++i) c0[i] = bias;
        z[mi] = mfma32(af, wf, c0);
    }
    float tot[2];
#pragma unroll
    for (int mi = 0; mi < 2; ++mi) {
        float run = 0.f;
#pragma unroll
        for (int i = 0; i < 16; ++i) {
            const float e = __builtin_amdgcn_exp2f(fminf(-z[mi][i] * LOG2E, 120.f));
            run -= __builtin_amdgcn_logf(1.f + e) * (1.f / 16.f);
            z[mi][i] = run;
        }
        tot[mi] = run;
    }
    const float oth0 = __int_as_float(__builtin_amdgcn_ds_bpermute((lane ^ 32) << 2, __float_as_int(tot[0])));
    const float oth1 = __int_as_float(__builtin_amdgcn_ds_bpermute((lane ^ 32) << 2, __float_as_int(tot[1])));
    const float off0 = hh ? oth0 : 0.f, off1 = tot[0] + oth0 + (hh ? oth1 : 0.f);
#pragma unroll
    for (int i = 0; i < 16; ++i) { BL[(16 * hh + i) * 33 + k] = z[0][i] + off0; BL[(32 + 16 * hh + i) * 33 + k] = z[1][i] + off1; }
    LDS_FENCE();
}
__device__ __forceinline__ float clamp_exp(float x) { return __builtin_amdgcn_exp2f(fminf(fmaxf(x, -115.f), 115.f)); }
__device__ __forceinline__ void gla_state_unit(LAS unsigned char* wl, const bf16* proj, const float* wa2, const float* ba, float* UC, float* GC, int b, int c, int h, int lane) {
    LAS float* BL = (LAS float*)wl; LAS unsigned char* VI = wl; LAS unsigned char* KI = wl + 9216;
    const size_t tok0 = (size_t)b * T + 64 * c;
    const int r = lane & 31, hh = lane >> 5;
    gla_cumsum(BL, proj, wa2, ba, tok0, h, lane);
    {
        const bf16* kp = proj + PX(tok0 + lane, COL_CK + h * 32);
#pragma unroll
        for (int ch = 0; ch < 4; ++ch) { const bf16x8 kv = ldg16(kp + ch * PXC);
            float x[8];
#pragma unroll
            for (int i = 0; i < 8; ++i) { const int kk = 8 * ch + i; x[i] = bf2f(kv[i]) * clamp_exp(BL[63 * 33 + kk] - BL[lane * 33 + kk]); }
            u32x4 w; w.x = cvtpk(x[0], x[1]); w.y = cvtpk(x[2], x[3]); w.z = cvtpk(x[4], x[5]); w.w = cvtpk(x[6], x[7]);
            *(LAS u32x4*)(KI + lane * 64 + ch * 16) = w; }
        if (lane < 32) GC[(size_t)((b * NCH + c) * 4 + h) * 32 + lane] = clamp_exp(BL[63 * 33 + lane]);
    }
    LDS_FENCE();
    stage_img64<false>(VI, proj, tok0, COL_CV + h * 64, lane, 1.f);
    LDS_FENCE();
    const LAS unsigned char* const vnb = tr_base_nat(VI, lane); const LAS unsigned char* const knb = tr_base_nat(KI, lane);
    float* uc = UC + (size_t)((b * NCH + c) * 4 + h) * 2048;
    f32x16 acc[2]; acc[0] = zero16(); acc[1] = zero16();
#define GS_STEP(K0) do { const bf16x8 a0 = ld_tr_nat<0, K0>(vnb), a1 = ld_tr_nat<1, K0>(vnb), b0_ = ld_tr_nat<0, K0>(knb); acc[0] = mfma32(a0, b0_, acc[0]); acc[1] = mfma32(a1, b0_, acc[1]); } while (0)
    GS_STEP(0); GS_STEP(16); GS_STEP(32); GS_STEP(48);
#undef GS_STEP
#pragma unroll
    for (int me = 0; me < 2; ++me)
#pragma unroll
        for (int i = 0; i < 16; ++i) uc[(32 * me + crow(i, hh)) * 32 + r] = acc[me][i];
    LDS_FENCE();
}
__device__ __forceinline__ void gla_frag(const bf16x8 v, const LAS float* bl, bf16x8& fp, bf16x8& fm) {
    float xp[8], xm[8];
#pragma unroll
    for (int j = 0; j < 8; ++j) { const float x = bf2f(v[j]), bb = bl[j]; xp[j] = x * clamp_exp(bb); xm[j] = x * clamp_exp(-bb); }
    u32x4 a, c;
    a.x = cvtpk(xp[0], xp[1]); a.y = cvtpk(xp[2], xp[3]); a.z = cvtpk(xp[4], xp[5]); a.w = cvtpk(xp[6], xp[7]);
    c.x = cvtpk(xm[0], xm[1]); c.y = cvtpk(xm[2], xm[3]); c.z = cvtpk(xm[4], xm[5]); c.w = cvtpk(xm[6], xm[7]);
    fp = __builtin_bit_cast(bf16x8, a); fm = __builtin_bit_cast(bf16x8, c);
}
__device__ __forceinline__ void gla_out_unit(LAS unsigned char* wl, const bf16* proj, const float* wa2, const float* ba, const bf16* SCB, const float* hng, bf16* Y, int b, int c, int h, int lane_in) {
    int lane = lane_in; asm volatile("" : "+v"(lane));
    LAS unsigned char* VI = wl; LAS float* BL = (LAS float*)(wl + 9216);
    const size_t tok0 = (size_t)b * T + 64 * c;
    const int r = lane & 31, hh = lane >> 5;
    bf16x8 vrow[8], kraw[2][2], qraw[2][2], stf[2][2];
    {
        const bf16* vp = proj + PX(tok0 + lane, COL_CV + h * 64);
#pragma unroll
        for (int ch = 0; ch < 8; ++ch) vrow[ch] = ldg16(vp + ch * PXC);
        const bf16* sc = SCB + (size_t)((b * NCH + c) * 4 + h) * 2048;
#pragma unroll
        for (int mi = 0; mi < 2; ++mi)
#pragma unroll
            for (int s = 0; s < 2; ++s) {
                kraw[mi][s] = ldg16(proj + PX(tok0 + 32 * mi + r, COL_CK + h * 32) + (2 * s + hh) * PXC);
                if (mi == 0) qraw[0][s] = ldg16(proj + PX(tok0 + r, COL_CQ + h * 32) + (2 * s + hh) * PXC);
                stf[mi][s] = ldg16(sc + (32 * mi + r) * 32 + 16 * s + 8 * hh);
            }
    }
    gla_cumsum(BL, proj, wa2, ba, tok0, h, lane);
#pragma unroll
    for (int ch = 0; ch < 8; ++ch) *(LAS bf16x8*)(VI + (ch >> 2) * 4096 + lane * 64 + (ch & 3) * 16) = vrow[ch];
    LDS_FENCE();
    const LAS unsigned char* const vtb = tr_base_perm(VI, lane);
    bf16x8 kp_[2][2], km_[2][2];
#pragma unroll
    for (int mi = 0; mi < 2; ++mi)
#pragma unroll
        for (int s = 0; s < 2; ++s) gla_frag(kraw[mi][s], BL + (32 * mi + r) * 33 + 16 * s + 8 * hh, kp_[mi][s], km_[mi][s]);
#pragma unroll
    for (int ni = 0; ni < 2; ++ni) {
        const int t_ = 32 * ni + r;
        if (ni == 0) {
#pragma unroll
            for (int s = 0; s < 2; ++s) qraw[1][s] = ldg16(proj + PX(tok0 + 32 + r, COL_CQ + h * 32) + (2 * s + hh) * PXC);
        }
        bf16x8 qp_[2], qm_[2];
#pragma unroll
        for (int s = 0; s < 2; ++s) gla_frag(qraw[ni][s], BL + t_ * 33 + 16 * s + 8 * hh, qp_[s], qm_[s]);
        f32x16 out[2];
#pragma unroll
        for (int me = 0; me < 2; ++me) {
            out[me] = zero16();
#pragma unroll
            for (int s = 0; s < 2; ++s) out[me] = mfma32(stf[me][s], qp_[s], out[me]);
        }
#pragma unroll
        for (int mi = 0; mi < 2; ++mi) {
            f32x16 x;
            if (mi < ni) {
                x = zero16();
#pragma unroll
                for (int s = 0; s < 2; ++s) x = mfma32(km_[mi][s], qp_[s], x);
            } else if (mi > ni) {
                x = zero16();
#pragma unroll
                for (int s = 0; s < 2; ++s) x = mfma32(kp_[mi][s], qm_[s], x);
            } else {
                f32x16 x1 = zero16(), x2 = zero16();
#pragma unroll
                for (int s = 0; s < 2; ++s) { x1 = mfma32(km_[mi][s], qp_[s], x1); x2 = mfma32(kp_[mi][s], qm_[s], x2); }
#pragma unroll
                for (int i = 0; i < 16; ++i) x[i] = (crow(i, hh) <= r) ? x1[i] : x2[i];
            }
            const bf16x8 p0 = pack8<0>(x), p1 = pack8<1>(x);
            if (mi == 0) {
                out[0] = mfma32(ld_tr_perm<0, 0>(vtb), p0, out[0]); out[0] = mfma32(ld_tr_perm<0, 16>(vtb), p1, out[0]);
                out[1] = mfma32(ld_tr_perm<1, 0>(vtb), p0, out[1]); out[1] = mfma32(ld_tr_perm<1, 16>(vtb), p1, out[1]);
            } else {
                out[0] = mfma32(ld_tr_perm<0, 32>(vtb), p0, out[0]); out[0] = mfma32(ld_tr_perm<0, 48>(vtb), p1, out[0]);
                out[1] = mfma32(ld_tr_perm<1, 32>(vtb), p0, out[1]); out[1] = mfma32(ld_tr_perm<1, 48>(vtb), p1, out[1]);
            }
        }
        headnorm_store<true, true>(out, hh, hng + 512 + h * 64, proj + PX(tok0 + t_, COL_CG + h * 64), 1.f, Y + (tok0 + t_) * D + 512 + h * 64);
    }
    LDS_FENCE();
}

#ifndef EN_P0
#define EN_P0 1
#endif
#ifndef EN_ROW
#define EN_ROW 1
#endif
#ifndef EN_G0
#define EN_G0 1
#endif
#ifndef EN_M1
#define EN_M1 1
#endif
#ifndef EN_M2
#define EN_M2 1
#endif
#ifndef EN_M3
#define EN_M3 1
#endif
#ifndef EN_G1
#define EN_G1 1
#endif
#ifndef EN_G2
#define EN_G2 1
#endif
#ifndef EN_G3
#define EN_G3 1
#endif
#ifndef EN_M1A
#define EN_M1A 1
#endif
#ifndef EN_M1A2
#define EN_M1A2 1
#endif
#ifndef EN_M1B
#define EN_M1B 1
#endif
#ifndef EN_M1C
#define EN_M1C 1
#endif
#ifndef EN_M3A
#define EN_M3A 1
#endif
#ifndef EN_M3B
#define EN_M3B 1
#endif
struct Args { const void* in[20]; float* out; unsigned char* ws; int ph_lo, ph_hi; };
#ifndef MK_ALIGN
#define MK_ALIGN true
#endif
#ifndef MK_SP2
#define MK_SP2 true
#endif

#ifndef REP_M1A
#define REP_M1A 1
#endif
#ifndef REP_M1B
#define REP_M1B 1
#endif
#ifndef REP_M1C
#define REP_M1C 1
#endif
#ifndef REP_M2A
#define REP_M2A 1
#endif
#ifndef REP_M2B
#define REP_M2B 1
#endif
#ifndef REP_M3
#define REP_M3 1
#endif
#ifndef REP_G
#define REP_G 1
#endif
#ifndef EN_SEAM
#define EN_SEAM 1
#endif
#ifndef NLAYER_LOOP
#define NLAYER_LOOP 2
#endif
__device__ __forceinline__ unsigned long long karg_raw(int idx) {
    const __attribute__((address_space(4))) unsigned char* k = (const __attribute__((address_space(4))) unsigned char*)__builtin_amdgcn_kernarg_segment_ptr();
    const unsigned long long v = *(const volatile __attribute__((address_space(4))) unsigned long long*)(k + 8 * idx);
    const unsigned lo = __builtin_amdgcn_readfirstlane((unsigned)v), hi = __builtin_amdgcn_readfirstlane((unsigned)(v >> 32));
    return ((unsigned long long)hi << 32) | lo;
}
template <class Tp> __device__ __forceinline__ Tp* kptr(int idx) { return (Tp*)(GAS Tp*)karg_raw(idx); }
#define KIN(idx) kptr<const float>(idx)
#define KWS() kptr<unsigned char>(21)
#define KOUT() kptr<float>(20)

__global__ void __launch_bounds__(NTHREADS, 2) mk_fwd(Args args) {
    extern __shared__ __attribute__((aligned(16))) unsigned char lds_raw[];
    LAS unsigned char* lds = (LAS unsigned char*)lds_raw;
    const int G = gridDim.x, bx = blockIdx.x;
    const int wave_s = __builtin_amdgcn_readfirstlane(threadIdx.x >> 6);
#define PHASE_IDS int tid; asm volatile("v_mbcnt_lo_u32_b32 %0, -1, 0\n\tv_mbcnt_hi_u32_b32 %0, -1, %0\n\tv_lshl_add_u32 %0, %1, 6, %0" : "=&v"(tid) : "s"(wave_s)); const int lane = tid & 63, wave = __builtin_amdgcn_readfirstlane(tid >> 6); const int gw = bx * NWAVES + wave, ngw = G * NWAVES; (void)gw; (void)ngw; (void)lane;

    for (int u = threadIdx.x; u < (LDS_BYTES - LDSCTL_OFF) / 4; u += NTHREADS) ((LAS unsigned*)(lds + LDSCTL_OFF))[u] = 0u;
    __syncthreads();
    const int lo = args.ph_lo, hi = args.ph_hi;
    if (hi - lo > 1) (void)xcd_barrier_post((unsigned*)(KWS() + WS_CTL) + CW_BAR, (volatile LAS unsigned*)(lds + LDSCTL_OFF));
#define IN(k) (lo <= (k) && (k) < hi)
#define SEAM(k) do { if (EN_SEAM && IN(k) && IN((k) + 1)) { XcdBarrier b_; b_.bar = (unsigned*)(KWS() + WS_CTL) + CW_BAR; b_.x = xb_xcc_id(); b_.st = (volatile LAS unsigned*)(lds + LDSCTL_OFF); xcd_barrier(b_); } } while (0)

    if (EN_P0 && IN(0)) {
        PHASE_IDS
        unsigned char* ws = KWS();
        LAS float* scr = (LAS float*)(lds + wave * 8448);
        constexpr int I_IN = (D / 64) * (NPROJ / 32), I_OUT = (D / 64) * (D / 32), I_1 = (D / 64) * (FF / 32), I_2 = (FF / 64) * (D / 32), I_L = I_IN + I_OUT + I_1 + I_2;
        {
            LAS float* condT = (LAS float*)lds;
            LAS float* part = (LAS float*)(lds + 65536);
            const float* c_in = KIN(1); const float* mod_w = KIN(3); const float* mod_b = KIN(4); float* MOD = (float*)(ws + WS_MOD);
            for (int i = tid; i < BATCH * D; i += NTHREADS) { const int b = i >> 10, k = i & 1023; const float v = c_in[i]; condT[k * 16 + b] = v / (1.f + expf(-v)); }
            __syncthreads();
            for (int cg = bx; cg < 256; cg += G) {
                const int l = cg >> 7, jj = 48 * (cg & 127) + (lane < 48 ? lane : 0);
                float acc[16];
#pragma unroll
                for (int b = 0; b < 16; ++b) acc[b] = 0.f;
                const float* wp = mod_w + ((size_t)l * D + 128 * wave) * 6144 + jj;
#pragma unroll 16
                for (int k = 0; k < 128; ++k) {
                    const float w = wp[(size_t)k * 6144];
                    const LAS float* cp = condT + (128 * wave + k) * 16;
                    const f32x4 c0 = *(const LAS f32x4*)(cp), c1 = *(const LAS f32x4*)(cp + 4), c2 = *(const LAS f32x4*)(cp + 8), c3 = *(const LAS f32x4*)(cp + 12);
#pragma unroll
                    for (int b = 0; b < 4; ++b) { acc[b] += c0[b] * w; acc[4 + b] += c1[b] * w; acc[8 + b] += c2[b] * w; acc[12 + b] += c3[b] * w; }
                }
                if (lane < 48) {
#pragma unroll
                    for (int b = 0; b < 16; ++b) part[(wave * 16 + b) * 48 + lane] = acc[b];
                }
                __syncthreads();
                for (int o = tid; o < 768; o += NTHREADS) {
                    const int b = o / 48, cc = o % 48, j = 48 * (cg & 127) + cc;
                    float s = mod_b[l * 6144 + j];
#pragma unroll
                    for (int w8 = 0; w8 < 8; ++w8) s += part[(w8 * 16 + b) * 48 + cc];
                    MOD[(size_t)(l * 16 + b) * 6144 + j] = s;
                }
                __syncthreads();
            }
        }
        const float* w_in = KIN(9); const float* w_out = KIN(17); const float* mlp_w1 = KIN(18); const float* mlp_w2 = KIN(19);
        for (int it = gw; it < 2 * I_L; it += ngw) {
            const int l = it / I_L; int rr = it % I_L;
            unsigned char* wl = ws + WS_W + (size_t)l * W_LAYER;
            if (rr < I_IN) { transpose_item<true>(w_in + (size_t)l * D * NPROJ_SRC, D, NPROJ_SRC, NPROJ, (bf16*)(wl + W_IN), scr, rr, lane); continue; } rr -= I_IN;
            if (rr < I_OUT) { transpose_item<false>(w_out + (size_t)l * D * D, D, D, D, (bf16*)(wl + W_OUT), scr, rr, lane); continue; } rr -= I_OUT;
            if (rr < I_1) {
                const float* wp = mlp_w1 + (size_t)l * D * FF + (size_t)rr * 2048 + 4 * lane; float am = 0.f;
#pragma unroll
                for (int j = 0; j < 8; ++j) { const f32x4 t = *(const f32x4*)(wp + 256 * j); am = fmaxf(am, fmaxf(fmaxf(fabsf(t[0]), fabsf(t[1])), fmaxf(fabsf(t[2]), fabsf(t[3])))); }
                am = wave_max(am);
                if (lane == 0) atomicMax((unsigned*)(ws + WS_CTL) + CW_W1MAX + l, __float_as_uint(am));
                continue; } rr -= I_1;
            transpose_item_f8(mlp_w2 + (size_t)l * FF * D, FF, D, wl + W_2, scr, rr, lane);
        }
    }
    SEAM(0);
    if (EN_ROW && IN(1)) { PHASE_IDS unsigned char* ws = KWS(); const float* MOD = (const float*)(ws + WS_MOD);
        {
            LAS float* scr = (LAS float*)(lds + wave * 8448); const float* mlp_w1 = KIN(18);
            constexpr int I_1 = (D / 64) * (FF / 32);
            for (int it = gw; it < 2 * I_1; it += ngw) {
                const int l = it / I_1, rr = it % I_1;
                const float amax = fmaxf(__uint_as_float(__hip_atomic_load((unsigned*)(ws + WS_CTL) + CW_W1MAX + l, __ATOMIC_RELAXED, __HIP_MEMORY_SCOPE_AGENT)), 1.0e-30f);
                transpose_item_i8(mlp_w1 + (size_t)l * D * FF, D, FF, ws + WS_W + (size_t)l * W_LAYER + W_1, scr, rr, lane, 127.f / amax);
            }
        }
        rowpass<false, true, false, false>(KIN(0), nullptr, nullptr, nullptr, nullptr, nullptr, nullptr, nullptr, KIN(5), MOD + 1 * D, MOD + 0 * D, (bf16*)(ws + WS_H), gw, ngw, lane); }
    SEAM(1);

    for (int l = 0; l < NLAYER_LOOP; ++l) {
        const int pb = 2 + 9 * l;
        if (EN_G0 && IN(pb + 0)) for (int rep = 0; rep < REP_G; ++rep) {
            unsigned char* ws = KWS();
            pg8::Gemm g{(const bf16*)(ws + WS_H), (const bf16*)(ws + WS_W + (size_t)l * W_LAYER + W_IN), M, NPROJ, D}; pg8::StaticOrder S; S.init(M, NPROJ, G, bx);
            EpiProj E{(bf16*)(ws + WS_PROJ), kptr<const int>(2), (bf16*)(ws + WS_KIP)};
            { PHASE_IDS pg8::gemm_phase<EpiProj, pg8::StaticOrder, MK_ALIGN, MK_SP2>(lds, g, S, E, tid); }
        }
        SEAM(pb + 0);
        if (EN_M1 && IN(pb + 1)) {
            for (int rep = 0; rep < REP_M1A; ++rep) {
                PHASE_IDS
                unsigned char* ws = KWS(); const bf16* PROJ = (const bf16*)(ws + WS_PROJ);
                float* UB = (float*)(ws + WS_UB); float* UC = (float*)(ws + WS_UC); float* GC = (float*)(ws + WS_GC);
                const float* gla_wa2 = KIN(10) + l * 16 * 128; const float* gla_ba = KIN(11) + l * 128;
                if (EN_M1A) for (int wu = gw; wu < 4096; wu += ngw) { const int b = wu >> 8, c = (wu >> 2) & 63, h = wu & 3; ret_state_unit(lds + wave * 18432, PROJ, UB, b, c, h, lane); }
                __builtin_amdgcn_sched_barrier(0);
                if (EN_M1A2) for (int wu = gw; wu < 4096; wu += ngw) { const int b = wu >> 8, c = (wu >> 2) & 63, h = wu & 3; gla_state_unit(lds + wave * 18432, PROJ, gla_wa2, gla_ba, UC, GC, b, c, h, lane); }
            }
            __syncthreads();
            if (EN_M1B) for (int rep = 0; rep < REP_M1B; ++rep) {
                PHASE_IDS
                unsigned char* ws = KWS(); const bf16* PROJ = (const bf16*)(ws + WS_PROJ);
                const float lam_init = 0.8f - 0.6f * expf(-0.3f * (float)l);
                float a1 = 0.f, a2 = 0.f;
                if (lane < 32) { a1 = KIN(12)[l * 32 + lane] * KIN(13)[l * 32 + lane]; a2 = KIN(14)[l * 32 + lane] * KIN(15)[l * 32 + lane]; }
                const float lam = expf(wave_sum(a1)) - expf(wave_sum(a2)) + lam_init;
                bf16* Y = (bf16*)(ws + WS_Y); const float* hng = KIN(16) + l * D;
                for (int i = bx; i < 1024; i += G) {
                    const int bh = i & 63, slot = i >> 6, qb = slot ^ ((slot & 4) ? 3 : 0);
                    diff_unit(lds, PROJ, Y, hng, lam, lam_init, bh >> 2, bh & 3, qb, tid, lane, wave);
                }
            }
            if (EN_M1C) for (int rep = 0; rep < REP_M1C; ++rep) {
                PHASE_IDS
                unsigned char* ws = KWS(); const bf16* PROJ = (const bf16*)(ws + WS_PROJ);
                u64* MASK = (u64*)(ws + WS_MASK);
                for (int i = bx; i < 8192; i += G) {
                    const int b = i & 15, slot = i >> 4, g8 = slot ^ ((slot & 16) ? 15 : 0);
                    indexer_unit(lds, PROJ, (const bf16*)(ws + WS_KIP), MASK, b, g8, lane, wave);
                }
            }
        }
        SEAM(pb + 1);
        if (EN_M2 && IN(pb + 2)) {
            for (int rep = 0; rep < REP_M2A; ++rep) {
                PHASE_IDS
                unsigned char* ws = KWS();
                const float* UB = (const float*)(ws + WS_UB); bf16* RB = (bf16*)(ws + WS_RB);
                for (int e = bx * NTHREADS + tid; e < 16 * 4 * 4096; e += G * NTHREADS) {
                    const int b = e >> 14, h = (e >> 12) & 3, ed = e & 4095;
                    const float g64 = exp2f(64.f * ret_log2g(h));
                    float rs = 0.f, uu[NCH];
#pragma unroll
                    for (int c = 0; c < NCH; ++c) uu[c] = UB[(size_t)((b * NCH + c) * 4 + h) * 4096 + ed];
#pragma unroll
                    for (int c = 0; c < NCH; ++c) { RB[(size_t)((b * NCH + c) * 4 + h) * 4096 + ed] = f2bf(rs); rs = g64 * rs + uu[c]; }
                }
                const float* UC = (const float*)(ws + WS_UC); const float* GC = (const float*)(ws + WS_GC); bf16* SCB = (bf16*)(ws + WS_SCB);
                for (int e = bx * NTHREADS + tid; e < 16 * 4 * 2048; e += G * NTHREADS) {
                    const int b = e >> 13, h = (e >> 11) & 3, dk = e & 2047, k = e & 31;
                    float st = 0.f;
                    for (int c0 = 0; c0 < NCH; c0 += 32) {
                        float uu[32], gg[32];
#pragma unroll
                        for (int c = 0; c < 32; ++c) { const size_t u0 = (size_t)((b * NCH + c0 + c) * 4 + h); uu[c] = UC[u0 * 2048 + dk]; gg[c] = GC[u0 * 32 + k]; }
#pragma unroll
                        for (int c = 0; c < 32; ++c) { const size_t u0 = (size_t)((b * NCH + c0 + c) * 4 + h); SCB[u0 * 2048 + dk] = f2bf(st); st = gg[c] * st + uu[c]; }
                    }
                }
            }
            __syncthreads();
            for (int rep = 0; rep < REP_M2B; ++rep) {
                PHASE_IDS
                unsigned char* ws = KWS();
                const bf16* PROJ = (const bf16*)(ws + WS_PROJ); const u64* MASK = (const u64*)(ws + WS_MASK); bf16* Y = (bf16*)(ws + WS_Y); const float* hng = KIN(16) + l * D;
                for (int i = bx; i < 1024; i += G) {
                    const int b = i & 15, slot = i >> 4, qc = slot ^ ((slot & 16) ? 15 : 0);
                    dsa_unit(lds, PROJ, MASK, Y, hng, b, qc, tid, lane, wave);
                }
            }
        }
        SEAM(pb + 2);
        if (EN_M3 && IN(pb + 3)) for (int rep = 0; rep < REP_M3; ++rep) {
            PHASE_IDS
            unsigned char* ws = KWS();
            const bf16* PROJ = (const bf16*)(ws + WS_PROJ); bf16* Y = (bf16*)(ws + WS_Y); const float* hng = KIN(16) + l * D;
            const bf16* RB = (const bf16*)(ws + WS_RB); const bf16* SCB = (const bf16*)(ws + WS_SCB);
            const float* gla_wa2 = KIN(10) + l * 16 * 128; const float* gla_ba = KIN(11) + l * 128;
            if (EN_M3A) for (int wu = gw; wu < 4096; wu += ngw) { const int b = wu >> 8, c = (wu >> 2) & 63, h = wu & 3; ret_out_unit(lds + wave * 18432, PROJ, RB, hng, Y, b, c, h, lane); }
            __builtin_amdgcn_sched_barrier(0);
            if (EN_M3B) for (int wu = gw; wu < 4096; wu += ngw) { const int b = wu >> 8, c = (wu >> 2) & 63, h = wu & 3; gla_out_unit(lds + wave * 18432, PROJ, gla_wa2, gla_ba, SCB, hng, Y, b, c, h, lane); }
            __syncthreads();
        }
        SEAM(pb + 3);
        if (EN_G1 && IN(pb + 4)) for (int rep = 0; rep < REP_G; ++rep) {
            unsigned char* ws = KWS();
            pg8::Gemm g{(const bf16*)(ws + WS_Y), (const bf16*)(ws + WS_W + (size_t)l * W_LAYER + W_OUT), M, D, D}; pg8::StaticOrder S; S.init(M, D, G, bx);
            EpiY2 E{(bf16*)(ws + WS_Y2), (float*)(ws + WS_SS), 1.f};
            { PHASE_IDS pg8::gemm_phase<EpiY2, pg8::StaticOrder, MK_ALIGN, MK_SP2>(lds, g, S, E, tid); }
        }
        SEAM(pb + 4);
        if (EN_ROW && IN(pb + 5)) {
            PHASE_IDS
            unsigned char* ws = KWS(); const float* modl = (const float*)(ws + WS_MOD) + (size_t)l * 16 * 6144; float* out = KOUT();
            rowpass<true, true, false, true, true>(l == 0 ? KIN(0) : (const float*)out, nullptr, (bf16*)(ws + WS_X1A), (bf16*)(ws + WS_X1B), (const bf16*)(ws + WS_Y2), (const float*)(ws + WS_SS), KIN(6) + l * D, modl + 2 * D, KIN(7) + l * D, modl + 4 * D, modl + 3 * D, (bf16*)(ws + WS_H), gw, ngw, lane, (float*)(ws + WS_HS));
        }
        SEAM(pb + 5);
        if (EN_G2 && IN(pb + 6)) for (int rep = 0; rep < REP_G; ++rep) {
            unsigned char* ws = KWS();
            pg8::Gemm g{(const bf16*)(ws + WS_H), (const bf16*)(ws + WS_W + (size_t)l * W_LAYER + W_1), M, FF, D / 2}; pg8::StaticOrder S; S.init(M, FF, G, bx);
            EpiRelu2I8 E{ws + WS_U, (const float*)(ws + WS_HS), (const unsigned*)(ws + WS_CTL) + CW_W1MAX + l};
            { PHASE_IDS pg8::gemm_phase<EpiRelu2I8, pg8::StaticOrder, MK_ALIGN, MK_SP2, false, true>(lds, g, S, E, tid); }
        }
        SEAM(pb + 6);
        if (EN_G3 && IN(pb + 7)) for (int rep = 0; rep < REP_G; ++rep) {
            unsigned char* ws = KWS();
            pg8::Gemm g{(const bf16*)(ws + WS_U), (const bf16*)(ws + WS_W + (size_t)l * W_LAYER + W_2), M, D, FF / 2}; pg8::StaticOrder S; S.init(M, D, G, bx);
            EpiY2 E{(bf16*)(ws + WS_Y2), (float*)(ws + WS_SS), 1.f / (U_SCALE * W2_SCALE)};
            { PHASE_IDS pg8::gemm_phase<EpiY2, pg8::StaticOrder, MK_ALIGN, MK_SP2, true>(lds, g, S, E, tid); }
        }
        SEAM(pb + 7);
        if (EN_ROW && IN(pb + 8)) {
            PHASE_IDS
            unsigned char* ws = KWS(); const float* MOD = (const float*)(ws + WS_MOD); const float* modl = MOD + (size_t)l * 16 * 6144; float* out = KOUT();
            if (l == 0) rowpass<true, true, true, false>(nullptr, out, (bf16*)(ws + WS_X1A), (bf16*)(ws + WS_X1B), (const bf16*)(ws + WS_Y2), (const float*)(ws + WS_SS), KIN(8) + l * D, modl + 5 * D, KIN(5) + D, MOD + (size_t)16 * 6144 + 1 * D, MOD + (size_t)16 * 6144 + 0 * D, (bf16*)(ws + WS_H), gw, ngw, lane);
            else rowpass<true, false, true, false>(nullptr, out, (bf16*)(ws + WS_X1A), (bf16*)(ws + WS_X1B), (const bf16*)(ws + WS_Y2), (const float*)(ws + WS_SS), KIN(8) + l * D, modl + 5 * D, nullptr, nullptr, nullptr, nullptr, gw, ngw, lane);
        }
        SEAM(pb + 8);
    }
#undef IN
#undef SEAM
}

#ifndef MK_N_LAUNCHES
#define MK_N_LAUNCHES 1
#endif
extern "C" void kernel_launch(void* const* d_in, const int* in_sizes, int n_in, void* d_out, int out_size, void* d_ws, size_t ws_size, hipStream_t stream) {
    static int grid = 0;
    if (grid == 0) {
        if (n_in != 20 || out_size != M * D || ws_size < WS_END) { fprintf(stderr, "kernel_launch: unexpected problem (n_in %d, out %d, ws %zu)\n", n_in, out_size, ws_size); grid = -1; return; }
        int dev = 0, cus = 0, per_cu = 0;
        if (hipGetDevice(&dev) != hipSuccess || hipDeviceGetAttribute(&cus, hipDeviceAttributeMultiprocessorCount, dev) != hipSuccess) { grid = -1; return; }
        if (hipFuncSetAttribute((const void*)mk_fwd, hipFuncAttributeMaxDynamicSharedMemorySize, LDS_BYTES) != hipSuccess) { fprintf(stderr, "kernel_launch: hipFuncSetAttribute failed\n"); grid = -1; return; }
        if (hipOccupancyMaxActiveBlocksPerMultiprocessor(&per_cu, (const void*)mk_fwd, NTHREADS, LDS_BYTES) != hipSuccess || per_cu < 1) fprintf(stderr, "kernel_launch: occupancy query says %d\n", per_cu);
        (void)hipGetLastError();
        grid = cus;
    }
    if (grid < 0) return;
    (void)hipMemsetAsync((char*)d_ws + WS_CTL, 0, CTL_ZERO_BYTES, stream);
    Args a{};
    for (int i = 0; i < 20; ++i) a.in[i] = d_in[i];
    a.out = (float*)d_out; a.ws = (unsigned char*)d_ws;
    if (MK_N_LAUNCHES == 1) { a.ph_lo = 0; a.ph_hi = NPHASES; hipLaunchKernelGGL(mk_fwd, dim3(grid), dim3(NTHREADS), LDS_BYTES, stream, a); }
    else for (int p = 0; p < NPHASES; ++p) { a.ph_lo = p; a.ph_hi = p + 1; hipLaunchKernelGGL(mk_fwd, dim3(grid), dim3(NTHREADS), LDS_BYTES, stream, a); }
}
```

```cpp
#include <hip/hip_runtime.h>
#include <cstdio>
#include <cstdint>
namespace pg8 {
#define PG8_LAS __attribute__((address_space(3)))
typedef unsigned short bf16_t;
typedef short bf16x8 __attribute__((ext_vector_type(8)));
typedef float f32x4 __attribute__((ext_vector_type(4)));
typedef unsigned u32x4 __attribute__((ext_vector_type(4)));
typedef int i32x4 __attribute__((ext_vector_type(4)));
typedef int i32x8 __attribute__((ext_vector_type(8)));
__device__ __forceinline__ i32x8 cat8(bf16x8 lo, bf16x8 hi) { return __builtin_shufflevector(__builtin_bit_cast(i32x4, lo), __builtin_bit_cast(i32x4, hi), 0, 1, 2, 3, 4, 5, 6, 7); }
constexpr int BM = 256, BK = 64, HALF = 128, HTB = HALF * BK * 2  , STAGE_BYTES = 8 * HTB, NXCD = 8, WGM = 8;

__host__ __device__ __forceinline__ int lds_byte(int r, int c) { const int st = (r >> 4) * 2 + (c >> 5), rr = r & 15, cc = c & 31, ob = rr * 64 + cc * 2; return st * 1024 + (ob ^ (((ob >> 9) & 1) << 5)); }
__host__ __device__ __forceinline__ void stage_rc(int b, int& R, int& C) { const int st = b / 1024, sb = b % 1024, swz = sb ^ (((sb >> 9) & 1) << 5); R = (st >> 1) * 16 + swz / 64; C = (st & 1) * 32 + (swz % 64) / 2; }
__host__ __device__ __forceinline__ int perm32(int rho) { const int n = rho >> 4, i = rho & 15; return 8 * (i >> 2) + 4 * n + (i & 3); }

struct Unit { int pm, pn; };
struct Gemm { const bf16_t* A; const bf16_t* Bt; int M, N, K; };

struct StaticOrder {
    int nM, nN, nwg, G, c;
    __host__ __device__ void init(int M, int N, int G_, int c_) { nM = M / BM; nN = N / BM; nwg = nM * nN; G = G_; c = c_; }
    __host__ __device__ bool next(int i, Unit& u) const {
        const long L = (long)i * G + c; if (L >= nwg) return false;
        int wgid = (int)L; { const int q = nwg / NXCD, r = nwg % NXCD, xcd = wgid % NXCD, off = wgid / NXCD; wgid = (xcd < r ? xcd * (q + 1) : r * (q + 1) + (xcd - r) * q) + off; }
        const int nig = WGM * nN, gid = wgid / nig, fm = gid * WGM, gsz = (nM - fm) < WGM ? (nM - fm) : WGM;
        u.pm = fm + ((wgid % nig) % gsz); u.pn = (wgid % nig) / gsz; return true;
    }
    __device__ __forceinline__ void a_ready(const Unit&) const {}
    __device__ __forceinline__ void done(const Unit&) const {}
};
struct MapOrder {
    StaticOrder S; int kind;
    __host__ __device__ void init(int M, int G_, int c_, int kind_) { kind = kind_; S.init(M, (kind_ ? 5 : 9) * BM, G_, c_); }
    __host__ __device__ bool next(int i, Unit& u) const { if (!S.next(i, u)) return false; const int p = u.pn; u.pn = kind ? (p < 2 ? 6 + p : (p < 4 ? 7 + p : 13)) : (p < 6 ? p : (p == 6 ? 8 : p + 4)); return true; }
    __device__ __forceinline__ void a_ready(const Unit&) const {}
    __device__ __forceinline__ void done(const Unit&) const {}
};

template <class Epi, class Sched, bool ALIGN_EPI = false, bool SP2 = false, bool F8 = false, bool I8 = false>
__device__ __forceinline__ void gemm_phase(PG8_LAS unsigned char* lds, const Gemm g, const Sched& S, const Epi& E, int tid_in) {
    int tid_o = tid_in; asm volatile("" : "+v"(tid_o));
    const int tid = tid_o, wid = __builtin_amdgcn_readfirstlane(tid >> 6), lane = tid & 63, wr = wid >> 2, wc = wid & 3, fr = lane & 15, fq = lane >> 4;
    const int K = g.K, nt = K / BK;
    unsigned voffA[2], voffB[2];
#pragma unroll
    for (int i = 0; i < 2; ++i) { int R, C; stage_rc(tid * 16 + i * 8192, R, C); const int Rb = Epi::PERM ? ((R & ~31) + perm32(R & 31)) : R;
        voffA[i] = (unsigned)(R * K + C) * 2u; voffB[i] = (unsigned)(Rb * K + C) * 2u; }
    const size_t kstep = (size_t)(BK * 2);
    const size_t hstep = (size_t)HALF * K * 2;
    const size_t tstep = 2 * hstep;
    const unsigned ldsw = (unsigned)wid * 1024u;
    const int aoff = lds_byte(wr * 64 + fr, fq * 8), boff = lds_byte(wc * 32 + fr, fq * 8);
#define PG8_SA(b, h) (((b) * 2 + (h)) * HTB)
#define PG8_SB(b, h) ((4 + (b) * 2 + (h)) * HTB)
#define PG8_STAGE(bufoff, gbase, voff) do { _Pragma("unroll") for (int _i = 0; _i < 2; ++_i) \
        __builtin_amdgcn_global_load_lds((const unsigned*)((const char*)(gbase) + (voff)[_i]), (PG8_LAS unsigned*)(lds + (bufoff) + ldsw + _i * 8192), 16, 0, 0); } while (0)
#define PG8_LDA(dst, b, h) do { _Pragma("unroll") for (int m = 0; m < 4; ++m) _Pragma("unroll") for (int k = 0; k < 2; ++k) dst[m][k] = *(const PG8_LAS bf16x8*)(lds + PG8_SA(b, h) + aoff + m * 2048 + k * 1024); } while (0)
#define PG8_LDB(dst, b, h) do { _Pragma("unroll") for (int n = 0; n < 2; ++n) _Pragma("unroll") for (int k = 0; k < 2; ++k) dst[n][k] = *(const PG8_LAS bf16x8*)(lds + PG8_SB(b, h) + boff + n * 2048 + k * 1024); } while (0)
#define PG8_MMA(ai, bj, At, Bt) do { __builtin_amdgcn_s_setprio(1); if constexpr (F8) { _Pragma("unroll") for (int m = 0; m < 4; ++m) _Pragma("unroll") for (int n = 0; n < 2; ++n) \
        acc[ai][bj][m][n] = __builtin_amdgcn_mfma_scale_f32_16x16x128_f8f6f4(cat8(Bt[n][0], Bt[n][1]), cat8(At[m][0], At[m][1]), acc[ai][bj][m][n], 0, 0, 0, 0, 0, 0); } else if constexpr (I8) { \
        _Pragma("unroll") for (int m = 0; m < 4; ++m) _Pragma("unroll") for (int n = 0; n < 2; ++n) _Pragma("unroll") for (int k = 0; k < 2; ++k) \
        acc[ai][bj][m][n] = __builtin_bit_cast(f32x4, __builtin_amdgcn_mfma_i32_16x16x64_i8(__builtin_bit_cast(i32x4, Bt[n][k]), __builtin_bit_cast(i32x4, At[m][k]), __builtin_bit_cast(i32x4, acc[ai][bj][m][n]), 0, 0, 0)); } else { \
        _Pragma("unroll") for (int m = 0; m < 4; ++m) _Pragma("unroll") for (int n = 0; n < 2; ++n) _Pragma("unroll") for (int k = 0; k < 2; ++k) \
        acc[ai][bj][m][n] = __builtin_amdgcn_mfma_f32_16x16x32_bf16(Bt[n][k], At[m][k], acc[ai][bj][m][n], 0, 0, 0); } __builtin_amdgcn_s_setprio(0); } while (0)
#define PG8_WAIT_V(n) asm volatile("s_waitcnt vmcnt(" #n ")" ::: "memory")
#define PG8_WAIT_L(n) asm volatile("s_waitcnt lgkmcnt(" #n ")" ::: "memory")
#define PG8_BAR __builtin_amdgcn_s_barrier()
#define PG8_SCHED __builtin_amdgcn_sched_barrier(0)
    Unit cur, nxt; int ui = 0;
    if (!S.next(0, cur)) return;
    f32x4 acc[2][2][4][2];
#pragma unroll
    for (int a = 0; a < 2; ++a)
#pragma unroll
        for (int b = 0; b < 2; ++b)
#pragma unroll
            for (int m = 0; m < 4; ++m)
#pragma unroll
                for (int n = 0; n < 2; ++n) acc[a][b][m][n] = (f32x4){0.f, 0.f, 0.f, 0.f};
    bf16x8 At[4][2], B0[2][2], B1[2][2];
    const char* cA = (const char*)g.A + (size_t)cur.pm * tstep; const char* cB = (const char*)g.Bt + (size_t)cur.pn * tstep;
    S.a_ready(cur);
    if constexpr (SP2) {
        PG8_STAGE(PG8_SB(0, 0), cB, voffB); PG8_STAGE(PG8_SB(0, 1), cB + hstep, voffB); PG8_STAGE(PG8_SA(0, 0), cA, voffA); PG8_STAGE(PG8_SA(0, 1), cA + hstep, voffA);
        if (wr == 1) PG8_BAR;
        PG8_WAIT_V(2); PG8_BAR;
        PG8_STAGE(PG8_SB(1, 0), cB + kstep, voffB); PG8_STAGE(PG8_SA(1, 0), cA + kstep, voffA); PG8_STAGE(PG8_SB(1, 1), cB + hstep + kstep, voffB);
        PG8_WAIT_V(6); PG8_BAR;
    } else {
        PG8_STAGE(PG8_SB(0, 0), cB, voffB); PG8_STAGE(PG8_SA(0, 0), cA, voffA); PG8_STAGE(PG8_SB(0, 1), cB + hstep, voffB); PG8_STAGE(PG8_SA(0, 1), cA + hstep, voffA);
        if (wr == 1) PG8_BAR;
        PG8_WAIT_V(4); PG8_BAR;
        PG8_STAGE(PG8_SB(1, 0), cB + kstep, voffB); PG8_STAGE(PG8_SA(1, 0), cA + kstep, voffA); PG8_STAGE(PG8_SB(1, 1), cB + hstep + kstep, voffB);
        PG8_WAIT_V(6); PG8_BAR;
    }
    for (;;) {
        const bool has_next = S.next(ui + 1, nxt);
        const char* nA = has_next ? (const char*)g.A + (size_t)nxt.pm * tstep : cA; const char* nB = has_next ? (const char*)g.Bt + (size_t)nxt.pn * tstep : cB;
        for (int t = 0; t < nt; t += 2) {
            if constexpr (F8) asm volatile("" : "+v"(voffA[0]), "+v"(voffA[1]), "+v"(voffB[0]), "+v"(voffB[1]));
            const bool last = (t == nt - 2);
            const char* a1 = cA + (size_t)(t + 1) * kstep;
            const char* a2 = last ? nA : cA + (size_t)(t + 2) * kstep; const char* b2 = last ? nB : cB + (size_t)(t + 2) * kstep;
            const char* a3 = a2 + kstep; const char* b3 = b2 + kstep;
            if (last && has_next) S.a_ready(nxt);
            if constexpr (SP2) {
            PG8_LDB(B0, 0, 0); PG8_LDB(B1, 0, 1); PG8_SCHED; PG8_LDA(At, 0, 0); PG8_STAGE(PG8_SA(1, 1), a1 + hstep, voffA);
            PG8_WAIT_V(8); PG8_WAIT_L(0); PG8_BAR; PG8_MMA(0, 0, At, B0); PG8_MMA(0, 1, At, B1); PG8_BAR; PG8_SCHED;
            PG8_LDA(At, 0, 1); PG8_STAGE(PG8_SB(0, 0), b2, voffB); PG8_STAGE(PG8_SB(0, 1), b2 + hstep, voffB); PG8_STAGE(PG8_SA(0, 0), a2, voffA);
            PG8_WAIT_V(8); PG8_WAIT_L(0); PG8_BAR; PG8_MMA(1, 0, At, B0); PG8_MMA(1, 1, At, B1); PG8_BAR; PG8_SCHED;
            PG8_LDB(B0, 1, 0); PG8_LDB(B1, 1, 1); PG8_SCHED; PG8_LDA(At, 1, 0); PG8_STAGE(PG8_SA(0, 1), a2 + hstep, voffA);
            PG8_WAIT_V(8); PG8_WAIT_L(0); PG8_BAR; PG8_MMA(0, 0, At, B0); PG8_MMA(0, 1, At, B1); PG8_BAR; PG8_SCHED;
            PG8_LDA(At, 1, 1); PG8_STAGE(PG8_SB(1, 0), b3, voffB); PG8_STAGE(PG8_SB(1, 1), b3 + hstep, voffB); PG8_STAGE(PG8_SA(1, 0), a3, voffA);
            PG8_WAIT_V(8); PG8_WAIT_L(0); PG8_BAR; PG8_MMA(1, 0, At, B0); PG8_MMA(1, 1, At, B1); PG8_BAR; PG8_SCHED;
            } else {
            PG8_LDB(B0, 0, 0); PG8_SCHED; PG8_LDA(At, 0, 0); PG8_STAGE(PG8_SA(1, 1), a1 + hstep, voffA);
            PG8_WAIT_L(8); PG8_BAR; PG8_WAIT_L(0); PG8_MMA(0, 0, At, B0); PG8_BAR; PG8_SCHED;
            PG8_LDB(B1, 0, 1); PG8_STAGE(PG8_SB(0, 0), b2, voffB);
            PG8_BAR; PG8_WAIT_L(0); PG8_MMA(0, 1, At, B1); PG8_BAR;
            PG8_LDA(At, 0, 1); PG8_STAGE(PG8_SA(0, 0), a2, voffA);
            PG8_BAR; PG8_WAIT_L(0); PG8_MMA(1, 0, At, B0); PG8_BAR; PG8_SCHED;
            PG8_STAGE(PG8_SB(0, 1), b2 + hstep, voffB);
            PG8_WAIT_V(6); PG8_BAR; PG8_MMA(1, 1, At, B1); PG8_BAR;
            PG8_LDB(B0, 1, 0); PG8_SCHED; PG8_LDA(At, 1, 0); PG8_STAGE(PG8_SA(0, 1), a2 + hstep, voffA);
            PG8_WAIT_L(8); PG8_BAR; PG8_WAIT_L(0); PG8_MMA(0, 0, At, B0); PG8_BAR; PG8_SCHED;
            PG8_LDB(B1, 1, 1); PG8_STAGE(PG8_SB(1, 0), b3, voffB);
            PG8_BAR; PG8_WAIT_L(0); PG8_MMA(0, 1, At, B1); PG8_BAR;
            PG8_LDA(At, 1, 1); PG8_STAGE(PG8_SA(1, 0), a3, voffA);
            PG8_BAR; PG8_WAIT_L(0); PG8_MMA(1, 0, At, B0); PG8_BAR; PG8_SCHED;
            PG8_STAGE(PG8_SB(1, 1), b3 + hstep, voffB);
            PG8_WAIT_V(6); PG8_BAR; PG8_MMA(1, 1, At, B1); PG8_BAR;
            }
        }
        if constexpr (ALIGN_EPI) { if (wr == 0) PG8_BAR; }
        if constexpr (!Epi::AFTER_DRAIN) {
            if constexpr (F8) { int le; asm volatile("v_mbcnt_lo_u32_b32 %0, -1, 0\n\tv_mbcnt_hi_u32_b32 %0, -1, %0" : "=v"(le)); E(acc, cur, wr, wc, le & 15, le >> 4); }
            else E(acc, cur, wr, wc, fr, fq);
            S.done(cur); }
        if (!has_next) break;
#pragma unroll
        for (int a = 0; a < 2; ++a)
#pragma unroll
            for (int b = 0; b < 2; ++b)
#pragma unroll
                for (int m = 0; m < 4; ++m)
#pragma unroll
                    for (int n = 0; n < 2; ++n) acc[a][b][m][n] = (f32x4){0.f, 0.f, 0.f, 0.f};
        cur = nxt; cA = nA; cB = nB; ++ui;
        if constexpr (ALIGN_EPI) { if (wr == 1) PG8_BAR; }
    }
    PG8_WAIT_V(0);
    if constexpr (!ALIGN_EPI) { if (wr == 0) PG8_BAR; }
    PG8_BAR;
    if constexpr (Epi::AFTER_DRAIN) { E.fused(acc, cur, wr, wc, fr, fq, lds, wid, lane); S.done(cur); }
#undef PG8_SA
#undef PG8_SB
#undef PG8_STAGE
#undef PG8_LDA
#undef PG8_LDB
#undef PG8_MMA
#undef PG8_WAIT_V
#undef PG8_WAIT_L
#undef PG8_BAR
#undef PG8_SCHED
}
}
#define LAS __attribute__((address_space(3)))
#define XB_TMO      128
#define XB_XCNT(j)  (256  + 64 * (j))
#define XB_XSUB(j)  (1280 + 64 * (j))
#define XB_XGEN(j)  (2304 + 64 * (j))
#define XB_TOP      3328
#define XB_TOPGEN   3392
#define XCD_BAR_WORDS 3456
#define XB_SPIN_CAP (1u << 18)

__device__ __forceinline__ unsigned xb_ld(unsigned* p)              { return __hip_atomic_load(p, __ATOMIC_RELAXED, __HIP_MEMORY_SCOPE_AGENT); }
__device__ __forceinline__ unsigned xb_add(unsigned* p, unsigned v) { return __hip_atomic_fetch_add(p, v, __ATOMIC_RELAXED, __HIP_MEMORY_SCOPE_AGENT); }
__device__ __forceinline__ unsigned xb_xcc_id() { return (unsigned)__builtin_amdgcn_s_getreg((3 << 11) | 20) & 0xFu; }
#define XB_SPIN(cond, bar) do { unsigned _sp = 0; while (cond) { __builtin_amdgcn_s_sleep(1); \
    if ((++_sp & 255u) == 0u) { if (xb_ld(&(bar)[XB_TMO])) break; if (_sp > XB_SPIN_CAP) { atomicAdd(&(bar)[XB_TMO], 1u); break; } } } } while (0)

struct XcdBarrier {
    unsigned* bar; unsigned x;
    volatile LAS unsigned* st;
};

__device__ __forceinline__ XcdBarrier xcd_barrier_post(unsigned* bar, volatile LAS unsigned* st) {
    XcdBarrier b; b.bar = bar; b.x = xb_xcc_id(); b.st = st;
    if (threadIdx.x == 0) (void)xb_add(&bar[XB_XCNT(b.x)], 1u);
    return b;
}
__device__ __forceinline__ void xcd_barrier_complete(unsigned* bar, unsigned x, unsigned& nloc, unsigned& nx) {
    const unsigned G = gridDim.x * gridDim.y * gridDim.z;
    unsigned sum, cnt, mine, sp = 0u;
    for (;;) {
        sum = 0u; cnt = 0u; mine = 0u;
#pragma unroll
        for (unsigned j = 0; j < 16; ++j) { const unsigned c = xb_ld(&bar[XB_XCNT(j)]); sum += c; cnt += (c > 0u) ? 1u : 0u; mine = (j == x) ? c : mine; }
        if (sum == G) break;
        __builtin_amdgcn_s_sleep(1);
        if ((++sp & 255u) == 0u) { if (xb_ld(&bar[XB_TMO])) break; if (sp > XB_SPIN_CAP) { atomicAdd(&bar[XB_TMO], 1u); break; } }
    }
    nloc = mine > 0u ? mine : 1u; nx = cnt > 0u ? cnt : 1u;
}

__device__ __forceinline__ void xcd_barrier(const XcdBarrier& b) {
    asm volatile("s_waitcnt vmcnt(0)" ::: "memory");
    __syncthreads();
    if (threadIdx.x == 0) {
        unsigned* bar = b.bar;
        __builtin_amdgcn_s_waitcnt(0);
        unsigned nloc = b.st[0], nx = b.st[1];
        if (nloc == 0u) { xcd_barrier_complete(bar, b.x, nloc, nx); b.st[0] = nloc; b.st[1] = nx; }
        const unsigned old = xb_add(&bar[XB_XSUB(b.x)], 1u);
        const unsigned gen = old / nloc;
        if (old + 1u == (gen + 1u) * nloc) {
            __builtin_amdgcn_fence(__ATOMIC_RELEASE, "agent");
            asm volatile("s_waitcnt vmcnt(0)" ::: "memory");
            const unsigned og = xb_add(&bar[XB_TOP], 1u);
            const unsigned tg = og / nx;
            if (og + 1u == (tg + 1u) * nx) xb_add(&bar[XB_TOPGEN], 1u);
            else XB_SPIN(xb_ld(&bar[XB_TOPGEN]) == tg, bar);
            __builtin_amdgcn_fence(__ATOMIC_ACQUIRE, "agent");
            xb_add(&bar[XB_XGEN(b.x)], 1u);
            asm volatile("s_waitcnt vmcnt(0)" ::: "memory");
        } else {
            XB_SPIN(xb_ld(&bar[XB_XGEN(b.x)]) == gen, bar);
            __builtin_amdgcn_fence(__ATOMIC_ACQUIRE, "agent");
            asm volatile("s_waitcnt vmcnt(0)" ::: "memory");
        }
    }
    __syncthreads();
}

constexpr int BATCH = 16, T = 4096, D = 1024, M = BATCH * T, NPROJ = 3584, NPROJ_SRC = 3544, FF = 4096, NCH = T / 64;
constexpr float EPS = 1e-6f;
constexpr float LOG2E = 1.44269504089f, INV2PI = 0.15915494309189535f;
constexpr float LOG2_5E5 = 18.931568569324174f, LOG2_1E4 = 13.287712379549449f;
constexpr int COL_AQ = 0, COL_AK = 256, COL_AV = 320, COL_AKI = 384, COL_CA = 448, COL_AWI = 464, COL_AQI = 512,
              COL_BQ = 1024, COL_BK = 1280, COL_BV = 1536, COL_BG = 1792, COL_CQ = 2048, COL_CK = 2176, COL_CV = 2304, COL_CG = 2560,
              COL_DQ = 2816, COL_DK = 3072, COL_DV = 3328;

constexpr size_t MiB = 1u << 20;
constexpr size_t WS_CTL = 0, CTL_ZERO_BYTES = 1 * MiB;
constexpr size_t WS_MOD = 1 * MiB;
constexpr size_t WS_SS = 2 * MiB;
constexpr size_t WS_GC = 6 * MiB;
constexpr size_t WS_W = 8 * MiB, W_LAYER = 25 * MiB, W_IN = 0, W_OUT = 7 * MiB, W_1 = 9 * MiB, W_2 = 17 * MiB;
constexpr size_t WS_H = 64 * MiB;
constexpr size_t WS_MASK = WS_H, WS_SCB = WS_H + 32 * MiB;
constexpr size_t WS_PROJ = 192 * MiB;
constexpr size_t WS_Y = 640 * MiB;
constexpr size_t WS_Y2 = 768 * MiB;
constexpr size_t WS_UB = WS_Y2, WS_RB = WS_Y2 + 64 * MiB, WS_UC = WS_Y2 + 96 * MiB;
constexpr size_t WS_U = WS_PROJ;
constexpr size_t WS_KIP = 896 * MiB;
constexpr size_t WS_X1A = 904 * MiB, WS_X1B = 704 * MiB;
constexpr size_t WS_END = 968 * MiB;
constexpr int CW_TMO = 0, CW_BAR = 4096, CW_W1MAX = 16, CW_WINMAX = 18;
constexpr size_t WS_HSP = 7 * MiB + 512 * 1024;
constexpr size_t WS_H8P = 640 * MiB;
constexpr size_t W_IN8 = 13 * MiB;
constexpr size_t WS_HS = 7 * MiB;

constexpr int SCRATCH_BYTES = 147456;
constexpr int LDSCTL_OFF = SCRATCH_BYTES, LDS_BYTES = SCRATCH_BYTES + 1024;
constexpr int NWAVES = 8, NTHREADS = 512;
constexpr int NPHASES = 20;

__host__ __device__ __forceinline__ size_t PX(size_t tok, int col) { return ((tok >> 6) * (NPROJ / 64) + (size_t)(col >> 6)) * 4096 + ((size_t)((col & 63) >> 3) * 64 + (tok & 63)) * 8 + (size_t)(col & 7); }
constexpr int PXC = 512;
constexpr size_t PX_TILE_STRIDE = (size_t)(NPROJ / 64) * 4096;
#define GAS __attribute__((address_space(1)))
#define LAS __attribute__((address_space(3)))
typedef unsigned short bf16;
typedef short bf16x8 __attribute__((ext_vector_type(8)));
typedef short s16x4 __attribute__((ext_vector_type(4)));
typedef float f32x4 __attribute__((ext_vector_type(4)));
typedef float f32x16 __attribute__((ext_vector_type(16)));
typedef unsigned u32x4 __attribute__((ext_vector_type(4)));
typedef unsigned u32x2 __attribute__((ext_vector_type(2)));
typedef float f32x2_t __attribute__((ext_vector_type(2)));
typedef __bf16 bf16x2_t __attribute__((ext_vector_type(2)));
typedef unsigned long long u64;

__device__ __forceinline__ unsigned cvtpk(float lo, float hi) { f32x2_t v = {lo, hi}; bf16x2_t b = __builtin_convertvector(v, bf16x2_t); return __builtin_bit_cast(unsigned, b); }
__device__ __forceinline__ bf16 f2bf(float f) { return (bf16)(cvtpk(f, 0.f) & 0xffffu); }
__device__ __forceinline__ float bf2f(short b) { return __uint_as_float(((unsigned)(unsigned short)b) << 16); }
__device__ __forceinline__ float bflo(unsigned w) { return __uint_as_float(w << 16); }
__device__ __forceinline__ float bfhi(unsigned w) { return __uint_as_float(w & 0xffff0000u); }
__device__ __forceinline__ bf16x8 ldg16(const bf16* p) { return *(const bf16x8*)p; }
__device__ __forceinline__ f32x16 mfma32(bf16x8 a, bf16x8 b, f32x16 c) { return __builtin_amdgcn_mfma_f32_32x32x16_bf16(a, b, c, 0, 0, 0); }
__device__ __forceinline__ int crow(int reg, int hh) { return (reg & 3) + 8 * (reg >> 2) + 4 * hh; }
__device__ __forceinline__ f32x16 zero16() { f32x16 z;
#pragma unroll
    for (int i = 0; i < 16; ++i) z[i] = 0.f; return z; }
#define LDS_FENCE() asm volatile("s_waitcnt lgkmcnt(0)" ::: "memory")
template <int S> __device__ __forceinline__ bf16x8 pack8(const f32x16& x) {
    u32x4 p; p.x = cvtpk(x[8 * S + 0], x[8 * S + 1]); p.y = cvtpk(x[8 * S + 2], x[8 * S + 3]); p.z = cvtpk(x[8 * S + 4], x[8 * S + 5]); p.w = cvtpk(x[8 * S + 6], x[8 * S + 7]);
    return __builtin_bit_cast(bf16x8, p);
}
typedef short v4i16_t __attribute__((ext_vector_type(4)));
__device__ __forceinline__ s16x4 vtr(const LAS unsigned char* p) { return __builtin_bit_cast(s16x4, __builtin_amdgcn_ds_read_tr16_b64_v4i16((LAS v4i16_t*)p)); }
__device__ __forceinline__ const LAS unsigned char* tr_base_perm(const LAS unsigned char* img, int lane) { return img + (4 * (lane >> 5) + ((lane & 15) >> 2)) * 64 + (16 * ((lane >> 4) & 1) + 4 * (lane & 3)) * 2; }
__device__ __forceinline__ const LAS unsigned char* tr_base_nat(const LAS unsigned char* img, int lane) { return img + (8 * (lane >> 5) + ((lane & 15) >> 2)) * 64 + (16 * ((lane >> 4) & 1) + 4 * (lane & 3)) * 2; }
template <int HALF, int K0> __device__ __forceinline__ bf16x8 ld_tr_perm(const LAS unsigned char* pb) {
    const s16x4 lo = vtr(pb + (HALF * 4096 + K0 * 64)), hi = vtr(pb + (HALF * 4096 + (K0 + 8) * 64));
    return __builtin_shufflevector(lo, hi, 0, 1, 2, 3, 4, 5, 6, 7);
}
template <int HALF, int K0> __device__ __forceinline__ bf16x8 ld_tr_nat(const LAS unsigned char* nb) {
    const s16x4 lo = vtr(nb + (HALF * 4096 + K0 * 64)), hi = vtr(nb + (HALF * 4096 + (K0 + 4) * 64));
    return __builtin_shufflevector(lo, hi, 0, 1, 2, 3, 4, 5, 6, 7);
}
template <int XM> __device__ __forceinline__ float swz_xor(float v) { return __int_as_float(__builtin_amdgcn_ds_swizzle(__float_as_int(v), (XM << 10) | 0x1f)); }
__device__ __forceinline__ float half_sum(float v) { const auto rr = __builtin_amdgcn_permlane32_swap(__float_as_uint(v), __float_as_uint(v), false, false); return __uint_as_float(rr[0]) + __uint_as_float(rr[1]); }
__device__ __forceinline__ float half_max(float v) { const auto rr = __builtin_amdgcn_permlane32_swap(__float_as_uint(v), __float_as_uint(v), false, false); return fmaxf(__uint_as_float(rr[0]), __uint_as_float(rr[1])); }
__device__ __forceinline__ int wave_sum_i(int v) {
    v += __builtin_amdgcn_update_dpp(0, v, 0xB1, 0xF, 0xF, true);
    v += __builtin_amdgcn_update_dpp(0, v, 0x4E, 0xF, 0xF, true);
    v += __builtin_amdgcn_update_dpp(0, v, 0x141, 0xF, 0xF, true);
    v += __builtin_amdgcn_update_dpp(0, v, 0x140, 0xF, 0xF, true);
    return __builtin_amdgcn_readlane(v, 0) + __builtin_amdgcn_readlane(v, 16) + __builtin_amdgcn_readlane(v, 32) + __builtin_amdgcn_readlane(v, 48);
}
__device__ __forceinline__ float wave_sum(float v) {
    v += swz_xor<1>(v); v += swz_xor<2>(v); v += swz_xor<4>(v); v += swz_xor<8>(v); v += swz_xor<16>(v);
    return half_sum(v);
}

struct EpiProj {
    static constexpr bool PERM = true, AFTER_DRAIN = false;
    bf16* O; const int* pos; bf16* KIP;
    __device__ __forceinline__ void operator()(const pg8::f32x4 (&acc)[2][2][4][2], const pg8::Unit& u, int wr, int wc, int fr, int fq) const {
        const int pn = u.pn;
        int mode = 0; float sc0 = 1.f, sc1 = 1.f; bool act = false;
        if (pn == 0) { mode = 1; sc0 = sc1 = 0.125f * LOG2E; act = true; }
        else if (pn == 1) { mode = 1; act = (wc < 2); if (wc == 2 && fq == 2) sc1 = 0.04419417382415922f; }
        else if (pn == 2 || pn == 3) { mode = 1; act = true; }
        else if (pn == 4) { mode = 2; sc0 = sc1 = 0.125f; act = true; }
        else if (pn == 5) { mode = 2; act = true; }
        else if (pn == 8) { sc0 = 0.17677669529663687f; }
        else if (pn == 11) { mode = 3; sc0 = sc1 = 0.17677669529663687f * LOG2E; act = true; }
        else if (pn == 12) { mode = 3; act = true; }
        float inv[2][2]; bool lane_act = false;
#pragma unroll
        for (int n = 0; n < 2; ++n)
#pragma unroll
            for (int p = 0; p < 2; ++p) {
                float e = 0.f;
                if (mode == 1) e = -(float)(4 * fq + 2 * n + p) * (LOG2_5E5 / 8.f);
                else if (mode == 2) e = -(float)(16 * (wc & 1) + 4 * fq + 2 * n + p) * (LOG2_1E4 / 32.f);
                else if (mode == 3) e = -(float)(2 * n + p) * (LOG2_5E5 / 4.f);
                inv[n][p] = exp2f(e);
            }
        if (mode == 1) lane_act = act && ((wc & 1) == 0) && (fq < 2);
        else if (mode == 2) lane_act = act;
        else if (mode == 3) lane_act = act && (fq == 0);
        const int row0 = u.pm * 256 + wr * 64 + fr;
        const int col0 = pn * 256 + wc * 32 + 8 * fq;
#pragma unroll
        for (int ai = 0; ai < 2; ++ai)
#pragma unroll
            for (int m = 0; m < 4; ++m) {
                const int row = row0 + ai * 128 + m * 16;
                float cs[2][2], sn[2][2];
                if (lane_act) {
                    const float pf = (float)pos[row];
#pragma unroll
                    for (int n = 0; n < 2; ++n)
#pragma unroll
                        for (int p = 0; p < 2; ++p) {
                            const float ang = pf * inv[n][p];
                            const float rv = __builtin_fmaf(ang, INV2PI, -__builtin_rintf(ang * INV2PI));
                            sn[n][p] = __builtin_amdgcn_sinf(rv); cs[n][p] = __builtin_amdgcn_cosf(rv);
                        }
                } else {
#pragma unroll
                    for (int n = 0; n < 2; ++n)
#pragma unroll
                        for (int p = 0; p < 2; ++p) { sn[n][p] = 0.f; cs[n][p] = 1.f; }
                }

#pragma unroll
                for (int bj = 0; bj < 2; ++bj) {
                    const float sc = bj ? sc1 : sc0;
                    pg8::f32x4 v0 = acc[ai][bj][m][0], v1 = acc[ai][bj][m][1];
                    float o[8];
                    o[0] = v0[0] * cs[0][0] - v0[1] * sn[0][0]; o[1] = v0[0] * sn[0][0] + v0[1] * cs[0][0];
                    o[2] = v0[2] * cs[0][1] - v0[3] * sn[0][1]; o[3] = v0[2] * sn[0][1] + v0[3] * cs[0][1];
                    o[4] = v1[0] * cs[1][0] - v1[1] * sn[1][0]; o[5] = v1[0] * sn[1][0] + v1[1] * cs[1][0];
                    o[6] = v1[2] * cs[1][1] - v1[3] * sn[1][1]; o[7] = v1[2] * sn[1][1] + v1[3] * cs[1][1];
                    u32x4 w; w.x = cvtpk(o[0] * sc, o[1] * sc); w.y = cvtpk(o[2] * sc, o[3] * sc); w.z = cvtpk(o[4] * sc, o[5] * sc); w.w = cvtpk(o[6] * sc, o[7] * sc);
                    *(u32x4*)(O + PX((size_t)row, col0 + bj * 128)) = w;
                    if (bj == 1 && pn == 1 && wc < 2)
                        *(u32x4*)(KIP + (size_t)(row >> 5) * 2048 + ((4 * wc + fq) * 32 + (row & 31)) * 8) = w;
                }
                asm volatile("" ::: "memory");
            }
    }
};
struct EpiProjI8 {
    static constexpr bool PERM = true, AFTER_DRAIN = false;
    bf16* O; const float* HS; const unsigned* WMAX;
    __device__ __forceinline__ void operator()(const pg8::f32x4 (&acc)[2][2][4][2], const pg8::Unit& u, int wr, int wc, int fr, int fq) const {
        const int row0 = u.pm * 256 + wr * 64 + fr, col0 = u.pn * 256 + wc * 32 + 8 * fq;
        const float sw = __uint_as_float(*WMAX) * (1.f / 127.f);
        float rs[2][4];
#pragma unroll
        for (int ai = 0; ai < 2; ++ai)
#pragma unroll
            for (int m = 0; m < 4; ++m) rs[ai][m] = HS[row0 + ai * 128 + m * 16];
#pragma unroll
        for (int ai = 0; ai < 2; ++ai)
#pragma unroll
            for (int m = 0; m < 4; ++m) {
                const int row = row0 + ai * 128 + m * 16; const float sc = rs[ai][m] * sw;
#pragma unroll
                for (int bj = 0; bj < 2; ++bj) {
                    const pg8::f32x4 a0 = acc[ai][bj][m][0], a1 = acc[ai][bj][m][1];
                    u32x4 w;
                    w.x = cvtpk((float)__float_as_int(a0[0]) * sc, (float)__float_as_int(a0[1]) * sc); w.y = cvtpk((float)__float_as_int(a0[2]) * sc, (float)__float_as_int(a0[3]) * sc);
                    w.z = cvtpk((float)__float_as_int(a1[0]) * sc, (float)__float_as_int(a1[1]) * sc); w.w = cvtpk((float)__float_as_int(a1[2]) * sc, (float)__float_as_int(a1[3]) * sc);
                    *(u32x4*)(O + PX((size_t)row, col0 + bj * 128)) = w;
                }
            }
    }
};
struct EpiY2 {
    static constexpr bool PERM = true, AFTER_DRAIN = false;
    bf16* O; float* SS; float osc;
    __device__ __forceinline__ void operator()(const pg8::f32x4 (&acc)[2][2][4][2], const pg8::Unit& u, int wr, int wc, int fr, int fq) const {
        const int row0 = u.pm * 256 + wr * 64 + fr, col0 = u.pn * 256 + wc * 32 + 8 * fq;
#pragma unroll
        for (int ai = 0; ai < 2; ++ai)
#pragma unroll
            for (int m = 0; m < 4; ++m) {
                const int row = row0 + ai * 128 + m * 16; float ss = 0.f;
                bf16* rowp = O + (size_t)row * D + col0;
#pragma unroll
                for (int bj = 0; bj < 2; ++bj) {
                    const pg8::f32x4 v0 = acc[ai][bj][m][0] * osc, v1 = acc[ai][bj][m][1] * osc;
                    ss += (v0[0] * v0[0] + v0[1] * v0[1]) + (v0[2] * v0[2] + v0[3] * v0[3]) + (v1[0] * v1[0] + v1[1] * v1[1]) + (v1[2] * v1[2] + v1[3] * v1[3]);
                    u32x4 w; w.x = cvtpk(v0[0], v0[1]); w.y = cvtpk(v0[2], v0[3]); w.z = cvtpk(v1[0], v1[1]); w.w = cvtpk(v1[2], v1[3]);
                    *(u32x4*)(rowp + bj * 128) = w;
                }
                ss += swz_xor<16>(ss); ss = half_sum(ss);
                if (fq == 0) SS[(size_t)row * 16 + u.pn * 4 + wc] = ss;
            }
    }
};
constexpr float U_SCALE = 4.f, W2_SCALE = 256.f;
__device__ __forceinline__ unsigned pk4_fp8(float a, float b, float c, float d) {
    int w = __builtin_amdgcn_cvt_pk_fp8_f32(a, b, 0, false); w = __builtin_amdgcn_cvt_pk_fp8_f32(c, d, w, true); return (unsigned)w;
}
struct EpiRelu2F8 {
    static constexpr bool PERM = true, AFTER_DRAIN = false;
    unsigned char* O;
    __device__ __forceinline__ void operator()(const pg8::f32x4 (&acc)[2][2][4][2], const pg8::Unit& u, int wr, int wc, int fr, int fq) const {
        const int row0 = u.pm * 256 + wr * 64 + fr, col0 = u.pn * 256 + wc * 32 + 8 * fq;
#pragma unroll
        for (int ai = 0; ai < 2; ++ai)
#pragma unroll
            for (int m = 0; m < 4; ++m) {
                unsigned char* rowp = O + (size_t)(row0 + ai * 128 + m * 16) * FF + col0;
#pragma unroll
                for (int bj = 0; bj < 2; ++bj) {
                    pg8::f32x4 v0 = acc[ai][bj][m][0], v1 = acc[ai][bj][m][1];
#pragma unroll
                    for (int j = 0; j < 4; ++j) { const float a = fmaxf(v0[j], 0.f), b = fmaxf(v1[j], 0.f); v0[j] = fminf(a * a * U_SCALE, 448.f); v1[j] = fminf(b * b * U_SCALE, 448.f); }
                    u32x2 w; w.x = pk4_fp8(v0[0], v0[1], v0[2], v0[3]); w.y = pk4_fp8(v1[0], v1[1], v1[2], v1[3]);
                    *(u32x2*)(rowp + bj * 128) = w;
                }
            }
    }
};
struct EpiRelu2I8 {
    static constexpr bool PERM = true, AFTER_DRAIN = false;
    unsigned char* O; const float* HS; const unsigned* WMAX;
    __device__ __forceinline__ void operator()(const pg8::f32x4 (&acc)[2][2][4][2], const pg8::Unit& u, int wr, int wc, int fr, int fq) const {
        const int row0 = u.pm * 256 + wr * 64 + fr, col0 = u.pn * 256 + wc * 32 + 8 * fq;
        const float sw = __uint_as_float(*WMAX) * (1.f / 127.f);
        float rs[2][4];
#pragma unroll
        for (int ai = 0; ai < 2; ++ai)
#pragma unroll
            for (int m = 0; m < 4; ++m) rs[ai][m] = HS[row0 + ai * 128 + m * 16];
#pragma unroll
        for (int ai = 0; ai < 2; ++ai)
#pragma unroll
            for (int m = 0; m < 4; ++m) {
                unsigned char* rowp = O + (size_t)(row0 + ai * 128 + m * 16) * FF + col0;
                const float sc = rs[ai][m] * sw;
#pragma unroll
                for (int bj = 0; bj < 2; ++bj) {
                    const pg8::f32x4 a0 = acc[ai][bj][m][0], a1 = acc[ai][bj][m][1];
                    float v0[4], v1[4];
#pragma unroll
                    for (int j = 0; j < 4; ++j) { const float a = fmaxf((float)__float_as_int(a0[j]) * sc, 0.f), b = fmaxf((float)__float_as_int(a1[j]) * sc, 0.f); v0[j] = fminf(a * a * U_SCALE, 448.f); v1[j] = fminf(b * b * U_SCALE, 448.f); }
                    u32x2 w; w.x = pk4_fp8(v0[0], v0[1], v0[2], v0[3]); w.y = pk4_fp8(v1[0], v1[1], v1[2], v1[3]);
                    *(u32x2*)(rowp + bj * 128) = w;
                }
            }
    }
};
struct EpiRelu2 {
    static constexpr bool PERM = true, AFTER_DRAIN = false;
    bf16* O;
    __device__ __forceinline__ void operator()(const pg8::f32x4 (&acc)[2][2][4][2], const pg8::Unit& u, int wr, int wc, int fr, int fq) const {
        const int row0 = u.pm * 256 + wr * 64 + fr, col0 = u.pn * 256 + wc * 32 + 8 * fq;
#pragma unroll
        for (int ai = 0; ai < 2; ++ai)
#pragma unroll
            for (int m = 0; m < 4; ++m) {
                bf16* rowp = O + (size_t)(row0 + ai * 128 + m * 16) * FF + col0;
#pragma unroll
                for (int bj = 0; bj < 2; ++bj) {
                    pg8::f32x4 v0 = acc[ai][bj][m][0], v1 = acc[ai][bj][m][1];
#pragma unroll
                    for (int j = 0; j < 4; ++j) { const float a = fmaxf(v0[j], 0.f), b = fmaxf(v1[j], 0.f); v0[j] = a * a; v1[j] = b * b; }
                    u32x4 w; w.x = cvtpk(v0[0], v0[1]); w.y = cvtpk(v0[2], v0[3]); w.z = cvtpk(v1[0], v1[1]); w.w = cvtpk(v1[2], v1[3]);
                    *(u32x4*)(rowp + bj * 128) = w;
                }
            }
    }
};

__device__ __forceinline__ int map_rope(int j, int R) { return (j < R) ? ((j >> 1) + (j & 1) * (R >> 1)) : j; }
__device__ __forceinline__ int win_src(int n) {
    if (n < 256) return (n >> 6) * 64 + map_rope(n & 63, 16);
    if (n < 320) return 256 + map_rope(n - 256, 16);
    if (n < 384) return 320 + (n - 320);
    if (n < 448) return 896 + map_rope(n - 384, 16);
    if (n < 464) return 2504 + (n - 448);
    if (n < 472) return 960 + (n - 464);
    if (n < 512) return -1;
    if (n < 1024) { const int m = n - 512; return 384 + (m >> 6) * 64 + map_rope(m & 63, 16); }
    if (n < 1280) { const int m = n - 1024; return 968 + (m >> 6) * 64 + map_rope(m & 63, 64); }
    if (n < 1536) { const int m = n - 1280; return 1224 + (m >> 6) * 64 + map_rope(m & 63, 64); }
    if (n < 1792) return 1480 + (n - 1536);
    if (n < 2048) return 1736 + (n - 1792);
    if (n < 2176) return 1992 + (n - 2048);
    if (n < 2304) return 2120 + (n - 2176);
    if (n < 2560) return 2248 + (n - 2304);
    if (n < 2816) return 2520 + (n - 2560);
    if (n < 3072) { const int m = n - 2816; return 2776 + (m >> 5) * 32 + map_rope(m & 31, 8); }
    if (n < 3328) { const int m = n - 3072; return 3032 + (m >> 5) * 32 + map_rope(m & 31, 8); }
    return 3288 + (n - 3328);
}
template <bool PERMUTE>
__device__ __forceinline__ void transpose_item(const float* W, int K, int Nsrc, int Nout, bf16* WT, LAS float* scr, int item, int lane) {
    const int nblk = Nout / 32, kb = item / nblk, nb = item % nblk, k0 = 64 * kb, n0 = 32 * nb;
    const int nn = n0 + (lane & 31); const int src = PERMUTE ? win_src(nn) : nn;
#pragma unroll 8
    for (int i = 0; i < 32; ++i) { const int kk = 2 * i + (lane >> 5); scr[kk * 33 + (lane & 31)] = (src >= 0) ? W[(size_t)(k0 + kk) * Nsrc + src] : 0.f; }
    LDS_FENCE();
    const int c = lane & 7;
#pragma unroll
    for (int j = 0; j < 4; ++j) { const int n = (lane >> 3) + 8 * j; const LAS float* s = scr + (8 * c) * 33 + n;
        u32x4 o; o.x = cvtpk(s[0 * 33], s[1 * 33]); o.y = cvtpk(s[2 * 33], s[3 * 33]); o.z = cvtpk(s[4 * 33], s[5 * 33]); o.w = cvtpk(s[6 * 33], s[7 * 33]);
        *(u32x4*)(WT + (size_t)(n0 + n) * K + k0 + 8 * c) = o; }
    LDS_FENCE();
}

__device__ __forceinline__ void transpose_item_i8(const float* W, int K, int N, unsigned char* WT, LAS float* scr, int item, int lane, float inv) {
    const int nblk = N / 32, kb = item / nblk, nb = item % nblk, k0 = 64 * kb, n0 = 32 * nb;
#pragma unroll 8
    for (int i = 0; i < 32; ++i) { const int kk = 2 * i + (lane >> 5); scr[kk * 33 + (lane & 31)] = W[(size_t)(k0 + kk) * N + n0 + (lane & 31)]; }
    LDS_FENCE();
    const int c = lane & 7;
#pragma unroll
    for (int j = 0; j < 4; ++j) { const int n = (lane >> 3) + 8 * j; const LAS float* s = scr + (8 * c) * 33 + n;
        unsigned o[2];
#pragma unroll
        for (int hwd = 0; hwd < 2; ++hwd) {
            const int q0 = (int)__builtin_rintf(s[(4 * hwd + 0) * 33] * inv), q1 = (int)__builtin_rintf(s[(4 * hwd + 1) * 33] * inv), q2 = (int)__builtin_rintf(s[(4 * hwd + 2) * 33] * inv), q3 = (int)__builtin_rintf(s[(4 * hwd + 3) * 33] * inv);
            o[hwd] = (unsigned)(q0 & 255) | ((unsigned)(q1 & 255) << 8) | ((unsigned)(q2 & 255) << 16) | ((unsigned)q3 << 24);
        }
        u32x2 ov; ov.x = o[0]; ov.y = o[1];
        *(u32x2*)(WT + (size_t)(n0 + n) * K + k0 + 8 * c) = ov; }
    LDS_FENCE();
}
__device__ __forceinline__ void transpose_item_i8_win(const float* W, unsigned char* WT, LAS float* scr, int kb, int n0, int lane, float inv) {
    const int k0 = 64 * kb; const int src = win_src(n0 + (lane & 31));
#pragma unroll 8
    for (int i = 0; i < 32; ++i) { const int kk = 2 * i + (lane >> 5); scr[kk * 33 + (lane & 31)] = (src >= 0) ? W[(size_t)(k0 + kk) * NPROJ_SRC + src] : 0.f; }
    LDS_FENCE();
    const int c = lane & 7;
#pragma unroll
    for (int j = 0; j < 4; ++j) { const int n = (lane >> 3) + 8 * j; const LAS float* s = scr + (8 * c) * 33 + n;
        unsigned o[2];
#pragma unroll
        for (int hwd = 0; hwd < 2; ++hwd) {
            const int q0 = (int)__builtin_rintf(s[(4 * hwd + 0) * 33] * inv), q1 = (int)__builtin_rintf(s[(4 * hwd + 1) * 33] * inv), q2 = (int)__builtin_rintf(s[(4 * hwd + 2) * 33] * inv), q3 = (int)__builtin_rintf(s[(4 * hwd + 3) * 33] * inv);
            o[hwd] = (unsigned)(q0 & 255) | ((unsigned)(q1 & 255) << 8) | ((unsigned)(q2 & 255) << 16) | ((unsigned)q3 << 24);
        }
        u32x2 ov; ov.x = o[0]; ov.y = o[1];
        *(u32x2*)(WT + (size_t)(n0 + n) * D + k0 + 8 * c) = ov; }
    LDS_FENCE();
}
__device__ __forceinline__ void transpose_item_f8(const float* W, int K, int N, unsigned char* WT, LAS float* scr, int item, int lane) {
    const int nblk = N / 32, kb = item / nblk, nb = item % nblk, k0 = 64 * kb, n0 = 32 * nb;
#pragma unroll 8
    for (int i = 0; i < 32; ++i) { const int kk = 2 * i + (lane >> 5); scr[kk * 33 + (lane & 31)] = W[(size_t)(k0 + kk) * N + n0 + (lane & 31)]; }
    LDS_FENCE();
    const int c = lane & 7;
#pragma unroll
    for (int j = 0; j < 4; ++j) { const int n = (lane >> 3) + 8 * j; const LAS float* s = scr + (8 * c) * 33 + n;
        float v[8];
#pragma unroll
        for (int e = 0; e < 8; ++e) v[e] = fminf(fmaxf(s[e * 33] * W2_SCALE, -448.f), 448.f);
        u32x2 o; o.x = pk4_fp8(v[0], v[1], v[2], v[3]); o.y = pk4_fp8(v[4], v[5], v[6], v[7]);
        *(u32x2*)(WT + (size_t)(n0 + n) * K + k0 + 8 * c) = o; }
    LDS_FENCE();
}

#ifndef ROWS_IN_FLIGHT
#define ROWS_IN_FLIGHT 2
#endif
__device__ __forceinline__ size_t x1_off(int m) { return (size_t)(m & (M / 2 - 1)) * D; }
__device__ __forceinline__ float wave_max(float v) {
    v = fmaxf(v, swz_xor<1>(v)); v = fmaxf(v, swz_xor<2>(v)); v = fmaxf(v, swz_xor<4>(v)); v = fmaxf(v, swz_xor<8>(v)); v = fmaxf(v, swz_xor<16>(v));
    return half_max(v);
}
template <bool HAS_RES, bool DO_H, bool XIN_BF, bool XOUT_BF, int H_I8 = 0>
__device__ __forceinline__ void rowpass(const float* xin, float* xout, bf16* xa, bf16* xb, const bf16* y2, const float* ss, const float* gpost, const float* gate,
                                        const float* gpre, const float* scale, const float* shift, bf16* hout, int gw, int ngw, int lane, float* hs = nullptr, unsigned char* h8 = nullptr) {
    constexpr int NR = ROWS_IN_FLIGHT;
    const int wpb = ngw / BATCH;
    if (wpb * BATCH != ngw || wpb == 0) return;
    const int b = gw / wpb, j0 = gw - b * wpb;
    f32x4 gpo[4], gat[4], gpr[4], scl[4], shf[4];
#pragma unroll
    for (int j = 0; j < 4; ++j) {
        const int c = 4 * lane + 256 * j;
        if (HAS_RES) { gpo[j] = *(const f32x4*)(gpost + c); gat[j] = *(const f32x4*)(gate + (size_t)b * 6144 + c); }
        if (DO_H) { gpr[j] = *(const f32x4*)(gpre + c); scl[j] = *(const f32x4*)(scale + (size_t)b * 6144 + c) + 1.0f; shf[j] = *(const f32x4*)(shift + (size_t)b * 6144 + c); }
    }
    for (int r0 = j0; r0 < T; r0 += NR * wpb) {
        int mm[NR]; bool live[NR];
#pragma unroll
        for (int u = 0; u < NR; ++u) { live[u] = (u == 0) || (r0 + u * wpb < T); mm[u] = b * T + (live[u] ? r0 + u * wpb : r0); }
        f32x4 v[NR][4]; float rstd[NR];
#pragma unroll
        for (int u = 0; u < NR; ++u)
#pragma unroll
            for (int j = 0; j < 4; ++j) {
                if (XIN_BF) { const u32x2 t = *(const u32x2*)((mm[u] < M / 2 ? xa : xb) + x1_off(mm[u]) + 4 * lane + 256 * j); v[u][j] = (f32x4){bflo(t.x), bfhi(t.x), bflo(t.y), bfhi(t.y)}; }
                else v[u][j] = *(const f32x4*)(xin + (size_t)mm[u] * D + 4 * lane + 256 * j);
            }
        if (HAS_RES) {
            u32x2 yy[NR][4];
#pragma unroll
            for (int u = 0; u < NR; ++u) {
                const float* sp = ss + (size_t)mm[u] * 16;
                const f32x4 s0 = *(const f32x4*)(sp), s1 = *(const f32x4*)(sp + 4), s2 = *(const f32x4*)(sp + 8), s3 = *(const f32x4*)(sp + 12);
                const float s = ((s0[0] + s0[1]) + (s0[2] + s0[3])) + ((s1[0] + s1[1]) + (s1[2] + s1[3])) + ((s2[0] + s2[1]) + (s2[2] + s2[3])) + ((s3[0] + s3[1]) + (s3[2] + s3[3]));
                rstd[u] = 1.0f / sqrtf(s * (1.f / D) + EPS);
#pragma unroll
                for (int j = 0; j < 4; ++j) yy[u][j] = *(const u32x2*)(y2 + (size_t)mm[u] * D + 4 * lane + 256 * j);
            }
#pragma unroll
            for (int u = 0; u < NR; ++u)
#pragma unroll
                for (int j = 0; j < 4; ++j) {
                    const int c = 4 * lane + 256 * j;
                    const f32x4 yv = {bflo(yy[u][j].x), bfhi(yy[u][j].x), bflo(yy[u][j].y), bfhi(yy[u][j].y)};
                    v[u][j] = v[u][j] + gat[j] * (yv * rstd[u] * gpo[j]);
                    if (live[u]) {
                        if (XOUT_BF) { u32x2 w; w.x = cvtpk(v[u][j][0], v[u][j][1]); w.y = cvtpk(v[u][j][2], v[u][j][3]); *(u32x2*)((mm[u] < M / 2 ? xa : xb) + x1_off(mm[u]) + c) = w; }
                        else *(f32x4*)(xout + (size_t)mm[u] * D + c) = v[u][j];
                    }
                }
        }
        if (DO_H) {
            float q[NR];
#pragma unroll
            for (int u = 0; u < NR; ++u) { q[u] = 0.f;
#pragma unroll
                for (int j = 0; j < 4; ++j) q[u] += (v[u][j][0] * v[u][j][0] + v[u][j][1] * v[u][j][1]) + (v[u][j][2] * v[u][j][2] + v[u][j][3] * v[u][j][3]); }
#pragma unroll
            for (int u = 0; u < NR; ++u) q[u] = wave_sum(q[u]);
#pragma unroll
            for (int u = 0; u < NR; ++u) {
                const float rstd2 = 1.0f / sqrtf(q[u] * (1.f / D) + EPS);
                if (H_I8) {
                    f32x4 hq[4]; float am = 0.f;
#pragma unroll
                    for (int j = 0; j < 4; ++j) { hq[j] = (v[u][j] * rstd2 * gpr[j]) * scl[j] + shf[j]; am = fmaxf(am, fmaxf(fmaxf(fabsf(hq[j][0]), fabsf(hq[j][1])), fmaxf(fabsf(hq[j][2]), fabsf(hq[j][3])))); }
                    am = fmaxf(wave_max(am), 1.0e-20f);
                    const float inv = 127.f / am;
                    unsigned char* hb = h8 + (size_t)mm[u] * D + 4 * lane;
#pragma unroll
                    for (int j = 0; j < 4; ++j) {
                        const int q0 = (int)__builtin_rintf(hq[j][0] * inv), q1 = (int)__builtin_rintf(hq[j][1] * inv), q2 = (int)__builtin_rintf(hq[j][2] * inv), q3 = (int)__builtin_rintf(hq[j][3] * inv);
                        const unsigned w = (unsigned)(q0 & 255) | ((unsigned)(q1 & 255) << 8) | ((unsigned)(q2 & 255) << 16) | ((unsigned)q3 << 24);
                        if (live[u]) *(unsigned*)(hb + 256 * j) = w;
                    }
                    if (live[u] && lane == 0) hs[mm[u]] = am * (1.f / 127.f);
                    if (H_I8 == 2) {
#pragma unroll
                        for (int j = 0; j < 4; ++j) { u32x2 w; w.x = cvtpk(hq[j][0], hq[j][1]); w.y = cvtpk(hq[j][2], hq[j][3]); if (live[u]) *(u32x2*)(hout + (size_t)mm[u] * D + 4 * lane + 256 * j) = w; }
                    }
                } else {
#pragma unroll
                for (int j = 0; j < 4; ++j) {
                    const int c = 4 * lane + 256 * j;
                    const f32x4 h = (v[u][j] * rstd2 * gpr[j]) * scl[j] + shf[j];
                    u32x2 w; w.x = cvtpk(h[0], h[1]); w.y = cvtpk(h[2], h[3]);
                    if (live[u]) *(u32x2*)(hout + (size_t)mm[u] * D + c) = w;
                }
                }
            }
        }
    }
}

__device__ __forceinline__ void store_pair16(const u32x2 a, const u32x2 b, bf16* p) {
    const auto r0 = __builtin_amdgcn_permlane32_swap(a.x, b.x, false, false), r1 = __builtin_amdgcn_permlane32_swap(a.y, b.y, false, false);
    u32x4 o; o.x = r0[0]; o.y = r1[0]; o.z = r0[1]; o.w = r1[1];
    *(u32x4*)p = o;
}
__device__ __forceinline__ void load_rows16(const bf16* p, int hh, u32x4 (&raw)[4]) {
#pragma unroll
    for (int me = 0; me < 2; ++me)
#pragma unroll
        for (int gp = 0; gp < 4; gp += 2) raw[me * 2 + (gp >> 1)] = *(const u32x4*)(p + (4 * me + gp + hh) * PXC);
}
__device__ __forceinline__ void unpack_pair16(const u32x4 raw, u32x2& ga, u32x2& gb) {
    const auto r0 = __builtin_amdgcn_permlane32_swap(raw.x, raw.z, false, false), r1 = __builtin_amdgcn_permlane32_swap(raw.y, raw.w, false, false);
    ga.x = r0[0]; ga.y = r1[0]; gb.x = r0[1]; gb.y = r1[1];
}
__device__ __forceinline__ void load_gains(const float* gptr, int hh, f32x4 (&gain)[8]) {
#pragma unroll
    for (int me = 0; me < 2; ++me)
#pragma unroll
        for (int g = 0; g < 4; ++g) gain[me * 4 + g] = *(const f32x4*)(gptr + 32 * me + 8 * g + 4 * hh);
}
template <bool GATE, bool FASTSILU>
__device__ __forceinline__ void headnorm_pair(const f32x16& resme, int me, int gp, int hh, float rstd, const f32x4 (&gain)[8], const u32x4 graw, bf16* outp) {
    u32x2 ga, gb, w[2];
    if (GATE) unpack_pair16(graw, ga, gb);
#pragma unroll
    for (int k = 0; k < 2; ++k) {
        const int g = gp + k;
        const f32x4 gv = gain[me * 4 + g];
        float o[4];
#pragma unroll
        for (int j = 0; j < 4; ++j) o[j] = resme[4 * g + j] * rstd * gv[j];
        if (GATE) {
            const u32x2 gg = k ? gb : ga;
            const float z[4] = {bflo(gg.x), bfhi(gg.x), bflo(gg.y), bfhi(gg.y)};
#pragma unroll
            for (int j = 0; j < 4; ++j) o[j] *= FASTSILU ? z[j] * __builtin_amdgcn_rcpf(1.f + __builtin_amdgcn_exp2f(-z[j] * LOG2E)) : z[j] / (1.f + __expf(-z[j]));
        }
        w[k].x = cvtpk(o[0], o[1]); w[k].y = cvtpk(o[2], o[3]);
    }
    store_pair16(w[0], w[1], outp + 32 * me + 8 * gp + 8 * hh);
}
template <bool CENTER, bool GATE>
__device__ __forceinline__ void headnorm_store(f32x16 (&res)[2], int hh_in, const float* gptr, const bf16* gateptr, float oscale, bf16* outp) {
    int hh = hh_in; asm volatile("" : "+v"(hh));
    f32x4 gain[8]; load_gains(gptr, hh, gain);
    u32x4 graw[4];
    if (GATE) load_rows16(gateptr, hh, graw);
    if (CENTER) {
        float s = 0.f;
#pragma unroll
        for (int me = 0; me < 2; ++me)
#pragma unroll
            for (int i = 0; i < 16; ++i) s += res[me][i];
        s = half_sum(s);
        const float mean = s * (1.f / 64.f);
#pragma unroll
        for (int me = 0; me < 2; ++me)
#pragma unroll
            for (int i = 0; i < 16; ++i) res[me][i] -= mean;
    }
    float q = 0.f;
#pragma unroll
    for (int me = 0; me < 2; ++me)
#pragma unroll
        for (int i = 0; i < 16; ++i) q += res[me][i] * res[me][i];
    q = half_sum(q);
    const float rstd = oscale / sqrtf(q * (1.f / 64.f) + EPS);
#pragma unroll
    for (int me = 0; me < 2; ++me)
#pragma unroll
        for (int gp = 0; gp < 4; gp += 2) headnorm_pair<GATE, false>(res[me], me, gp, hh, rstd, gain, GATE ? graw[me * 2 + (gp >> 1)] : (u32x4){0u, 0u, 0u, 0u}, outp);
}

#ifndef ATTN_PREFETCH
#define ATTN_PREFETCH 1
#endif
#ifndef ATTN_SB
#define ATTN_SB 0
#endif
template <bool CENTER>
__device__ __forceinline__ void headnorm_store_g(f32x16 (&res)[2], int hh_in, const float* gptr, const u32x4 (&graw)[4], float oscale, bf16* outp) {
    int hh = hh_in; asm volatile("" : "+v"(hh));
    f32x4 gain[8]; load_gains(gptr, hh, gain);
    if (CENTER) {
        float s = 0.f;
#pragma unroll
        for (int me = 0; me < 2; ++me)
#pragma unroll
            for (int i = 0; i < 16; ++i) s += res[me][i];
        s = half_sum(s);
        const float mean = s * (1.f / 64.f);
#pragma unroll
        for (int me = 0; me < 2; ++me)
#pragma unroll
            for (int i = 0; i < 16; ++i) res[me][i] -= mean;
    }
    float q = 0.f;
#pragma unroll
    for (int me = 0; me < 2; ++me)
#pragma unroll
        for (int i = 0; i < 16; ++i) q += res[me][i] * res[me][i];
    q = half_sum(q);
    const float rstd = oscale / sqrtf(q * (1.f / 64.f) + EPS);
#pragma unroll
    for (int me = 0; me < 2; ++me)
#pragma unroll
        for (int gp = 0; gp < 4; gp += 2) headnorm_pair<true, true>(res[me], me, gp, hh, rstd, gain, graw[me * 2 + (gp >> 1)], outp);
}

constexpr int ATTN_BUF = 64 * 144 + 8192;
template <int NC, int DK, bool MASKED>
__device__ __forceinline__ void attn_core(LAS unsigned char* lds, const bf16* kbase, const bf16* vbase, const bf16* qrow, int nt_block, int nt_wave,
                                          const u64* mrow, f32x16 (&o)[NC][2], float (&lsum)[NC], int tid, int lane) {
    static_assert((NC == 2 && !MASKED) || (NC == 1 && MASKED), "two maps unmasked (differential) or one map masked (DSA)");
    constexpr int KST = DK / 16;
    constexpr float THR = 14.f;
    const int r = lane & 31, hh = lane >> 5;
    bf16x8 qf[NC][KST];
#pragma unroll
    for (int cc = 0; cc < NC; ++cc)
#pragma unroll
        for (int s = 0; s < KST; ++s) qf[cc][s] = ldg16(qrow + ((cc * DK + 16 * s) / 8 + hh) * PXC);
    float negm[NC];
#pragma unroll
    for (int cc = 0; cc < NC; ++cc) { negm[cc] = 0.f; lsum[cc] = 0.f; o[cc][0] = zero16(); o[cc][1] = zero16(); }
    const int krow_ = tid >> 3, kch = tid & 7;
    const int ksw = krow_ * 144 + kch * 16, vsw = 64 * 144 + (kch >> 2) * 4096 + krow_ * 64 + (kch & 3) * 16;
    const int kfo = r * 144 + hh * 16;
    const int vto = (int)(tr_base_perm(lds + 64 * 144, lane) - lds);
    const bf16* kp = kbase + (kch * 64 + krow_) * 8; const bf16* vp = vbase + (kch * 64 + krow_) * 8;
    bf16x8 kreg = ldg16(kp), vreg = ldg16(vp);
    *(LAS bf16x8*)(lds + ksw) = kreg; *(LAS bf16x8*)(lds + vsw) = vreg;
    if (nt_block > 1) { kreg = ldg16(kp + PX_TILE_STRIDE); vreg = ldg16(vp + PX_TILE_STRIDE); }
    __syncthreads();
    for (int t = 0; t < nt_block; ++t) {
        LAS unsigned char* const buf = lds + (t & 1) * ATTN_BUF;
        if (t < nt_wave) {
            const LAS unsigned char* const kfb = buf + kfo; const LAS unsigned char* const vtb = buf + vto;
            if constexpr (NC == 2) {
                bf16x8 vf[2][4];
                vf[0][0] = ld_tr_perm<0, 0>(vtb); vf[0][1] = ld_tr_perm<0, 16>(vtb); vf[0][2] = ld_tr_perm<0, 32>(vtb); vf[0][3] = ld_tr_perm<0, 48>(vtb);
                vf[1][0] = ld_tr_perm<1, 0>(vtb); vf[1][1] = ld_tr_perm<1, 16>(vtb); vf[1][2] = ld_tr_perm<1, 32>(vtb); vf[1][3] = ld_tr_perm<1, 48>(vtb);
                f32x16 sa[2][2];
                if (__builtin_amdgcn_ballot_w64(negm[0] != 0.f || negm[1] != 0.f) == 0ull) {
#pragma unroll
                    for (int cc = 0; cc < 2; ++cc)
#pragma unroll
                        for (int kt = 0; kt < 2; ++kt) {
                            sa[cc][kt] = mfma32(*(const LAS bf16x8*)(kfb + (32 * kt * 144 + (cc * DK) * 2)), qf[cc][0], zero16());
#pragma unroll
                            for (int s = 1; s < KST; ++s) sa[cc][kt] = mfma32(*(const LAS bf16x8*)(kfb + (32 * kt * 144 + (cc * DK + 16 * s) * 2)), qf[cc][s], sa[cc][kt]);
                        }
                } else {
#pragma unroll
                    for (int cc = 0; cc < 2; ++cc)
#pragma unroll
                        for (int kt = 0; kt < 2; ++kt) {
                            f32x16 c0;
#pragma unroll
                            for (int i = 0; i < 16; ++i) c0[i] = negm[cc];
                            sa[cc][kt] = mfma32(*(const LAS bf16x8*)(kfb + (32 * kt * 144 + (cc * DK) * 2)), qf[cc][0], c0);
#pragma unroll
                            for (int s = 1; s < KST; ++s) sa[cc][kt] = mfma32(*(const LAS bf16x8*)(kfb + (32 * kt * 144 + (cc * DK + 16 * s) * 2)), qf[cc][s], sa[cc][kt]);
                        }
                }
#pragma unroll
                for (int cc = 0; cc < 2; ++cc) {
                    float tmax = sa[cc][0][0];
#pragma unroll
                    for (int i = 1; i < 16; ++i) tmax = fmaxf(tmax, sa[cc][0][i]);
#pragma unroll
                    for (int i = 0; i < 16; ++i) tmax = fmaxf(tmax, sa[cc][1][i]);
                    if (__builtin_amdgcn_ballot_w64(tmax > THR || (t == 0 && tmax < -24.f)) != 0ull) {
                        const float hm = half_max(tmax);
                        tmax = (hm > THR) ? hm : ((t == 0 && hm < -24.f) ? fmaxf(hm, -64.f) : 0.f);
                        const float alpha = __builtin_amdgcn_exp2f(-tmax);
                        negm[cc] -= tmax; lsum[cc] *= alpha;
#pragma unroll
                        for (int i = 0; i < 16; ++i) { o[cc][0][i] *= alpha; o[cc][1][i] *= alpha; sa[cc][0][i] -= tmax; sa[cc][1][i] -= tmax; }
                    }
                    float ps = 0.f;
#pragma unroll
                    for (int kt = 0; kt < 2; ++kt)
#pragma unroll
                        for (int i = 0; i < 16; ++i) { const float p = __builtin_amdgcn_exp2f(sa[cc][kt][i]); sa[cc][kt][i] = p; ps += p; }
                    lsum[cc] += ps;
                    const bf16x8 p00 = pack8<0>(sa[cc][0]), p01 = pack8<1>(sa[cc][0]), p10 = pack8<0>(sa[cc][1]), p11 = pack8<1>(sa[cc][1]);
                    o[cc][0] = mfma32(vf[0][0], p00, o[cc][0]); o[cc][0] = mfma32(vf[0][1], p01, o[cc][0]);
                    o[cc][0] = mfma32(vf[0][2], p10, o[cc][0]); o[cc][0] = mfma32(vf[0][3], p11, o[cc][0]);
                    o[cc][1] = mfma32(vf[1][0], p00, o[cc][1]); o[cc][1] = mfma32(vf[1][1], p01, o[cc][1]);
                    o[cc][1] = mfma32(vf[1][2], p10, o[cc][1]); o[cc][1] = mfma32(vf[1][3], p11, o[cc][1]);
                }
            } else {
                const u64 mw = mrow[t];
                bf16x8 vf[2][4];
                vf[0][0] = ld_tr_perm<0, 0>(vtb); vf[0][1] = ld_tr_perm<0, 16>(vtb); vf[0][2] = ld_tr_perm<0, 32>(vtb); vf[0][3] = ld_tr_perm<0, 48>(vtb);
                vf[1][0] = ld_tr_perm<1, 0>(vtb); vf[1][1] = ld_tr_perm<1, 16>(vtb); vf[1][2] = ld_tr_perm<1, 32>(vtb); vf[1][3] = ld_tr_perm<1, 48>(vtb);
                f32x16 sa[2];
#pragma unroll
                for (int kt = 0; kt < 2; ++kt) {
                    const unsigned m32 = (unsigned)(mw >> (32 * kt + 4 * hh));
#pragma unroll
                    for (int i = 0; i < 16; ++i) {
                        const int sel = __builtin_amdgcn_sbfe((int)m32, (i & 3) + 8 * (i >> 2), 1);
                        sa[kt][i] = __int_as_float((sel & __float_as_int(negm[0])) | (~sel & (int)0xF149F2CAu));
                    }
#pragma unroll
                    for (int s = 0; s < KST; ++s) sa[kt] = mfma32(*(const LAS bf16x8*)(kfb + (32 * kt * 144 + (16 * s) * 2)), qf[0][s], sa[kt]);
                }
#pragma unroll
                for (int kt = 0; kt < 2; ++kt) {
                    float tmax = sa[kt][0];
#pragma unroll
                    for (int i = 1; i < 16; ++i) tmax = fmaxf(tmax, sa[kt][i]);
                    if ((t == 0 && kt == 0) || __builtin_amdgcn_ballot_w64(tmax > THR) != 0ull) {
                        tmax = fmaxf(half_max(tmax), (t == 0 && kt == 0) ? -64.f : 0.f);
                        const float alpha = __builtin_amdgcn_exp2f(-tmax);
                        negm[0] -= tmax; lsum[0] *= alpha;
#pragma unroll
                        for (int i = 0; i < 16; ++i) { o[0][0][i] *= alpha; o[0][1][i] *= alpha; sa[kt][i] -= tmax; if (kt == 0) sa[1][i] -= tmax; }
                    }
                    float ps = 0.f;
#pragma unroll
                    for (int i = 0; i < 16; ++i) { const float p = __builtin_amdgcn_exp2f(sa[kt][i]); sa[kt][i] = p; ps += p; }
                    lsum[0] += ps;
                    const bf16x8 p0 = pack8<0>(sa[kt]), p1 = pack8<1>(sa[kt]);
                    o[0][0] = mfma32(vf[0][2 * kt], p0, o[0][0]); o[0][0] = mfma32(vf[0][2 * kt + 1], p1, o[0][0]);
                    o[0][1] = mfma32(vf[1][2 * kt], p0, o[0][1]); o[0][1] = mfma32(vf[1][2 * kt + 1], p1, o[0][1]);
                }
            }
        }
        if (t + 1 < nt_block) {
            LAS unsigned char* const nb = lds + ((t + 1) & 1) * ATTN_BUF;
            *(LAS bf16x8*)(nb + ksw) = kreg; *(LAS bf16x8*)(nb + vsw) = vreg;
            if (t + 2 < nt_block) { kreg = ldg16(kp + (size_t)(t + 2) * PX_TILE_STRIDE); vreg = ldg16(vp + (size_t)(t + 2) * PX_TILE_STRIDE); }
        }
        __syncthreads();
    }
}

__device__ __forceinline__ void diff_unit(LAS unsigned char* lds, const bf16* proj, bf16* Y, const float* hng, float lam, float lam_init, int b, int h, int qb, int tid, int lane, int wave) {
    const int q0 = 256 * qb, qtok = q0 + 32 * wave + (lane & 31), hh = lane >> 5;
    const size_t tokrow = (size_t)b * T + qtok;
    f32x16 o[2][2]; float ls[2];
    const int nt_block = (q0 + 256) / 64, nt_wave = ((q0 + 32 * wave) >> 6) + 1;
    attn_core<2, 32, false>(lds, proj + PX((size_t)b * T, COL_DK + h * 64), proj + PX((size_t)b * T, COL_DV + h * 64), proj + PX(tokrow, COL_DQ + h * 64), nt_block, nt_wave, nullptr, o, ls, tid, lane);
    const float l0 = half_sum(ls[0]), l1 = half_sum(ls[1]);
    const float i0 = 1.f / l0, i1 = lam / l1;
    f32x16 res[2];
#pragma unroll
    for (int me = 0; me < 2; ++me)
#pragma unroll
        for (int i = 0; i < 16; ++i) res[me][i] = o[0][me][i] * i0 - o[1][me][i] * i1;
    headnorm_store<false, false>(res, hh, hng + 768 + h * 64, nullptr, 1.f - lam_init, Y + tokrow * D + 768 + h * 64);
}
__device__ __forceinline__ void dsa_unit(LAS unsigned char* lds, const bf16* proj, const u64* mask, bf16* Y, const float* hng, int b, int qc, int tid, int lane, int wave) {
    const int head = wave >> 1, qtok = 64 * qc + 32 * (wave & 1) + (lane & 31), hh = lane >> 5;
    const size_t tokrow = (size_t)b * T + qtok;
    f32x16 o[1][2]; float ls[1];
    attn_core<1, 64, true>(lds, proj + PX((size_t)b * T, COL_AK), proj + PX((size_t)b * T, COL_AV), proj + PX(tokrow, COL_AQ + head * 64), qc + 1, qc + 1, mask + tokrow * 64, o, ls, tid, lane);
    const float l0 = half_sum(ls[0]), i0 = 1.f / l0;
    f32x16 res[2];
#pragma unroll
    for (int me = 0; me < 2; ++me)
#pragma unroll
        for (int i = 0; i < 16; ++i) res[me][i] = o[0][me][i] * i0;
    headnorm_store<false, false>(res, hh, hng + head * 64, nullptr, 1.f, Y + tokrow * D + head * 64);
}
#ifndef REP_IDX_MM
#define REP_IDX_MM 1
#endif
__device__ __forceinline__ void count8(int& acc0, int& acc1, float k0, float k1, float k2, float k3, float k4, float k5, float k6, float k7, float cand) {
    unsigned long long m0, m1, m2, m3, m4, m5, m6, m7, dmy;
    asm volatile(
        "v_cmp_ge_f32_e64 %2, %11, %19\n\t"
        "v_cmp_ge_f32_e64 %3, %12, %19\n\t"
        "v_cmp_ge_f32_e64 %4, %13, %19\n\t"
        "v_cmp_ge_f32_e64 %5, %14, %19\n\t"
        "v_cmp_ge_f32_e64 %6, %15, %19\n\t"
        "v_cmp_ge_f32_e64 %7, %16, %19\n\t"
        "v_cmp_ge_f32_e64 %8, %17, %19\n\t"
        "v_cmp_ge_f32_e64 %9, %18, %19\n\t"
        "v_addc_co_u32_e64 %0, %10, %0, 0, %2\n\t"
        "v_addc_co_u32_e64 %1, %10, %1, 0, %3\n\t"
        "v_addc_co_u32_e64 %0, %10, %0, 0, %4\n\t"
        "v_addc_co_u32_e64 %1, %10, %1, 0, %5\n\t"
        "v_addc_co_u32_e64 %0, %10, %0, 0, %6\n\t"
        "v_addc_co_u32_e64 %1, %10, %1, 0, %7\n\t"
        "v_addc_co_u32_e64 %0, %10, %0, 0, %8\n\t"
        "v_addc_co_u32_e64 %1, %10, %1, 0, %9"
        : "+v"(acc0), "+v"(acc1), "=&s"(m0), "=&s"(m1), "=&s"(m2), "=&s"(m3), "=&s"(m4), "=&s"(m5), "=&s"(m6), "=&s"(m7), "=&s"(dmy)
        : "v"(k0), "v"(k1), "v"(k2), "v"(k3), "v"(k4), "v"(k5), "v"(k6), "v"(k7), "v"(cand));
}
__device__ __forceinline__ float key_to_float(unsigned k) { return __uint_as_float((k & 0x80000000u) ? (k & 0x7fffffffu) : ~k); }
#define DPP_F(v, ctrl) __int_as_float(__builtin_amdgcn_update_dpp(0, __float_as_int(v), (ctrl), 0xF, 0xF, true))
__device__ __forceinline__ float wave_max_f(float v) {
    v = fmaxf(v, DPP_F(v, 0xB1)); v = fmaxf(v, DPP_F(v, 0x4E)); v = fmaxf(v, DPP_F(v, 0x141)); v = fmaxf(v, DPP_F(v, 0x140));
    const float a = __int_as_float(__builtin_amdgcn_readlane(__float_as_int(v), 0)), b = __int_as_float(__builtin_amdgcn_readlane(__float_as_int(v), 16));
    const float c = __int_as_float(__builtin_amdgcn_readlane(__float_as_int(v), 32)), d = __int_as_float(__builtin_amdgcn_readlane(__float_as_int(v), 48));
    return fmaxf(fmaxf(a, b), fmaxf(c, d));
}
__device__ __forceinline__ float wave_min_f(float v) { return -wave_max_f(-v); }
__device__ __forceinline__ unsigned wave_incl_scan(unsigned v) {
    v += (unsigned)__builtin_amdgcn_update_dpp(0, (int)v, 0x111, 0xF, 0xF, false);
    v += (unsigned)__builtin_amdgcn_update_dpp(0, (int)v, 0x112, 0xF, 0xF, false);
    v += (unsigned)__builtin_amdgcn_update_dpp(0, (int)v, 0x114, 0xF, 0xF, false);
    v += (unsigned)__builtin_amdgcn_update_dpp(0, (int)v, 0x118, 0xF, 0xF, false);
    v += (unsigned)__builtin_amdgcn_update_dpp(0, (int)v, 0x142, 0xA, 0xF, false);
    v += (unsigned)__builtin_amdgcn_update_dpp(0, (int)v, 0x143, 0xC, 0xF, false);
    return v;
}
template <int NG>
__device__ __forceinline__ bool topk_hist(const float (&x)[64], LAS unsigned* H, LAS float* LIST, float& tf, bool& found, int lane) {
    float g0 = x[0], g1 = x[1], g2 = x[2], g3 = x[3];
#pragma unroll
    for (int i = 4; i < 8 * NG; i += 4) { g0 = fmaxf(g0, x[i]); g1 = fmaxf(g1, x[i + 1]); g2 = fmaxf(g2, x[i + 2]); g3 = fmaxf(g3, x[i + 3]); }
    const float hi = wave_max_f(fmaxf(fmaxf(g0, g1), fmaxf(g2, g3))), lo = wave_min_f(fminf(fminf(g0, g1), fminf(g2, g3)));
    if (!(hi > lo) || !(lo > -3.0e38f) || !(hi < 3.0e38f)) return false;
    const float s4 = 16124.f / (hi - lo), hs4 = __builtin_fmaf(hi, s4, 0.25f);
    if (!(s4 < 1.0e30f)) return false;
#pragma unroll
    for (int k = 0; k < 16; ++k) *(LAS u32x4*)(H + 4 * (lane + 64 * k)) = (u32x4){0u, 0u, 0u, 0u};
    const float dummy = (float)(16128 + 4 * lane);
    const unsigned hbase = (unsigned)(__UINTPTR_TYPE__)H;
#pragma unroll
    for (int i = 0; i < 8 * NG; ++i) {
        const float t4 = __builtin_fmaf(x[i], -s4, hs4);
        __hip_atomic_fetch_add((LAS unsigned*)(__UINTPTR_TYPE__)(((unsigned)fminf(t4, dummy) & ~3u) | hbase), 1u, __ATOMIC_RELAXED, __HIP_MEMORY_SCOPE_WORKGROUP);
    }
    LDS_FENCE();
    const LAS unsigned* hp = H + 63 * lane;
    unsigned tot = 0u;
#pragma unroll
    for (int jb = 0; jb < 64; jb += 16) {
        unsigned hv[16];
#pragma unroll
        for (int j = 0; j < 16; ++j) hv[j] = (jb + j < 63) ? hp[jb + j] : 0u;
        __builtin_amdgcn_sched_barrier(0);
#pragma unroll
        for (int j = 0; j < 16; j += 2) tot += hv[j] + hv[j + 1];
        __builtin_amdgcn_sched_barrier(0);
    }
    const unsigned P = wave_incl_scan(tot);
    if (__builtin_amdgcn_readlane((int)P, 63) < 256) return false;
    const int Ls = __builtin_ctzll(__builtin_amdgcn_ballot_w64(P >= 256u));
    const unsigned basec = (unsigned)__builtin_amdgcn_readlane((int)(P - tot), Ls);
    const unsigned h = (lane < 63) ? H[63 * Ls + lane] : 0u;
    const unsigned Q = wave_incl_scan(h);
    const int js = __builtin_ctzll(__builtin_amdgcn_ballot_w64(basec + Q >= 256u));
    const int cab = (int)basec + __builtin_amdgcn_readlane((int)(Q - h), js), nB = __builtin_amdgcn_readlane((int)h, js);
    const int B = 63 * Ls + js, need = 256 - cab;
    const float lo4 = 4.f * (float)B;
    int ncand = 0;
#pragma unroll
    for (int g = 0; g < NG; ++g) {
        u64 m[8], any = 0ull;
#pragma unroll
        for (int k = 0; k < 8; ++k) { const float t4 = __builtin_fmaf(x[8 * g + k], -s4, hs4); m[k] = __builtin_amdgcn_ballot_w64(__float_as_uint(t4 - lo4) < 0x40800000u); any |= m[k]; }
        if (any != 0ull) {
#pragma unroll
            for (int k = 0; k < 8; ++k) if (m[k] != 0ull) {
                const int pos = ncand + (int)__builtin_amdgcn_mbcnt_hi((unsigned)(m[k] >> 32), __builtin_amdgcn_mbcnt_lo((unsigned)m[k], 0u));
                if (((m[k] >> lane) & 1ull) && pos < 256) LIST[pos] = x[8 * g + k];
                ncand += __builtin_popcountll(m[k]);
            }
        }
    }
    if (ncand != nB || ncand > 64 || need < 1 || need > ncand) return false;
    LDS_FENCE();
    const float c = (lane < ncand) ? LIST[lane] : -__builtin_inff();
    int G = 0, GE = 0;
    for (int i = 0; i < ncand; ++i) { const float v = LIST[i]; G += (v > c) ? 1 : 0; GE += (v >= c) ? 1 : 0; }
    const u64 ok = __builtin_amdgcn_ballot_w64(lane < ncand && G < need && need <= GE);
    if (ok == 0ull) return false;
    const int j0 = __builtin_ctzll(ok);
    tf = __int_as_float(__builtin_amdgcn_readlane(__float_as_int(c), j0));
    found = (__builtin_amdgcn_readlane(GE, j0) == need);
    return true;
}
template <int NG>
__device__ __forceinline__ void topk_search(const float (&x)[64], LAS unsigned* H, LAS float* LIST, float& tf, bool& found, u64& myword, int lane_o) {
    found = false;
    if (!topk_hist<NG>(x, H, LIST, tf, found, lane_o)) {
    unsigned Tk = 0u; found = false;
    for (int bit = 31; bit >= 0; --bit) {
        const unsigned cand = Tk | (1u << bit);
        const float cf = key_to_float(cand);
        int cl = 0, cl2 = 0;
#pragma unroll
        for (int g = 0; g < NG; ++g) count8(cl, cl2, x[8 * g], x[8 * g + 1], x[8 * g + 2], x[8 * g + 3], x[8 * g + 4], x[8 * g + 5], x[8 * g + 6], x[8 * g + 7], cf);
        const int cnt = wave_sum_i(cl + cl2);
        if (cnt >= 256) { Tk = cand; if (cnt == 256) { found = true; break; } }
    }
    tf = key_to_float(Tk);
    }
    if (found) {
#pragma unroll
        for (int i = 0; i < 8 * NG; ++i) {
            const u64 w = __ballot(x[i] >= tf);
            if (lane_o == i) myword = w;
            if ((i & 3) == 3) __builtin_amdgcn_sched_barrier(0);
        }
    }
}
__device__ __forceinline__ void indexer_unit(LAS unsigned char* lds, const bf16* proj, const bf16* kip, u64* mask, int b, int g8, int lane, int wave) {
    const int q0 = g8 * 8, qc = q0 >> 6, L = 64 * (qc + 1), nr = qc + 1;
    u64* mout = mask + ((size_t)b * T + q0 + wave) * 64;
    if (L <= 256) { u64 ones = ~0ull; asm volatile("" : "+v"(ones)); if (lane < nr) mout[lane] = ones; return; }
    LAS float* SCR = (LAS float*)lds;
    const int r = lane & 31, hh = lane >> 5;
    bf16x8 af[2][4]; float wv[2][2][8];
    {
        const int a_ = r >> 4, b_ = (r >> 3) & 1, c_ = (r >> 2) & 1, d_ = r & 3;
#pragma unroll
        for (int mi = 0; mi < 2; ++mi) {
            const bf16* qp = proj + PX((size_t)b * T + q0 + 4 * mi + 2 * a_ + c_, COL_AQI + (4 * b_ + d_) * 64) + hh * PXC;
#pragma unroll
            for (int s = 0; s < 4; ++s) af[mi][s] = ldg16(qp + 2 * s * PXC);
#pragma unroll
            for (int a = 0; a < 2; ++a) {
                const u32x4 w4 = *(const u32x4*)(proj + PX((size_t)b * T + q0 + 4 * mi + 2 * a + hh, COL_AWI));
                wv[mi][a][0] = bflo(w4.x); wv[mi][a][1] = bfhi(w4.x); wv[mi][a][2] = bflo(w4.y); wv[mi][a][3] = bfhi(w4.y);
                wv[mi][a][4] = bflo(w4.z); wv[mi][a][5] = bfhi(w4.z); wv[mi][a][6] = bflo(w4.w); wv[mi][a][7] = bfhi(w4.w);
            }
        }
    }
    const bf16* kb = kip + (size_t)b * (T / 32) * 2048 + lane * 8;
    const int ntl = L / 32;
    for (int rep_mm = 0; rep_mm < REP_IDX_MM; ++rep_mm) {
    bf16x8 b0[4], b1[4], b2[4];
#pragma unroll
    for (int s = 0; s < 4; ++s) { b0[s] = ldg16(kb + (size_t)wave * 2048 + s * 512); b1[s] = b0[s]; b2[s] = b0[s]; }
    if (wave + 8 < ntl) {
#pragma unroll
        for (int s = 0; s < 4; ++s) b1[s] = ldg16(kb + (size_t)(wave + 8) * 2048 + s * 512);
    }
    if (wave + 16 < ntl) {
#pragma unroll
        for (int s = 0; s < 4; ++s) b2[s] = ldg16(kb + (size_t)(wave + 16) * 2048 + s * 512);
    }
    auto tile = [&](int kt, bf16x8 (&bq)[4]) {
#pragma unroll
        for (int mi = 0; mi < 2; ++mi) {
            f32x16 acc = zero16();
#pragma unroll
            for (int s = 0; s < 4; ++s) acc = mfma32(af[mi][s], bq[s], acc);
#pragma unroll
            for (int a = 0; a < 2; ++a) {
                float sc = 0.f;
#pragma unroll
                for (int h8 = 0; h8 < 8; ++h8) { const int ri = __float_as_int(acc[8 * a + h8]); sc = __builtin_fmaf(__int_as_float(ri > 0 ? ri : 0), wv[mi][a][h8], sc); }
                SCR[(4 * mi + 2 * a + hh) * 4096 + 32 * kt + r] = sc;
            }
        }
        if (kt + 24 < ntl) {
#pragma unroll
            for (int s = 0; s < 4; ++s) bq[s] = ldg16(kb + (size_t)(kt + 24) * 2048 + s * 512);
        }
    };
    for (int kt = wave; kt < ntl; kt += 24) {
        tile(kt, b0);
        if (kt + 8 < ntl) tile(kt + 8, b1);
        if (kt + 16 < ntl) tile(kt + 16, b2);
    }
    }
    {
        LAS float* padrow = SCR + wave * 4096;
        const int Lp = ((nr + 7) & ~7) * 64;
        for (int c = L + lane; c < Lp; c += 64) padrow[c] = -__builtin_inff();
    }
    __syncthreads();
    const LAS float* myrow = SCR + wave * 4096;
    float x[64];
#pragma unroll
    for (int g = 0; g < 8; ++g) {
        if (8 * g < nr) {
#pragma unroll
            for (int i = 0; i < 8; ++i) x[8 * g + i] = myrow[64 * (8 * g + i) + lane];
        } else {
#pragma unroll
            for (int i = 0; i < 8; ++i) x[8 * g + i] = -__builtin_inff();
        }
    }
    float tf = 0.f; bool found = false; u64 myword = 0ull;
    LAS unsigned* HH = (LAS unsigned*)(SCR + wave * 4096); LAS float* LIST = (LAS float*)(lds + 131072 + wave * 2048);
    int lane_o = lane; asm volatile("" : "+v"(lane_o));
    switch ((nr + 7) >> 3) {
        case 1: topk_search<1>(x, HH, LIST, tf, found, myword, lane_o); break;
        case 2: topk_search<2>(x, HH, LIST, tf, found, myword, lane_o); break;
        case 3: topk_search<3>(x, HH, LIST, tf, found, myword, lane_o); break;
        case 4: topk_search<4>(x, HH, LIST, tf, found, myword, lane_o); break;
        case 5: topk_search<5>(x, HH, LIST, tf, found, myword, lane_o); break;
        case 6: topk_search<6>(x, HH, LIST, tf, found, myword, lane_o); break;
        case 7: topk_search<7>(x, HH, LIST, tf, found, myword, lane_o); break;
        default: topk_search<8>(x, HH, LIST, tf, found, myword, lane_o); break;
    }
    if (!found) {
        int cgt = 0;
#pragma unroll
        for (int i = 0; i < 64; ++i) { cgt += __popcll(__ballot(x[i] > tf)); if ((i & 3) == 3) __builtin_amdgcn_sched_barrier(0); }
        int need = 256 - cgt;
        float tf2 = tf; asm volatile("" : "+v"(tf2));
#pragma unroll
        for (int i = 0; i < 64; ++i) {
            u64 w = __ballot(x[i] > tf2);
            u64 e = __ballot(x[i] == tf2);
            if (need > 0 && e != 0ull) {
                const int c = __popcll(e);
                if (c <= need) { w |= e; need -= c; }
                else { for (int t2 = 0; t2 < need; ++t2) { const u64 low = e & (0ull - e); w |= low; e ^= low; } need = 0; }
            }
            if (lane_o == i) myword = w;
            if ((i & 3) == 3) __builtin_amdgcn_sched_barrier(0);
        }
    }
    if (lane < nr) mout[lane] = myword;
    __syncthreads();
}

__device__ __forceinline__ float ret_log2g(int h) { return log2f(1.f - exp2f(-5.f - (float)h)); }
template <bool SCALE>
__device__ __forceinline__ void stage_img64(LAS unsigned char* img, const bf16* proj, size_t tok0, int col, int lane, float scale) {
    const bf16* vp = proj + PX(tok0 + lane, col);
#pragma unroll
    for (int ch = 0; ch < 8; ++ch) {
        bf16x8 vv = ldg16(vp + ch * PXC);
        if (SCALE) { u32x4 w; w.x = cvtpk(bf2f(vv[0]) * scale, bf2f(vv[1]) * scale); w.y = cvtpk(bf2f(vv[2]) * scale, bf2f(vv[3]) * scale); w.z = cvtpk(bf2f(vv[4]) * scale, bf2f(vv[5]) * scale); w.w = cvtpk(bf2f(vv[6]) * scale, bf2f(vv[7]) * scale); vv = __builtin_bit_cast(bf16x8, w); }
        *(LAS bf16x8*)(img + (ch >> 2) * 4096 + lane * 64 + (ch & 3) * 16) = vv;
    }
}
__device__ __forceinline__ void ret_state_unit(LAS unsigned char* wl, const bf16* proj, float* UB, int b, int c, int h, int lane) {
    LAS unsigned char* VI = wl; LAS unsigned char* KI = wl + 8192;
    const size_t tok0 = (size_t)b * T + 64 * c;
    const int r = lane & 31, hh = lane >> 5;
    stage_img64<false>(VI, proj, tok0, COL_BV + h * 64, lane, 1.f);
    stage_img64<true>(KI, proj, tok0, COL_BK + h * 64, lane, exp2f((63.f - (float)lane) * ret_log2g(h)));
    LDS_FENCE();
    const LAS unsigned char* const vnb = tr_base_nat(VI, lane); const LAS unsigned char* const knb = tr_base_nat(KI, lane);
    float* ub = UB + (size_t)((b * NCH + c) * 4 + h) * 4096;
    f32x16 acc[2][2];
#pragma unroll
    for (int me = 0; me < 2; ++me)
#pragma unroll
        for (int nd = 0; nd < 2; ++nd) acc[me][nd] = zero16();
#define RS_STEP(K0) do { const bf16x8 a0 = ld_tr_nat<0, K0>(vnb), a1 = ld_tr_nat<1, K0>(vnb), b0_ = ld_tr_nat<0, K0>(knb), b1_ = ld_tr_nat<1, K0>(knb); \
        acc[0][0] = mfma32(a0, b0_, acc[0][0]); acc[0][1] = mfma32(a0, b1_, acc[0][1]); acc[1][0] = mfma32(a1, b0_, acc[1][0]); acc[1][1] = mfma32(a1, b1_, acc[1][1]); } while (0)
    RS_STEP(0); RS_STEP(16); RS_STEP(32); RS_STEP(48);
#undef RS_STEP
#pragma unroll
    for (int me = 0; me < 2; ++me)
#pragma unroll
        for (int nd = 0; nd < 2; ++nd)
#pragma unroll
            for (int i = 0; i < 16; ++i) ub[(32 * me + crow(i, hh)) * 64 + 32 * nd + r] = acc[me][nd][i];
    LDS_FENCE();
}
__device__ __forceinline__ void ret_out_unit(LAS unsigned char* wl, const bf16* proj, const bf16* RB, const float* hng, bf16* Y, int b, int c, int h, int lane_in) {
    int lane = lane_in; asm volatile("" : "+v"(lane));
    LAS unsigned char* VI = wl;
    const size_t tok0 = (size_t)b * T + 64 * c;
    const int r = lane & 31, hh = lane >> 5;
    bf16x8 vrow[8], kf[2][4], qf[2][4], rbf[2][4];
    {
        const bf16* vp = proj + PX(tok0 + lane, COL_BV + h * 64);
#pragma unroll
        for (int ch = 0; ch < 8; ++ch) vrow[ch] = ldg16(vp + ch * PXC);
        const bf16* rb = RB + (size_t)((b * NCH + c) * 4 + h) * 4096;
#pragma unroll
        for (int mi = 0; mi < 2; ++mi)
#pragma unroll
            for (int s = 0; s < 4; ++s) {
                kf[mi][s] = ldg16(proj + PX(tok0 + 32 * mi + r, COL_BK + h * 64) + (2 * s + hh) * PXC);
                if (mi == 0) qf[0][s] = ldg16(proj + PX(tok0 + r, COL_BQ + h * 64) + (2 * s + hh) * PXC);
                rbf[mi][s] = ldg16(rb + (32 * mi + r) * 64 + 16 * s + 8 * hh);
            }
    }
#pragma unroll
    for (int ch = 0; ch < 8; ++ch) *(LAS bf16x8*)(VI + (ch >> 2) * 4096 + lane * 64 + (ch & 3) * 16) = vrow[ch];
    LDS_FENCE();
    const LAS unsigned char* const vtb = tr_base_perm(VI, lane);
    const float lg = ret_log2g(h);
#pragma unroll
    for (int ni = 0; ni < 2; ++ni) {
        const int i_ = 32 * ni + r;
        u32x4 gt[4];
        load_rows16(proj + PX(tok0 + i_, COL_BG + h * 64), hh, gt);
        if (ni == 0) {
#pragma unroll
            for (int s = 0; s < 4; ++s) qf[1][s] = ldg16(proj + PX(tok0 + 32 + r, COL_BQ + h * 64) + (2 * s + hh) * PXC);
        }
        f32x16 out[2];
#pragma unroll
        for (int me = 0; me < 2; ++me) {
            out[me] = zero16();
#pragma unroll
            for (int s = 0; s < 4; ++s) out[me] = mfma32(rbf[me][s], qf[ni][s], out[me]);
        }
        const float xi = __builtin_amdgcn_exp2f((float)(i_ + 1) * lg);
#pragma unroll
        for (int me = 0; me < 2; ++me)
#pragma unroll
            for (int i = 0; i < 16; ++i) out[me][i] *= xi;
#pragma unroll
        for (int mi = 0; mi < 2; ++mi) {
            f32x16 x = zero16();
#pragma unroll
            for (int s = 0; s < 4; ++s) x = mfma32(kf[mi][s], qf[ni][s], x);
#pragma unroll
            for (int i = 0; i < 16; ++i) { const int j_ = 32 * mi + crow(i, hh); x[i] *= __builtin_amdgcn_exp2f(fabsf((float)(i_ - j_)) * lg); }
            const bf16x8 p0 = pack8<0>(x), p1 = pack8<1>(x);
            if (mi == 0) {
                out[0] = mfma32(ld_tr_perm<0, 0>(vtb), p0, out[0]); out[0] = mfma32(ld_tr_perm<0, 16>(vtb), p1, out[0]);
                out[1] = mfma32(ld_tr_perm<1, 0>(vtb), p0, out[1]); out[1] = mfma32(ld_tr_perm<1, 16>(vtb), p1, out[1]);
            } else {
                out[0] = mfma32(ld_tr_perm<0, 32>(vtb), p0, out[0]); out[0] = mfma32(ld_tr_perm<0, 48>(vtb), p1, out[0]);
                out[1] = mfma32(ld_tr_perm<1, 32>(vtb), p0, out[1]); out[1] = mfma32(ld_tr_perm<1, 48>(vtb), p1, out[1]);
            }
        }
        headnorm_store_g<true>(out, hh, hng + 256 + h * 64, gt, 1.f, Y + (tok0 + i_) * D + 256 + h * 64);
    }
    LDS_FENCE();
}

__device__ __forceinline__ void gla_cumsum(LAS float* BL, const bf16* proj, const float* wa2, const float* ba, size_t tok0, int h, int lane) {
    const int k = lane & 31, hh = lane >> 5;
    bf16x8 wf;
    {
        float w[8];
#pragma unroll
        for (int j = 0; j < 8; ++j) w[j] = wa2[(8 * hh + j) * 128 + h * 32 + k];
        u32x4 p; p.x = cvtpk(w[0], w[1]); p.y = cvtpk(w[2], w[3]); p.z = cvtpk(w[4], w[5]); p.w = cvtpk(w[6], w[7]);
        wf = __builtin_bit_cast(bf16x8, p);
    }
    const float bias = ba[h * 32 + k];
    const int tau = 16 * ((k >> 2) & 1) + 4 * (k >> 3) + (k & 3);
    f32x16 z[2];
#pragma unroll
    for (int mi = 0; mi < 2; ++mi) {
        const bf16x8 af = ldg16(proj + PX(tok0 + 32 * mi + tau, COL_CA) + hh * PXC);
        f32x16 c0;
#pragma unroll
        for (int i = 0; i < 16; ++i) c0[i] = bias;
        z[mi] = mfma32(af, wf, c0);
    }
    float tot[2];
#pragma unroll
    for (int mi = 0; mi < 2; ++mi) {
        float run = 0.f;
#pragma unroll
        for (int i = 0; i < 16; ++i) {
            const float e = __builtin_amdgcn_exp2f(fminf(-z[mi][i] * LOG2E, 120.f));
            run -= __builtin_amdgcn_logf(1.f + e) * (1.f / 16.f);
            z[mi][i] = run;
        }
        tot[mi] = run;
    }
    const float oth0 = __int_as_float(__builtin_amdgcn_ds_bpermute((lane ^ 32) << 2, __float_as_int(tot[0])));
    const float oth1 = __int_as_float(__builtin_amdgcn_ds_bpermute((lane ^ 32) << 2, __float_as_int(tot[1])));
    const float off0 = hh ? oth0 : 0.f, off1 = tot[0] + oth0 + (hh ? oth1 : 0.f);
#pragma unroll
    for (int i = 0; i < 16; ++i) { BL[(16 * hh + i) * 33 + k] = z[0][i] + off0; BL[(32 + 16 * hh + i) * 33 + k] = z[1][i] + off1; }
    LDS_FENCE();
}
__device__ __forceinline__ float clamp_exp(float x) { return __builtin_amdgcn_exp2f(fminf(fmaxf(x, -115.f), 115.f)); }
__device__ __forceinline__ void gla_state_unit(LAS unsigned char* wl, const bf16* proj, const float* wa2, const float* ba, float* UC, float* GC, int b, int c, int h, int lane) {
    LAS float* BL = (LAS float*)wl; LAS unsigned char* VI = wl; LAS unsigned char* KI = wl + 9216;
    const size_t tok0 = (size_t)b * T + 64 * c;
    const int r = lane & 31, hh = lane >> 5;
    gla_cumsum(BL, proj, wa2, ba, tok0, h, lane);
    {
        const bf16* kp = proj + PX(tok0 + lane, COL_CK + h * 32);
#pragma unroll
        for (int ch = 0; ch < 4; ++ch) { const bf16x8 kv = ldg16(kp + ch * PXC);
            float x[8];
#pragma unroll
            for (int i = 0; i < 8; ++i) { const int kk = 8 * ch + i; x[i] = bf2f(kv[i]) * clamp_exp(BL[63 * 33 + kk] - BL[lane * 33 + kk]); }
            u32x4 w; w.x = cvtpk(x[0], x[1]); w.y = cvtpk(x[2], x[3]); w.z = cvtpk(x[4], x[5]); w.w = cvtpk(x[6], x[7]);
            *(LAS u32x4*)(KI + lane * 64 + ch * 16) = w; }
        if (lane < 32) GC[(size_t)((b * NCH + c) * 4 + h) * 32 + lane] = clamp_exp(BL[63 * 33 + lane]);
    }
    LDS_FENCE();
    stage_img64<false>(VI, proj, tok0, COL_CV + h * 64, lane, 1.f);
    LDS_FENCE();
    const LAS unsigned char* const vnb = tr_base_nat(VI, lane); const LAS unsigned char* const knb = tr_base_nat(KI, lane);
    float* uc = UC + (size_t)((b * NCH + c) * 4 + h) * 2048;
    f32x16 acc[2]; acc[0] = zero16(); acc[1] = zero16();
#define GS_STEP(K0) do { const bf16x8 a0 = ld_tr_nat<0, K0>(vnb), a1 = ld_tr_nat<1, K0>(vnb), b0_ = ld_tr_nat<0, K0>(knb); acc[0] = mfma32(a0, b0_, acc[0]); acc[1] = mfma32(a1, b0_, acc[1]); } while (0)
    GS_STEP(0); GS_STEP(16); GS_STEP(32); GS_STEP(48);
#undef GS_STEP
#pragma unroll
    for (int me = 0; me < 2; ++me)
#pragma unroll
        for (int i = 0; i < 16; ++i) uc[(32 * me + crow(i, hh)) * 32 + r] = acc[me][i];
    LDS_FENCE();
}
__device__ __forceinline__ void gla_frag(const bf16x8 v, const LAS float* bl, bf16x8& fp, bf16x8& fm) {
    float xp[8], xm[8];
#pragma unroll
    for (int j = 0; j < 8; ++j) { const float x = bf2f(v[j]), bb = bl[j]; xp[j] = x * clamp_exp(bb); xm[j] = x * clamp_exp(-bb); }
    u32x4 a, c;
    a.x = cvtpk(xp[0], xp[1]); a.y = cvtpk(xp[2], xp[3]); a.z = cvtpk(xp[4], xp[5]); a.w = cvtpk(xp[6], xp[7]);
    c.x = cvtpk(xm[0], xm[1]); c.y = cvtpk(xm[2], xm[3]); c.z = cvtpk(xm[4], xm[5]); c.w = cvtpk(xm[6], xm[7]);
    fp = __builtin_bit_cast(bf16x8, a); fm = __builtin_bit_cast(bf16x8, c);
}
__device__ __forceinline__ void gla_out_unit(LAS unsigned char* wl, const bf16* proj, const float* wa2, const float* ba, const bf16* SCB, const float* hng, bf16* Y, int b, int c, int h, int lane_in) {
    int lane = lane_in; asm volatile("" : "+v"(lane));
    LAS unsigned char* VI = wl; LAS float* BL = (LAS float*)(wl + 9216);
    const size_t tok0 = (size_t)b * T + 64 * c;
    const int r = lane & 31, hh = lane >> 5;
    bf16x8 vrow[8], kraw[2][2], qraw[2][2], stf[2][2];
    {
        const bf16* vp = proj + PX(tok0 + lane, COL_CV + h * 64);
#pragma unroll
        for (int ch = 0; ch < 8; ++ch) vrow[ch] = ldg16(vp + ch * PXC);
        const bf16* sc = SCB + (size_t)((b * NCH + c) * 4 + h) * 2048;
#pragma unroll
        for (int mi = 0; mi < 2; ++mi)
#pragma unroll
            for (int s = 0; s < 2; ++s) {
                kraw[mi][s] = ldg16(proj + PX(tok0 + 32 * mi + r, COL_CK + h * 32) + (2 * s + hh) * PXC);
                if (mi == 0) qraw[0][s] = ldg16(proj + PX(tok0 + r, COL_CQ + h * 32) + (2 * s + hh) * PXC);
                stf[mi][s] = ldg16(sc + (32 * mi + r) * 32 + 16 * s + 8 * hh);
            }
    }
    gla_cumsum(BL, proj, wa2, ba, tok0, h, lane);
#pragma unroll
    for (int ch = 0; ch < 8; ++ch) *(LAS bf16x8*)(VI + (ch >> 2) * 4096 + lane * 64 + (ch & 3) * 16) = vrow[ch];
    LDS_FENCE();
    const LAS unsigned char* const vtb = tr_base_perm(VI, lane);
    bf16x8 kp_[2][2], km_[2][2];
#pragma unroll
    for (int mi = 0; mi < 2; ++mi)
#pragma unroll
        for (int s = 0; s < 2; ++s) gla_frag(kraw[mi][s], BL + (32 * mi + r) * 33 + 16 * s + 8 * hh, kp_[mi][s], km_[mi][s]);
#pragma unroll
    for (int ni = 0; ni < 2; ++ni) {
        const int t_ = 32 * ni + r;
        if (ni == 0) {
#pragma unroll
            for (int s = 0; s < 2; ++s) qraw[1][s] = ldg16(proj + PX(tok0 + 32 + r, COL_CQ + h * 32) + (2 * s + hh) * PXC);
        }
        bf16x8 qp_[2], qm_[2];
#pragma unroll
        for (int s = 0; s < 2; ++s) gla_frag(qraw[ni][s], BL + t_ * 33 + 16 * s + 8 * hh, qp_[s], qm_[s]);
        f32x16 out[2];
#pragma unroll
        for (int me = 0; me < 2; ++me) {
            out[me] = zero16();
#pragma unroll
            for (int s = 0; s < 2; ++s) out[me] = mfma32(stf[me][s], qp_[s], out[me]);
        }
#pragma unroll
        for (int mi = 0; mi < 2; ++mi) {
            f32x16 x;
            if (mi < ni) {
                x = zero16();
#pragma unroll
                for (int s = 0; s < 2; ++s) x = mfma32(km_[mi][s], qp_[s], x);
            } else if (mi > ni) {
                x = zero16();
#pragma unroll
                for (int s = 0; s < 2; ++s) x = mfma32(kp_[mi][s], qm_[s], x);
            } else {
                f32x16 x1 = zero16(), x2 = zero16();
#pragma unroll
                for (int s = 0; s < 2; ++s) { x1 = mfma32(km_[mi][s], qp_[s], x1); x2 = mfma32(kp_[mi][s], qm_[s], x2); }
#pragma unroll
                for (int i = 0; i < 16; ++i) x[i] = (crow(i, hh) <= r) ? x1[i] : x2[i];
            }
            const bf16x8 p0 = pack8<0>(x), p1 = pack8<1>(x);
            if (mi == 0) {
                out[0] = mfma32(ld_tr_perm<0, 0>(vtb), p0, out[0]); out[0] = mfma32(ld_tr_perm<0, 16>(vtb), p1, out[0]);
                out[1] = mfma32(ld_tr_perm<1, 0>(vtb), p0, out[1]); out[1] = mfma32(ld_tr_perm<1, 16>(vtb), p1, out[1]);
            } else {
                out[0] = mfma32(ld_tr_perm<0, 32>(vtb), p0, out[0]); out[0] = mfma32(ld_tr_perm<0, 48>(vtb), p1, out[0]);
                out[1] = mfma32(ld_tr_perm<1, 32>(vtb), p0, out[1]); out[1] = mfma32(ld_tr_perm<1, 48>(vtb), p1, out[1]);
            }
        }
        headnorm_store<true, true>(out, hh, hng + 512 + h * 64, proj + PX(tok0 + t_, COL_CG + h * 64), 1.f, Y + (tok0 + t_) * D + 512 + h * 64);
    }
    LDS_FENCE();
}

#ifndef EN_P0
#define EN_P0 1
#endif
#ifndef EN_ROW
#define EN_ROW 1
#endif
#ifndef EN_G0
#define EN_G0 1
#endif
#ifndef EN_M1
#define EN_M1 1
#endif
#ifndef EN_M2
#define EN_M2 1
#endif
#ifndef EN_M3
#define EN_M3 1
#endif
#ifndef EN_G1
#define EN_G1 1
#endif
#ifndef EN_G2
#define EN_G2 1
#endif
#ifndef EN_G3
#define EN_G3 1
#endif
#ifndef EN_M1A
#define EN_M1A 1
#endif
#ifndef EN_M1A2
#define EN_M1A2 1
#endif
#ifndef EN_M1B
#define EN_M1B 1
#endif
#ifndef EN_M1C
#define EN_M1C 1
#endif
#ifndef EN_M3A
#define EN_M3A 1
#endif
#ifndef EN_M3B
#define EN_M3B 1
#endif
struct Args { const void* in[20]; float* out; unsigned char* ws; int ph_lo, ph_hi; };
#ifndef MK_ALIGN
#define MK_ALIGN true
#endif
#ifndef MK_SP2
#define MK_SP2 true
#endif

#ifndef REP_M1A
#define REP_M1A 1
#endif
#ifndef REP_M1B
#define REP_M1B 1
#endif
#ifndef REP_M1C
#define REP_M1C 1
#endif
#ifndef REP_M2A
#define REP_M2A 1
#endif
#ifndef REP_M2B
#define REP_M2B 1
#endif
#ifndef REP_M3
#define REP_M3 1
#endif
#ifndef REP_G
#define REP_G 1
#endif
#ifndef EN_SEAM
#define EN_SEAM 1
#endif
#ifndef NLAYER_LOOP
#define NLAYER_LOOP 2
#endif
__device__ __forceinline__ unsigned long long karg_raw(int idx) {
    const __attribute__((address_space(4))) unsigned char* k = (const __attribute__((address_space(4))) unsigned char*)__builtin_amdgcn_kernarg_segment_ptr();
    const unsigned long long v = *(const volatile __attribute__((address_space(4))) unsigned long long*)(k + 8 * idx);
    const unsigned lo = __builtin_amdgcn_readfirstlane((unsigned)v), hi = __builtin_amdgcn_readfirstlane((unsigned)(v >> 32));
    return ((unsigned long long)hi << 32) | lo;
}
template <class Tp> __device__ __forceinline__ Tp* kptr(int idx) { return (Tp*)(GAS Tp*)karg_raw(idx); }
#define KIN(idx) kptr<const float>(idx)
#define KWS() kptr<unsigned char>(21)
#define KOUT() kptr<float>(20)

__global__ void __launch_bounds__(NTHREADS, 2) mk_fwd(Args args) {
    extern __shared__ __attribute__((aligned(16))) unsigned char lds_raw[];
    LAS unsigned char* lds = (LAS unsigned char*)lds_raw;
    const int G = gridDim.x, bx = blockIdx.x;
    const int wave_s = __builtin_amdgcn_readfirstlane(threadIdx.x >> 6);
#define PHASE_IDS int tid; asm volatile("v_mbcnt_lo_u32_b32 %0, -1, 0\n\tv_mbcnt_hi_u32_b32 %0, -1, %0\n\tv_lshl_add_u32 %0, %1, 6, %0" : "=&v"(tid) : "s"(wave_s)); const int lane = tid & 63, wave = __builtin_amdgcn_readfirstlane(tid >> 6); const int gw = bx * NWAVES + wave, ngw = G * NWAVES; (void)gw; (void)ngw; (void)lane;

    for (int u = threadIdx.x; u < (LDS_BYTES - LDSCTL_OFF) / 4; u += NTHREADS) ((LAS unsigned*)(lds + LDSCTL_OFF))[u] = 0u;
    __syncthreads();
    const int lo = args.ph_lo, hi = args.ph_hi;
    if (hi - lo > 1) (void)xcd_barrier_post((unsigned*)(KWS() + WS_CTL) + CW_BAR, (volatile LAS unsigned*)(lds + LDSCTL_OFF));
#define IN(k) (lo <= (k) && (k) < hi)
#define SEAM(k) do { if (EN_SEAM && IN(k) && IN((k) + 1)) { XcdBarrier b_; b_.bar = (unsigned*)(KWS() + WS_CTL) + CW_BAR; b_.x = xb_xcc_id(); b_.st = (volatile LAS unsigned*)(lds + LDSCTL_OFF); xcd_barrier(b_); } } while (0)

    if (EN_P0 && IN(0)) {
        PHASE_IDS
        unsigned char* ws = KWS();
        LAS float* scr = (LAS float*)(lds + wave * 8448);
        constexpr int I_IN = (D / 64) * (NPROJ / 32), I_OUT = (D / 64) * (D / 32), I_1 = (D / 64) * (FF / 32), I_2 = (FF / 64) * (D / 32), I_AIN = (D * NPROJ_SRC) / 2048, I_L = I_IN + I_OUT + I_1 + I_2 + I_AIN;
        static_assert((D * NPROJ_SRC) % 2048 == 0, "w_in absmax items");
        {
            LAS float* condT = (LAS float*)lds;
            LAS float* part = (LAS float*)(lds + 65536);
            const float* c_in = KIN(1); const float* mod_w = KIN(3); const float* mod_b = KIN(4); float* MOD = (float*)(ws + WS_MOD);
            for (int i = tid; i < BATCH * D; i += NTHREADS) { const int b = i >> 10, k = i & 1023; const float v = c_in[i]; condT[k * 16 + b] = v / (1.f + expf(-v)); }
            __syncthreads();
            for (int cg = bx; cg < 256; cg += G) {
                const int l = cg >> 7, jj = 48 * (cg & 127) + (lane < 48 ? lane : 0);
                float acc[16];
#pragma unroll
                for (int b = 0; b < 16; ++b) acc[b] = 0.f;
                const float* wp = mod_w + ((size_t)l * D + 128 * wave) * 6144 + jj;
#pragma unroll 16
                for (int k = 0; k < 128; ++k) {
                    const float w = wp[(size_t)k * 6144];
                    const LAS float* cp = condT + (128 * wave + k) * 16;
                    const f32x4 c0 = *(const LAS f32x4*)(cp), c1 = *(const LAS f32x4*)(cp + 4), c2 = *(const LAS f32x4*)(cp + 8), c3 = *(const LAS f32x4*)(cp + 12);
#pragma unroll
                    for (int b = 0; b < 4; ++b) { acc[b] += c0[b] * w; acc[4 + b] += c1[b] * w; acc[8 + b] += c2[b] * w; acc[12 + b] += c3[b] * w; }
                }
                if (lane < 48) {
#pragma unroll
                    for (int b = 0; b < 16; ++b) part[(wave * 16 + b) * 48 + lane] = acc[b];
                }
                __syncthreads();
                for (int o = tid; o < 768; o += NTHREADS) {
                    const int b = o / 48, cc = o % 48, j = 48 * (cg & 127) + cc;
                    float s = mod_b[l * 6144 + j];
#pragma unroll
                    for (int w8 = 0; w8 < 8; ++w8) s += part[(w8 * 16 + b) * 48 + cc];
                    MOD[(size_t)(l * 16 + b) * 6144 + j] = s;
                }
                __syncthreads();
            }
        }
        const float* w_in = KIN(9); const float* w_out = KIN(17); const float* mlp_w1 = KIN(18); const float* mlp_w2 = KIN(19);
        for (int it = gw; it < 2 * I_L; it += ngw) {
            const int l = it / I_L; int rr = it % I_L;
            unsigned char* wl = ws + WS_W + (size_t)l * W_LAYER;
            if (rr < I_IN) { transpose_item<true>(w_in + (size_t)l * D * NPROJ_SRC, D, NPROJ_SRC, NPROJ, (bf16*)(wl + W_IN), scr, rr, lane); continue; } rr -= I_IN;
            if (rr < I_OUT) { transpose_item<false>(w_out + (size_t)l * D * D, D, D, D, (bf16*)(wl + W_OUT), scr, rr, lane); continue; } rr -= I_OUT;
            if (rr < I_1) {
                const float* wp = mlp_w1 + (size_t)l * D * FF + (size_t)rr * 2048 + 4 * lane; float am = 0.f;
#pragma unroll
                for (int j = 0; j < 8; ++j) { const f32x4 t = *(const f32x4*)(wp + 256 * j); am = fmaxf(am, fmaxf(fmaxf(fabsf(t[0]), fabsf(t[1])), fmaxf(fabsf(t[2]), fabsf(t[3])))); }
                am = wave_max(am);
                if (lane == 0) atomicMax((unsigned*)(ws + WS_CTL) + CW_W1MAX + l, __float_as_uint(am));
                continue; } rr -= I_1;
            if (rr < I_2) { transpose_item_f8(mlp_w2 + (size_t)l * FF * D, FF, D, wl + W_2, scr, rr, lane); continue; } rr -= I_2;
            {
                const float* wp = w_in + (size_t)l * D * NPROJ_SRC + (size_t)rr * 2048 + 4 * lane; float am = 0.f;
#pragma unroll
                for (int j = 0; j < 8; ++j) { const f32x4 t = *(const f32x4*)(wp + 256 * j); am = fmaxf(am, fmaxf(fmaxf(fabsf(t[0]), fabsf(t[1])), fmaxf(fabsf(t[2]), fabsf(t[3])))); }
                am = wave_max(am);
                if (lane == 0) atomicMax((unsigned*)(ws + WS_CTL) + CW_WINMAX + l, __float_as_uint(am));
            }
        }
    }
    SEAM(0);
    if (EN_ROW && IN(1)) { PHASE_IDS unsigned char* ws = KWS(); const float* MOD = (const float*)(ws + WS_MOD);
        {
            LAS float* scr = (LAS float*)(lds + wave * 8448); const float* mlp_w1 = KIN(18);
            constexpr int I_1 = (D / 64) * (FF / 32);
            for (int it = gw; it < 2 * I_1; it += ngw) {
                const int l = it / I_1, rr = it % I_1;
                const float amax = fmaxf(__uint_as_float(__hip_atomic_load((unsigned*)(ws + WS_CTL) + CW_W1MAX + l, __ATOMIC_RELAXED, __HIP_MEMORY_SCOPE_AGENT)), 1.0e-30f);
                transpose_item_i8(mlp_w1 + (size_t)l * D * FF, D, FF, ws + WS_W + (size_t)l * W_LAYER + W_1, scr, rr, lane, 127.f / amax);
            }
            const float* w_in = KIN(9);
            constexpr int I_IN8 = (D / 64) * 40;
            for (int it = gw; it < 2 * I_IN8; it += ngw) {
                const int l = it / I_IN8, rr = it % I_IN8, kb = rr / 40, nb = rr % 40, t5 = nb >> 3, pn = t5 < 2 ? 6 + t5 : (t5 < 4 ? 7 + t5 : 13);
                const float amax = fmaxf(__uint_as_float(__hip_atomic_load((unsigned*)(ws + WS_CTL) + CW_WINMAX + l, __ATOMIC_RELAXED, __HIP_MEMORY_SCOPE_AGENT)), 1.0e-30f);
                transpose_item_i8_win(w_in + (size_t)l * D * NPROJ_SRC, ws + WS_W + (size_t)l * W_LAYER + W_IN8, scr, kb, pn * 256 + (nb & 7) * 32, lane, 127.f / amax);
            }
        }
        rowpass<false, true, false, false, 2>(KIN(0), nullptr, nullptr, nullptr, nullptr, nullptr, nullptr, nullptr, KIN(5), MOD + 1 * D, MOD + 0 * D, (bf16*)(ws + WS_H), gw, ngw, lane, (float*)(ws + WS_HSP), ws + WS_H8P); }
    SEAM(1);

    for (int l = 0; l < NLAYER_LOOP; ++l) {
        const int pb = 2 + 9 * l;
        if (EN_G0 && IN(pb + 0)) for (int rep = 0; rep < REP_G; ++rep) {
            unsigned char* ws = KWS();
            {
                pg8::Gemm g{(const bf16*)(ws + WS_H), (const bf16*)(ws + WS_W + (size_t)l * W_LAYER + W_IN), M, NPROJ, D}; pg8::MapOrder S; S.init(M, G, bx, 0);
                EpiProj E{(bf16*)(ws + WS_PROJ), kptr<const int>(2), (bf16*)(ws + WS_KIP)};
                { PHASE_IDS pg8::gemm_phase<EpiProj, pg8::MapOrder, MK_ALIGN, MK_SP2>(lds, g, S, E, tid); }
            }
            {
                pg8::Gemm g{(const bf16*)(ws + WS_H8P), (const bf16*)(ws + WS_W + (size_t)l * W_LAYER + W_IN8), M, NPROJ, D / 2}; pg8::MapOrder S; S.init(M, G, bx, 1);
                EpiProjI8 E{(bf16*)(ws + WS_PROJ), (const float*)(ws + WS_HSP), (const unsigned*)(ws + WS_CTL) + CW_WINMAX + l};
                { PHASE_IDS pg8::gemm_phase<EpiProjI8, pg8::MapOrder, MK_ALIGN, MK_SP2, false, true>(lds, g, S, E, tid); }
            }
        }
        SEAM(pb + 0);
        if (EN_M1 && IN(pb + 1)) {
            for (int rep = 0; rep < REP_M1A; ++rep) {
                PHASE_IDS
                unsigned char* ws = KWS(); const bf16* PROJ = (const bf16*)(ws + WS_PROJ);
                float* UB = (float*)(ws + WS_UB); float* UC = (float*)(ws + WS_UC); float* GC = (float*)(ws + WS_GC);
                const float* gla_wa2 = KIN(10) + l * 16 * 128; const float* gla_ba = KIN(11) + l * 128;
                if (EN_M1A) for (int wu = gw; wu < 4096; wu += ngw) { const int b = wu >> 8, c = (wu >> 2) & 63, h = wu & 3; ret_state_unit(lds + wave * 18432, PROJ, UB, b, c, h, lane); }
                __builtin_amdgcn_sched_barrier(0);
                if (EN_M1A2) for (int wu = gw; wu < 4096; wu += ngw) { const int b = wu >> 8, c = (wu >> 2) & 63, h = wu & 3; gla_state_unit(lds + wave * 18432, PROJ, gla_wa2, gla_ba, UC, GC, b, c, h, lane); }
            }
            __syncthreads();
            if (EN_M1B) for (int rep = 0; rep < REP_M1B; ++rep) {
                PHASE_IDS
                unsigned char* ws = KWS(); const bf16* PROJ = (const bf16*)(ws + WS_PROJ);
                const float lam_init = 0.8f - 0.6f * expf(-0.3f * (float)l);
                float a1 = 0.f, a2 = 0.f;
                if (lane < 32) { a1 = KIN(12)[l * 32 + lane] * KIN(13)[l * 32 + lane]; a2 = KIN(14)[l * 32 + lane] * KIN(15)[l * 32 + lane]; }
                const float lam = expf(wave_sum(a1)) - expf(wave_sum(a2)) + lam_init;
                bf16* Y = (bf16*)(ws + WS_Y); const float* hng = KIN(16) + l * D;
                for (int i = bx; i < 1024; i += G) {
                    const int bh = i & 63, slot = i >> 6, qb = slot ^ ((slot & 4) ? 3 : 0);
                    diff_unit(lds, PROJ, Y, hng, lam, lam_init, bh >> 2, bh & 3, qb, tid, lane, wave);
                }
            }
            if (EN_M1C) for (int rep = 0; rep < REP_M1C; ++rep) {
                PHASE_IDS
                unsigned char* ws = KWS(); const bf16* PROJ = (const bf16*)(ws + WS_PROJ);
                u64* MASK = (u64*)(ws + WS_MASK);
                for (int i = bx; i < 8192; i += G) {
                    const int b = i & 15, slot = i >> 4, g8 = slot ^ ((slot & 16) ? 15 : 0);
                    indexer_unit(lds, PROJ, (const bf16*)(ws + WS_KIP), MASK, b, g8, lane, wave);
                }
            }
        }
        SEAM(pb + 1);
        if (EN_M2 && IN(pb + 2)) {
            for (int rep = 0; rep < REP_M2A; ++rep) {
                PHASE_IDS
                unsigned char* ws = KWS();
                const float* UB = (const float*)(ws + WS_UB); bf16* RB = (bf16*)(ws + WS_RB);
                for (int e = bx * NTHREADS + tid; e < 16 * 4 * 4096; e += G * NTHREADS) {
                    const int b = e >> 14, h = (e >> 12) & 3, ed = e & 4095;
                    const float g64 = exp2f(64.f * ret_log2g(h));
                    float rs = 0.f, uu[NCH];
#pragma unroll
                    for (int c = 0; c < NCH; ++c) uu[c] = UB[(size_t)((b * NCH + c) * 4 + h) * 4096 + ed];
#pragma unroll
                    for (int c = 0; c < NCH; ++c) { RB[(size_t)((b * NCH + c) * 4 + h) * 4096 + ed] = f2bf(rs); rs = g64 * rs + uu[c]; }
                }
                const float* UC = (const float*)(ws + WS_UC); const float* GC = (const float*)(ws + WS_GC); bf16* SCB = (bf16*)(ws + WS_SCB);
                for (int e = bx * NTHREADS + tid; e < 16 * 4 * 2048; e += G * NTHREADS) {
                    const int b = e >> 13, h = (e >> 11) & 3, dk = e & 2047, k = e & 31;
                    float st = 0.f;
                    for (int c0 = 0; c0 < NCH; c0 += 32) {
                        float uu[32], gg[32];
#pragma unroll
                        for (int c = 0; c < 32; ++c) { const size_t u0 = (size_t)((b * NCH + c0 + c) * 4 + h); uu[c] = UC[u0 * 2048 + dk]; gg[c] = GC[u0 * 32 + k]; }
#pragma unroll
                        for (int c = 0; c < 32; ++c) { const size_t u0 = (size_t)((b * NCH + c0 + c) * 4 + h); SCB[u0 * 2048 + dk] = f2bf(st); st = gg[c] * st + uu[c]; }
                    }
                }
            }
            __syncthreads();
            for (int rep = 0; rep < REP_M2B; ++rep) {
                PHASE_IDS
                unsigned char* ws = KWS();
                const bf16* PROJ = (const bf16*)(ws + WS_PROJ); const u64* MASK = (const u64*)(ws + WS_MASK); bf16* Y = (bf16*)(ws + WS_Y); const float* hng = KIN(16) + l * D;
                for (int i = bx; i < 1024; i += G) {
                    const int b = i & 15, slot = i >> 4, qc = slot ^ ((slot & 16) ? 15 : 0);
                    dsa_unit(lds, PROJ, MASK, Y, hng, b, qc, tid, lane, wave);
                }
            }
        }
        SEAM(pb + 2);
        if (EN_M3 && IN(pb + 3)) for (int rep = 0; rep < REP_M3; ++rep) {
            PHASE_IDS
            unsigned char* ws = KWS();
            const bf16* PROJ = (const bf16*)(ws + WS_PROJ); bf16* Y = (bf16*)(ws + WS_Y); const float* hng = KIN(16) + l * D;
            const bf16* RB = (const bf16*)(ws + WS_RB); const bf16* SCB = (const bf16*)(ws + WS_SCB);
            const float* gla_wa2 = KIN(10) + l * 16 * 128; const float* gla_ba = KIN(11) + l * 128;
            if (EN_M3A) for (int wu = gw; wu < 4096; wu += ngw) { const int b = wu >> 8, c = (wu >> 2) & 63, h = wu & 3; ret_out_unit(lds + wave * 18432, PROJ, RB, hng, Y, b, c, h, lane); }
            __builtin_amdgcn_sched_barrier(0);
            if (EN_M3B) for (int wu = gw; wu < 4096; wu += ngw) { const int b = wu >> 8, c = (wu >> 2) & 63, h = wu & 3; gla_out_unit(lds + wave * 18432, PROJ, gla_wa2, gla_ba, SCB, hng, Y, b, c, h, lane); }
            __syncthreads();
        }
        SEAM(pb + 3);
        if (EN_G1 && IN(pb + 4)) for (int rep = 0; rep < REP_G; ++rep) {
            unsigned char* ws = KWS();
            pg8::Gemm g{(const bf16*)(ws + WS_Y), (const bf16*)(ws + WS_W + (size_t)l * W_LAYER + W_OUT), M, D, D}; pg8::StaticOrder S; S.init(M, D, G, bx);
            EpiY2 E{(bf16*)(ws + WS_Y2), (float*)(ws + WS_SS), 1.f};
            { PHASE_IDS pg8::gemm_phase<EpiY2, pg8::StaticOrder, MK_ALIGN, MK_SP2>(lds, g, S, E, tid); }
        }
        SEAM(pb + 4);
        if (EN_ROW && IN(pb + 5)) {
            PHASE_IDS
            unsigned char* ws = KWS(); const float* modl = (const float*)(ws + WS_MOD) + (size_t)l * 16 * 6144; float* out = KOUT();
            rowpass<true, true, false, true, 1>(l == 0 ? KIN(0) : (const float*)out, nullptr, (bf16*)(ws + WS_X1A), (bf16*)(ws + WS_X1B), (const bf16*)(ws + WS_Y2), (const float*)(ws + WS_SS), KIN(6) + l * D, modl + 2 * D, KIN(7) + l * D, modl + 4 * D, modl + 3 * D, (bf16*)(ws + WS_H), gw, ngw, lane, (float*)(ws + WS_HS), ws + WS_H);
        }
        SEAM(pb + 5);
        if (EN_G2 && IN(pb + 6)) for (int rep = 0; rep < REP_G; ++rep) {
            unsigned char* ws = KWS();
            pg8::Gemm g{(const bf16*)(ws + WS_H), (const bf16*)(ws + WS_W + (size_t)l * W_LAYER + W_1), M, FF, D / 2}; pg8::StaticOrder S; S.init(M, FF, G, bx);
            EpiRelu2I8 E{ws + WS_U, (const float*)(ws + WS_HS), (const unsigned*)(ws + WS_CTL) + CW_W1MAX + l};
            { PHASE_IDS pg8::gemm_phase<EpiRelu2I8, pg8::StaticOrder, MK_ALIGN, MK_SP2, false, true>(lds, g, S, E, tid); }
        }
        SEAM(pb + 6);
        if (EN_G3 && IN(pb + 7)) for (int rep = 0; rep < REP_G; ++rep) {
            unsigned char* ws = KWS();
            pg8::Gemm g{(const bf16*)(ws + WS_U), (const bf16*)(ws + WS_W + (size_t)l * W_LAYER + W_2), M, D, FF / 2}; pg8::StaticOrder S; S.init(M, D, G, bx);
            EpiY2 E{(bf16*)(ws + WS_Y2), (float*)(ws + WS_SS), 1.f / (U_SCALE * W2_SCALE)};
            { PHASE_IDS pg8::gemm_phase<EpiY2, pg8::StaticOrder, MK_ALIGN, MK_SP2, true>(lds, g, S, E, tid); }
        }
        SEAM(pb + 7);
        if (EN_ROW && IN(pb + 8)) {
            PHASE_IDS
            unsigned char* ws = KWS(); const float* MOD = (const float*)(ws + WS_MOD); const float* modl = MOD + (size_t)l * 16 * 6144; float* out = KOUT();
            if (l == 0) rowpass<true, true, true, false, 2>(nullptr, out, (bf16*)(ws + WS_X1A), (bf16*)(ws + WS_X1B), (const bf16*)(ws + WS_Y2), (const float*)(ws + WS_SS), KIN(8) + l * D, modl + 5 * D, KIN(5) + D, MOD + (size_t)16 * 6144 + 1 * D, MOD + (size_t)16 * 6144 + 0 * D, (bf16*)(ws + WS_H), gw, ngw, lane, (float*)(ws + WS_HSP), ws + WS_H8P);
            else rowpass<true, false, true, false>(nullptr, out, (bf16*)(ws + WS_X1A), (bf16*)(ws + WS_X1B), (const bf16*)(ws + WS_Y2), (const float*)(ws + WS_SS), KIN(8) + l * D, modl + 5 * D, nullptr, nullptr, nullptr, nullptr, gw, ngw, lane);
        }
        SEAM(pb + 8);
    }
#undef IN
#undef SEAM
}

#ifndef MK_N_LAUNCHES
#define MK_N_LAUNCHES 1
#endif
extern "C" void kernel_launch(void* const* d_in, const int* in_sizes, int n_in, void* d_out, int out_size, void* d_ws, size_t ws_size, hipStream_t stream) {
    static int grid = 0;
    if (grid == 0) {
        if (n_in != 20 || out_size != M * D || ws_size < WS_END) { fprintf(stderr, "kernel_launch: unexpected problem (n_in %d, out %d, ws %zu)\n", n_in, out_size, ws_size); grid = -1; return; }
        int dev = 0, cus = 0, per_cu = 0;
        if (hipGetDevice(&dev) != hipSuccess || hipDeviceGetAttribute(&cus, hipDeviceAttributeMultiprocessorCount, dev) != hipSuccess) { grid = -1; return; }
        if (hipFuncSetAttribute((const void*)mk_fwd, hipFuncAttributeMaxDynamicSharedMemorySize, LDS_BYTES) != hipSuccess) { fprintf(stderr, "kernel_launch: hipFuncSetAttribute failed\n"); grid = -1; return; }
        if (hipOccupancyMaxActiveBlocksPerMultiprocessor(&per_cu, (const void*)mk_fwd, NTHREADS, LDS_BYTES) != hipSuccess || per_cu < 1) fprintf(stderr, "kernel_launch: occupancy query says %d\n", per_cu);
        (void)hipGetLastError();
        grid = cus;
    }
    if (grid < 0) return;
    (void)hipMemsetAsync((char*)d_ws + WS_CTL, 0, CTL_ZERO_BYTES, stream);
    Args a{};
    for (int i = 0; i < 20; ++i) a.in[i] = d_in[i];
    a.out = (float*)d_out; a.ws = (unsigned char*)d_ws;
    if (MK_N_LAUNCHES == 1) { a.ph_lo = 0; a.ph_hi = NPHASES; hipLaunchKernelGGL(mk_fwd, dim3(grid), dim3(NTHREADS), LDS_BYTES, stream, a); }
    else for (int p = 0; p < NPHASES; ++p) { a.ph_lo = p; a.ph_hi = p + 1; hipLaunchKernelGGL(mk_fwd, dim3(grid), dim3(NTHREADS), LDS_BYTES, stream, a); }
}
```

```cpp
#include <hip/hip_runtime.h>
#include <cstdio>
#include <cstdint>
namespace pg8 {
#define PG8_LAS __attribute__((address_space(3)))
typedef unsigned short bf16_t;
typedef short bf16x8 __attribute__((ext_vector_type(8)));
typedef float f32x4 __attribute__((ext_vector_type(4)));
typedef unsigned u32x4 __attribute__((ext_vector_type(4)));
typedef int i32x4 __attribute__((ext_vector_type(4)));
typedef int i32x8 __attribute__((ext_vector_type(8)));
__device__ __forceinline__ i32x8 cat8(bf16x8 lo, bf16x8 hi) { return __builtin_shufflevector(__builtin_bit_cast(i32x4, lo), __builtin_bit_cast(i32x4, hi), 0, 1, 2, 3, 4, 5, 6, 7); }
constexpr int BM = 256, BK = 64, HALF = 128, HTB = HALF * BK * 2  , STAGE_BYTES = 8 * HTB, NXCD = 8, WGM = 8;

__host__ __device__ __forceinline__ int lds_byte(int r, int c) { const int st = (r >> 4) * 2 + (c >> 5), rr = r & 15, cc = c & 31, ob = rr * 64 + cc * 2; return st * 1024 + (ob ^ (((ob >> 9) & 1) << 5)); }
__host__ __device__ __forceinline__ void stage_rc(int b, int& R, int& C) { const int st = b / 1024, sb = b % 1024, swz = sb ^ (((sb >> 9) & 1) << 5); R = (st >> 1) * 16 + swz / 64; C = (st & 1) * 32 + (swz % 64) / 2; }
__host__ __device__ __forceinline__ int perm32(int rho) { const int n = rho >> 4, i = rho & 15; return 8 * (i >> 2) + 4 * n + (i & 3); }

struct Unit { int pm, pn; };
struct Gemm { const bf16_t* A; const bf16_t* Bt; int M, N, K; };

struct StaticOrder {
    int nM, nN, nwg, G, c;
    __host__ __device__ void init(int M, int N, int G_, int c_) { nM = M / BM; nN = N / BM; nwg = nM * nN; G = G_; c = c_; }
    __host__ __device__ bool next(int i, Unit& u) const {
        const long L = (long)i * G + c; if (L >= nwg) return false;
        int wgid = (int)L; { const int q = nwg / NXCD, r = nwg % NXCD, xcd = wgid % NXCD, off = wgid / NXCD; wgid = (xcd < r ? xcd * (q + 1) : r * (q + 1) + (xcd - r) * q) + off; }
        const int nig = WGM * nN, gid = wgid / nig, fm = gid * WGM, gsz = (nM - fm) < WGM ? (nM - fm) : WGM;
        u.pm = fm + ((wgid % nig) % gsz); u.pn = (wgid % nig) / gsz; return true;
    }
    __device__ __forceinline__ void a_ready(const Unit&) const {}
    __device__ __forceinline__ void done(const Unit&) const {}
};
struct MapOrder {
    StaticOrder S; int kind;
    __host__ __device__ void init(int M, int G_, int c_, int kind_) { kind = kind_; S.init(M, (kind_ ? 8 : 6) * BM, G_, c_); }
    __host__ __device__ bool next(int i, Unit& u) const { if (!S.next(i, u)) return false; const int p = u.pn; u.pn = kind ? (p < 7 ? 4 + p : 13) : (p < 4 ? p : 7 + p); return true; }
    __device__ __forceinline__ void a_ready(const Unit&) const {}
    __device__ __forceinline__ void done(const Unit&) const {}
};

template <class Epi, class Sched, bool ALIGN_EPI = false, bool SP2 = false, bool F8 = false, bool I8 = false>
__device__ __forceinline__ void gemm_phase(PG8_LAS unsigned char* lds, const Gemm g, const Sched& S, const Epi& E, int tid_in) {
    int tid_o = tid_in; asm volatile("" : "+v"(tid_o));
    const int tid = tid_o, wid = __builtin_amdgcn_readfirstlane(tid >> 6), lane = tid & 63, wr = wid >> 2, wc = wid & 3, fr = lane & 15, fq = lane >> 4;
    const int K = g.K, nt = K / BK;
    unsigned voffA[2], voffB[2];
#pragma unroll
    for (int i = 0; i < 2; ++i) { int R, C; stage_rc(tid * 16 + i * 8192, R, C); const int Rb = Epi::PERM ? ((R & ~31) + perm32(R & 31)) : R;
        voffA[i] = (unsigned)(R * K + C) * 2u; voffB[i] = (unsigned)(Rb * K + C) * 2u; }
    const size_t kstep = (size_t)(BK * 2);
    const size_t hstep = (size_t)HALF * K * 2;
    const size_t tstep = 2 * hstep;
    const unsigned ldsw = (unsigned)wid * 1024u;
    const int aoff = lds_byte(wr * 64 + fr, fq * 8), boff = lds_byte(wc * 32 + fr, fq * 8);
#define PG8_SA(b, h) (((b) * 2 + (h)) * HTB)
#define PG8_SB(b, h) ((4 + (b) * 2 + (h)) * HTB)
#define PG8_STAGE(bufoff, gbase, voff) do { _Pragma("unroll") for (int _i = 0; _i < 2; ++_i) \
        __builtin_amdgcn_global_load_lds((const unsigned*)((const char*)(gbase) + (voff)[_i]), (PG8_LAS unsigned*)(lds + (bufoff) + ldsw + _i * 8192), 16, 0, 0); } while (0)
#define PG8_LDA(dst, b, h) do { _Pragma("unroll") for (int m = 0; m < 4; ++m) _Pragma("unroll") for (int k = 0; k < 2; ++k) dst[m][k] = *(const PG8_LAS bf16x8*)(lds + PG8_SA(b, h) + aoff + m * 2048 + k * 1024); } while (0)
#define PG8_LDB(dst, b, h) do { _Pragma("unroll") for (int n = 0; n < 2; ++n) _Pragma("unroll") for (int k = 0; k < 2; ++k) dst[n][k] = *(const PG8_LAS bf16x8*)(lds + PG8_SB(b, h) + boff + n * 2048 + k * 1024); } while (0)
#define PG8_MMA(ai, bj, At, Bt) do { __builtin_amdgcn_s_setprio(1); if constexpr (F8) { _Pragma("unroll") for (int m = 0; m < 4; ++m) _Pragma("unroll") for (int n = 0; n < 2; ++n) \
        acc[ai][bj][m][n] = __builtin_amdgcn_mfma_scale_f32_16x16x128_f8f6f4(cat8(Bt[n][0], Bt[n][1]), cat8(At[m][0], At[m][1]), acc[ai][bj][m][n], 0, 0, 0, 0, 0, 0); } else if constexpr (I8) { \
        _Pragma("unroll") for (int m = 0; m < 4; ++m) _Pragma("unroll") for (int n = 0; n < 2; ++n) _Pragma("unroll") for (int k = 0; k < 2; ++k) \
        acc[ai][bj][m][n] = __builtin_bit_cast(f32x4, __builtin_amdgcn_mfma_i32_16x16x64_i8(__builtin_bit_cast(i32x4, Bt[n][k]), __builtin_bit_cast(i32x4, At[m][k]), __builtin_bit_cast(i32x4, acc[ai][bj][m][n]), 0, 0, 0)); } else { \
        _Pragma("unroll") for (int m = 0; m < 4; ++m) _Pragma("unroll") for (int n = 0; n < 2; ++n) _Pragma("unroll") for (int k = 0; k < 2; ++k) \
        acc[ai][bj][m][n] = __builtin_amdgcn_mfma_f32_16x16x32_bf16(Bt[n][k], At[m][k], acc[ai][bj][m][n], 0, 0, 0); } __builtin_amdgcn_s_setprio(0); } while (0)
#define PG8_WAIT_V(n) asm volatile("s_waitcnt vmcnt(" #n ")" ::: "memory")
#define PG8_WAIT_L(n) asm volatile("s_waitcnt lgkmcnt(" #n ")" ::: "memory")
#define PG8_BAR __builtin_amdgcn_s_barrier()
#define PG8_SCHED __builtin_amdgcn_sched_barrier(0)
    Unit cur, nxt; int ui = 0;
    if (!S.next(0, cur)) return;
    f32x4 acc[2][2][4][2];
#pragma unroll
    for (int a = 0; a < 2; ++a)
#pragma unroll
        for (int b = 0; b < 2; ++b)
#pragma unroll
            for (int m = 0; m < 4; ++m)
#pragma unroll
                for (int n = 0; n < 2; ++n) acc[a][b][m][n] = (f32x4){0.f, 0.f, 0.f, 0.f};
    bf16x8 At[4][2], B0[2][2], B1[2][2];
    const char* cA = (const char*)g.A + (size_t)cur.pm * tstep; const char* cB = (const char*)g.Bt + (size_t)cur.pn * tstep;
    S.a_ready(cur);
    if constexpr (SP2) {
        PG8_STAGE(PG8_SB(0, 0), cB, voffB); PG8_STAGE(PG8_SB(0, 1), cB + hstep, voffB); PG8_STAGE(PG8_SA(0, 0), cA, voffA); PG8_STAGE(PG8_SA(0, 1), cA + hstep, voffA);
        if (wr == 1) PG8_BAR;
        PG8_WAIT_V(2); PG8_BAR;
        PG8_STAGE(PG8_SB(1, 0), cB + kstep, voffB); PG8_STAGE(PG8_SA(1, 0), cA + kstep, voffA); PG8_STAGE(PG8_SB(1, 1), cB + hstep + kstep, voffB);
        PG8_WAIT_V(6); PG8_BAR;
    } else {
        PG8_STAGE(PG8_SB(0, 0), cB, voffB); PG8_STAGE(PG8_SA(0, 0), cA, voffA); PG8_STAGE(PG8_SB(0, 1), cB + hstep, voffB); PG8_STAGE(PG8_SA(0, 1), cA + hstep, voffA);
        if (wr == 1) PG8_BAR;
        PG8_WAIT_V(4); PG8_BAR;
        PG8_STAGE(PG8_SB(1, 0), cB + kstep, voffB); PG8_STAGE(PG8_SA(1, 0), cA + kstep, voffA); PG8_STAGE(PG8_SB(1, 1), cB + hstep + kstep, voffB);
        PG8_WAIT_V(6); PG8_BAR;
    }
    for (;;) {
        const bool has_next = S.next(ui + 1, nxt);
        const char* nA = has_next ? (const char*)g.A + (size_t)nxt.pm * tstep : cA; const char* nB = has_next ? (const char*)g.Bt + (size_t)nxt.pn * tstep : cB;
        for (int t = 0; t < nt; t += 2) {
            if constexpr (F8) asm volatile("" : "+v"(voffA[0]), "+v"(voffA[1]), "+v"(voffB[0]), "+v"(voffB[1]));
            const bool last = (t == nt - 2);
            const char* a1 = cA + (size_t)(t + 1) * kstep;
            const char* a2 = last ? nA : cA + (size_t)(t + 2) * kstep; const char* b2 = last ? nB : cB + (size_t)(t + 2) * kstep;
            const char* a3 = a2 + kstep; const char* b3 = b2 + kstep;
            if (last && has_next) S.a_ready(nxt);
            if constexpr (SP2) {
            PG8_LDB(B0, 0, 0); PG8_LDB(B1, 0, 1); PG8_SCHED; PG8_LDA(At, 0, 0); PG8_STAGE(PG8_SA(1, 1), a1 + hstep, voffA);
            PG8_WAIT_V(8); PG8_WAIT_L(0); PG8_BAR; PG8_MMA(0, 0, At, B0); PG8_MMA(0, 1, At, B1); PG8_BAR; PG8_SCHED;
            PG8_LDA(At, 0, 1); PG8_STAGE(PG8_SB(0, 0), b2, voffB); PG8_STAGE(PG8_SB(0, 1), b2 + hstep, voffB); PG8_STAGE(PG8_SA(0, 0), a2, voffA);
            PG8_WAIT_V(8); PG8_WAIT_L(0); PG8_BAR; PG8_MMA(1, 0, At, B0); PG8_MMA(1, 1, At, B1); PG8_BAR; PG8_SCHED;
            PG8_LDB(B0, 1, 0); PG8_LDB(B1, 1, 1); PG8_SCHED; PG8_LDA(At, 1, 0); PG8_STAGE(PG8_SA(0, 1), a2 + hstep, voffA);
            PG8_WAIT_V(8); PG8_WAIT_L(0); PG8_BAR; PG8_MMA(0, 0, At, B0); PG8_MMA(0, 1, At, B1); PG8_BAR; PG8_SCHED;
            PG8_LDA(At, 1, 1); PG8_STAGE(PG8_SB(1, 0), b3, voffB); PG8_STAGE(PG8_SB(1, 1), b3 + hstep, voffB); PG8_STAGE(PG8_SA(1, 0), a3, voffA);
            PG8_WAIT_V(8); PG8_WAIT_L(0); PG8_BAR; PG8_MMA(1, 0, At, B0); PG8_MMA(1, 1, At, B1); PG8_BAR; PG8_SCHED;
            } else {
            PG8_LDB(B0, 0, 0); PG8_SCHED; PG8_LDA(At, 0, 0); PG8_STAGE(PG8_SA(1, 1), a1 + hstep, voffA);
            PG8_WAIT_L(8); PG8_BAR; PG8_WAIT_L(0); PG8_MMA(0, 0, At, B0); PG8_BAR; PG8_SCHED;
            PG8_LDB(B1, 0, 1); PG8_STAGE(PG8_SB(0, 0), b2, voffB);
            PG8_BAR; PG8_WAIT_L(0); PG8_MMA(0, 1, At, B1); PG8_BAR;
            PG8_LDA(At, 0, 1); PG8_STAGE(PG8_SA(0, 0), a2, voffA);
            PG8_BAR; PG8_WAIT_L(0); PG8_MMA(1, 0, At, B0); PG8_BAR; PG8_SCHED;
            PG8_STAGE(PG8_SB(0, 1), b2 + hstep, voffB);
            PG8_WAIT_V(6); PG8_BAR; PG8_MMA(1, 1, At, B1); PG8_BAR;
            PG8_LDB(B0, 1, 0); PG8_SCHED; PG8_LDA(At, 1, 0); PG8_STAGE(PG8_SA(0, 1), a2 + hstep, voffA);
            PG8_WAIT_L(8); PG8_BAR; PG8_WAIT_L(0); PG8_MMA(0, 0, At, B0); PG8_BAR; PG8_SCHED;
            PG8_LDB(B1, 1, 1); PG8_STAGE(PG8_SB(1, 0), b3, voffB);
            PG8_BAR; PG8_WAIT_L(0); PG8_MMA(0, 1, At, B1); PG8_BAR;
            PG8_LDA(At, 1, 1); PG8_STAGE(PG8_SA(1, 0), a3, voffA);
            PG8_BAR; PG8_WAIT_L(0); PG8_MMA(1, 0, At, B0); PG8_BAR; PG8_SCHED;
            PG8_STAGE(PG8_SB(1, 1), b3 + hstep, voffB);
            PG8_WAIT_V(6); PG8_BAR; PG8_MMA(1, 1, At, B1); PG8_BAR;
            }
        }
        if constexpr (ALIGN_EPI) { if (wr == 0) PG8_BAR; }
        if constexpr (!Epi::AFTER_DRAIN) {
            if constexpr (F8) { int le; asm volatile("v_mbcnt_lo_u32_b32 %0, -1, 0\n\tv_mbcnt_hi_u32_b32 %0, -1, %0" : "=v"(le)); E(acc, cur, wr, wc, le & 15, le >> 4); }
            else E(acc, cur, wr, wc, fr, fq);
            S.done(cur); }
        if (!has_next) break;
#pragma unroll
        for (int a = 0; a < 2; ++a)
#pragma unroll
            for (int b = 0; b < 2; ++b)
#pragma unroll
                for (int m = 0; m < 4; ++m)
#pragma unroll
                    for (int n = 0; n < 2; ++n) acc[a][b][m][n] = (f32x4){0.f, 0.f, 0.f, 0.f};
        cur = nxt; cA = nA; cB = nB; ++ui;
        if constexpr (ALIGN_EPI) { if (wr == 1) PG8_BAR; }
    }
    PG8_WAIT_V(0);
    if constexpr (!ALIGN_EPI) { if (wr == 0) PG8_BAR; }
    PG8_BAR;
    if constexpr (Epi::AFTER_DRAIN) { E.fused(acc, cur, wr, wc, fr, fq, lds, wid, lane); S.done(cur); }
#undef PG8_SA
#undef PG8_SB
#undef PG8_STAGE
#undef PG8_LDA
#undef PG8_LDB
#undef PG8_MMA
#undef PG8_WAIT_V
#undef PG8_WAIT_L
#undef PG8_BAR
#undef PG8_SCHED
}
}
#define LAS __attribute__((address_space(3)))
#define XB_TMO      128
#define XB_XCNT(j)  (256  + 64 * (j))
#define XB_XSUB(j)  (1280 + 64 * (j))
#define XB_XGEN(j)  (2304 + 64 * (j))
#define XB_TOP      3328
#define XB_TOPGEN   3392
#define XCD_BAR_WORDS 3456
#define XB_SPIN_CAP (1u << 18)

__device__ __forceinline__ unsigned xb_ld(unsigned* p)              { return __hip_atomic_load(p, __ATOMIC_RELAXED, __HIP_MEMORY_SCOPE_AGENT); }
__device__ __forceinline__ unsigned xb_add(unsigned* p, unsigned v) { return __hip_atomic_fetch_add(p, v, __ATOMIC_RELAXED, __HIP_MEMORY_SCOPE_AGENT); }
__device__ __forceinline__ unsigned xb_xcc_id() { return (unsigned)__builtin_amdgcn_s_getreg((3 << 11) | 20) & 0xFu; }
#define XB_SPIN(cond, bar) do { unsigned _sp = 0; while (cond) { __builtin_amdgcn_s_sleep(1); \
    if ((++_sp & 255u) == 0u) { if (xb_ld(&(bar)[XB_TMO])) break; if (_sp > XB_SPIN_CAP) { atomicAdd(&(bar)[XB_TMO], 1u); break; } } } } while (0)

struct XcdBarrier {
    unsigned* bar; unsigned x;
    volatile LAS unsigned* st;
};

__device__ __forceinline__ XcdBarrier xcd_barrier_post(unsigned* bar, volatile LAS unsigned* st) {
    XcdBarrier b; b.bar = bar; b.x = xb_xcc_id(); b.st = st;
    if (threadIdx.x == 0) (void)xb_add(&bar[XB_XCNT(b.x)], 1u);
    return b;
}
__device__ __forceinline__ void xcd_barrier_complete(unsigned* bar, unsigned x, unsigned& nloc, unsigned& nx) {
    const unsigned G = gridDim.x * gridDim.y * gridDim.z;
    unsigned sum, cnt, mine, sp = 0u;
    for (;;) {
        sum = 0u; cnt = 0u; mine = 0u;
#pragma unroll
        for (unsigned j = 0; j < 16; ++j) { const unsigned c = xb_ld(&bar[XB_XCNT(j)]); sum += c; cnt += (c > 0u) ? 1u : 0u; mine = (j == x) ? c : mine; }
        if (sum == G) break;
        __builtin_amdgcn_s_sleep(1);
        if ((++sp & 255u) == 0u) { if (xb_ld(&bar[XB_TMO])) break; if (sp > XB_SPIN_CAP) { atomicAdd(&bar[XB_TMO], 1u); break; } }
    }
    nloc = mine > 0u ? mine : 1u; nx = cnt > 0u ? cnt : 1u;
}

__device__ __forceinline__ void xcd_barrier(const XcdBarrier& b) {
    asm volatile("s_waitcnt vmcnt(0)" ::: "memory");
    __syncthreads();
    if (threadIdx.x == 0) {
        unsigned* bar = b.bar;
        __builtin_amdgcn_s_waitcnt(0);
        unsigned nloc = b.st[0], nx = b.st[1];
        if (nloc == 0u) { xcd_barrier_complete(bar, b.x, nloc, nx); b.st[0] = nloc; b.st[1] = nx; }
        const unsigned old = xb_add(&bar[XB_XSUB(b.x)], 1u);
        const unsigned gen = old / nloc;
        if (old + 1u == (gen + 1u) * nloc) {
            __builtin_amdgcn_fence(__ATOMIC_RELEASE, "agent");
            asm volatile("s_waitcnt vmcnt(0)" ::: "memory");
            const unsigned og = xb_add(&bar[XB_TOP], 1u);
            const unsigned tg = og / nx;
            if (og + 1u == (tg + 1u) * nx) xb_add(&bar[XB_TOPGEN], 1u);
            else XB_SPIN(xb_ld(&bar[XB_TOPGEN]) == tg, bar);
            __builtin_amdgcn_fence(__ATOMIC_ACQUIRE, "agent");
            xb_add(&bar[XB_XGEN(b.x)], 1u);
            asm volatile("s_waitcnt vmcnt(0)" ::: "memory");
        } else {
            XB_SPIN(xb_ld(&bar[XB_XGEN(b.x)]) == gen, bar);
            __builtin_amdgcn_fence(__ATOMIC_ACQUIRE, "agent");
            asm volatile("s_waitcnt vmcnt(0)" ::: "memory");
        }
    }
    __syncthreads();
}

constexpr int BATCH = 16, T = 4096, D = 1024, M = BATCH * T, NPROJ = 3584, NPROJ_SRC = 3544, FF = 4096, NCH = T / 64;
constexpr float EPS = 1e-6f;
constexpr float LOG2E = 1.44269504089f, INV2PI = 0.15915494309189535f;
constexpr float LOG2_5E5 = 18.931568569324174f, LOG2_1E4 = 13.287712379549449f;
constexpr int COL_AQ = 0, COL_AK = 256, COL_AV = 320, COL_AKI = 384, COL_CA = 448, COL_AWI = 464, COL_AQI = 512,
              COL_BQ = 1024, COL_BK = 1280, COL_BV = 1536, COL_BG = 1792, COL_CQ = 2048, COL_CK = 2176, COL_CV = 2304, COL_CG = 2560,
              COL_DQ = 2816, COL_DK = 3072, COL_DV = 3328;

constexpr size_t MiB = 1u << 20;
constexpr size_t WS_CTL = 0, CTL_ZERO_BYTES = 1 * MiB;
constexpr size_t WS_MOD = 1 * MiB;
constexpr size_t WS_SS = 2 * MiB;
constexpr size_t WS_GC = 6 * MiB;
constexpr size_t WS_W = 8 * MiB, W_LAYER = 25 * MiB, W_IN = 0, W_OUT = 7 * MiB, W_1 = 9 * MiB, W_2 = 17 * MiB;
constexpr size_t WS_H = 64 * MiB;
constexpr size_t WS_MASK = WS_H, WS_SCB = WS_H + 32 * MiB;
constexpr size_t WS_PROJ = 192 * MiB;
constexpr size_t WS_Y = 640 * MiB;
constexpr size_t WS_Y2 = 768 * MiB;
constexpr size_t WS_UB = WS_Y2, WS_RB = WS_Y2 + 64 * MiB, WS_UC = WS_Y2 + 96 * MiB;
constexpr size_t WS_U = WS_PROJ;
constexpr size_t WS_KIP = 896 * MiB;
constexpr size_t WS_X1A = 904 * MiB, WS_X1B = 704 * MiB;
constexpr size_t WS_END = 968 * MiB;
constexpr int CW_TMO = 0, CW_BAR = 4096, CW_W1MAX = 16, CW_WINMAX = 18;
constexpr size_t WS_HSP = 7 * MiB + 512 * 1024;
constexpr size_t WS_H8P = 640 * MiB;
constexpr size_t W_IN8 = 13 * MiB;
constexpr size_t WS_HS = 7 * MiB;

constexpr int SCRATCH_BYTES = 147456;
constexpr int LDSCTL_OFF = SCRATCH_BYTES, LDS_BYTES = SCRATCH_BYTES + 1024;
constexpr int NWAVES = 8, NTHREADS = 512;
constexpr int NPHASES = 20;

__host__ __device__ __forceinline__ size_t PX(size_t tok, int col) { return ((tok >> 6) * (NPROJ / 64) + (size_t)(col >> 6)) * 4096 + ((size_t)((col & 63) >> 3) * 64 + (tok & 63)) * 8 + (size_t)(col & 7); }
constexpr int PXC = 512;
constexpr size_t PX_TILE_STRIDE = (size_t)(NPROJ / 64) * 4096;
#define GAS __attribute__((address_space(1)))
#define LAS __attribute__((address_space(3)))
typedef unsigned short bf16;
typedef short bf16x8 __attribute__((ext_vector_type(8)));
typedef short s16x4 __attribute__((ext_vector_type(4)));
typedef float f32x4 __attribute__((ext_vector_type(4)));
typedef float f32x16 __attribute__((ext_vector_type(16)));
typedef unsigned u32x4 __attribute__((ext_vector_type(4)));
typedef unsigned u32x2 __attribute__((ext_vector_type(2)));
typedef float f32x2_t __attribute__((ext_vector_type(2)));
typedef __bf16 bf16x2_t __attribute__((ext_vector_type(2)));
typedef unsigned long long u64;

__device__ __forceinline__ unsigned cvtpk(float lo, float hi) { f32x2_t v = {lo, hi}; bf16x2_t b = __builtin_convertvector(v, bf16x2_t); return __builtin_bit_cast(unsigned, b); }
__device__ __forceinline__ bf16 f2bf(float f) { return (bf16)(cvtpk(f, 0.f) & 0xffffu); }
__device__ __forceinline__ float bf2f(short b) { return __uint_as_float(((unsigned)(unsigned short)b) << 16); }
__device__ __forceinline__ float bflo(unsigned w) { return __uint_as_float(w << 16); }
__device__ __forceinline__ float bfhi(unsigned w) { return __uint_as_float(w & 0xffff0000u); }
__device__ __forceinline__ bf16x8 ldg16(const bf16* p) { return *(const bf16x8*)p; }
__device__ __forceinline__ f32x16 mfma32(bf16x8 a, bf16x8 b, f32x16 c) { return __builtin_amdgcn_mfma_f32_32x32x16_bf16(a, b, c, 0, 0, 0); }
__device__ __forceinline__ int crow(int reg, int hh) { return (reg & 3) + 8 * (reg >> 2) + 4 * hh; }
__device__ __forceinline__ f32x16 zero16() { f32x16 z;
#pragma unroll
    for (int i = 0; i < 16; ++i) z[i] = 0.f; return z; }
#define LDS_FENCE() asm volatile("s_waitcnt lgkmcnt(0)" ::: "memory")
template <int S> __device__ __forceinline__ bf16x8 pack8(const f32x16& x) {
    u32x4 p; p.x = cvtpk(x[8 * S + 0], x[8 * S + 1]); p.y = cvtpk(x[8 * S + 2], x[8 * S + 3]); p.z = cvtpk(x[8 * S + 4], x[8 * S + 5]); p.w = cvtpk(x[8 * S + 6], x[8 * S + 7]);
    return __builtin_bit_cast(bf16x8, p);
}
typedef short v4i16_t __attribute__((ext_vector_type(4)));
__device__ __forceinline__ s16x4 vtr(const LAS unsigned char* p) { return __builtin_bit_cast(s16x4, __builtin_amdgcn_ds_read_tr16_b64_v4i16((LAS v4i16_t*)p)); }
__device__ __forceinline__ const LAS unsigned char* tr_base_perm(const LAS unsigned char* img, int lane) { return img + (4 * (lane >> 5) + ((lane & 15) >> 2)) * 64 + (16 * ((lane >> 4) & 1) + 4 * (lane & 3)) * 2; }
__device__ __forceinline__ const LAS unsigned char* tr_base_nat(const LAS unsigned char* img, int lane) { return img + (8 * (lane >> 5) + ((lane & 15) >> 2)) * 64 + (16 * ((lane >> 4) & 1) + 4 * (lane & 3)) * 2; }
template <int HALF, int K0> __device__ __forceinline__ bf16x8 ld_tr_perm(const LAS unsigned char* pb) {
    const s16x4 lo = vtr(pb + (HALF * 4096 + K0 * 64)), hi = vtr(pb + (HALF * 4096 + (K0 + 8) * 64));
    return __builtin_shufflevector(lo, hi, 0, 1, 2, 3, 4, 5, 6, 7);
}
template <int HALF, int K0> __device__ __forceinline__ bf16x8 ld_tr_nat(const LAS unsigned char* nb) {
    const s16x4 lo = vtr(nb + (HALF * 4096 + K0 * 64)), hi = vtr(nb + (HALF * 4096 + (K0 + 4) * 64));
    return __builtin_shufflevector(lo, hi, 0, 1, 2, 3, 4, 5, 6, 7);
}
template <int XM> __device__ __forceinline__ float swz_xor(float v) { return __int_as_float(__builtin_amdgcn_ds_swizzle(__float_as_int(v), (XM << 10) | 0x1f)); }
__device__ __forceinline__ float half_sum(float v) { const auto rr = __builtin_amdgcn_permlane32_swap(__float_as_uint(v), __float_as_uint(v), false, false); return __uint_as_float(rr[0]) + __uint_as_float(rr[1]); }
__device__ __forceinline__ float half_max(float v) { const auto rr = __builtin_amdgcn_permlane32_swap(__float_as_uint(v), __float_as_uint(v), false, false); return fmaxf(__uint_as_float(rr[0]), __uint_as_float(rr[1])); }
__device__ __forceinline__ int wave_sum_i(int v) {
    v += __builtin_amdgcn_update_dpp(0, v, 0xB1, 0xF, 0xF, true);
    v += __builtin_amdgcn_update_dpp(0, v, 0x4E, 0xF, 0xF, true);
    v += __builtin_amdgcn_update_dpp(0, v, 0x141, 0xF, 0xF, true);
    v += __builtin_amdgcn_update_dpp(0, v, 0x140, 0xF, 0xF, true);
    return __builtin_amdgcn_readlane(v, 0) + __builtin_amdgcn_readlane(v, 16) + __builtin_amdgcn_readlane(v, 32) + __builtin_amdgcn_readlane(v, 48);
}
__device__ __forceinline__ float wave_sum(float v) {
    v += swz_xor<1>(v); v += swz_xor<2>(v); v += swz_xor<4>(v); v += swz_xor<8>(v); v += swz_xor<16>(v);
    return half_sum(v);
}

template <bool I8>
struct EpiProj {
    static constexpr bool PERM = true, AFTER_DRAIN = false;
    bf16* O; const int* pos; bf16* KIP; const float* HS; const unsigned* WMAX;
    __device__ __forceinline__ void operator()(const pg8::f32x4 (&acc)[2][2][4][2], const pg8::Unit& u, int wr, int wc, int fr, int fq) const {
        const int pn = u.pn;
        int mode = 0; float sc0 = 1.f, sc1 = 1.f; bool act = false;
        if (pn == 0) { mode = 1; sc0 = sc1 = 0.125f * LOG2E; act = true; }
        else if (pn == 1) { mode = 1; act = (wc < 2); if (wc == 2 && fq == 2) sc1 = 0.04419417382415922f; }
        else if (pn == 2 || pn == 3) { mode = 1; act = true; }
        else if (pn == 4) { mode = 2; sc0 = sc1 = 0.125f; act = true; }
        else if (pn == 5) { mode = 2; act = true; }
        else if (pn == 8) { sc0 = 0.17677669529663687f; }
        else if (pn == 11) { mode = 3; sc0 = sc1 = 0.17677669529663687f * LOG2E; act = true; }
        else if (pn == 12) { mode = 3; act = true; }
        float inv[2][2]; bool lane_act = false;
#pragma unroll
        for (int n = 0; n < 2; ++n)
#pragma unroll
            for (int p = 0; p < 2; ++p) {
                float e = 0.f;
                if (mode == 1) e = -(float)(4 * fq + 2 * n + p) * (LOG2_5E5 / 8.f);
                else if (mode == 2) e = -(float)(16 * (wc & 1) + 4 * fq + 2 * n + p) * (LOG2_1E4 / 32.f);
                else if (mode == 3) e = -(float)(2 * n + p) * (LOG2_5E5 / 4.f);
                inv[n][p] = exp2f(e);
            }
        if (mode == 1) lane_act = act && ((wc & 1) == 0) && (fq < 2);
        else if (mode == 2) lane_act = act;
        else if (mode == 3) lane_act = act && (fq == 0);
        const int row0 = u.pm * 256 + wr * 64 + fr;
        const int col0 = pn * 256 + wc * 32 + 8 * fq;
        float rs[2][4]; float sw = 1.f;
        if (I8) { sw = __uint_as_float(*WMAX) * (1.f / 127.f);
#pragma unroll
            for (int ai = 0; ai < 2; ++ai)
#pragma unroll
                for (int m = 0; m < 4; ++m) rs[ai][m] = HS[row0 + ai * 128 + m * 16]; }
#pragma unroll
        for (int ai = 0; ai < 2; ++ai)
#pragma unroll
            for (int m = 0; m < 4; ++m) {
                const int row = row0 + ai * 128 + m * 16;
                float cs[2][2], sn[2][2];
                if (lane_act) {
                    const float pf = (float)pos[row];
#pragma unroll
                    for (int n = 0; n < 2; ++n)
#pragma unroll
                        for (int p = 0; p < 2; ++p) {
                            const float ang = pf * inv[n][p];
                            const float rv = __builtin_fmaf(ang, INV2PI, -__builtin_rintf(ang * INV2PI));
                            sn[n][p] = __builtin_amdgcn_sinf(rv); cs[n][p] = __builtin_amdgcn_cosf(rv);
                        }
                } else {
#pragma unroll
                    for (int n = 0; n < 2; ++n)
#pragma unroll
                        for (int p = 0; p < 2; ++p) { sn[n][p] = 0.f; cs[n][p] = 1.f; }
                }

#pragma unroll
                for (int bj = 0; bj < 2; ++bj) {
                    const float sc = bj ? sc1 : sc0;
                    pg8::f32x4 v0 = acc[ai][bj][m][0], v1 = acc[ai][bj][m][1];
                    if (I8) { const float dq = rs[ai][m] * sw;
#pragma unroll
                        for (int j = 0; j < 4; ++j) { v0[j] = (float)__float_as_int(v0[j]) * dq; v1[j] = (float)__float_as_int(v1[j]) * dq; } }
                    float o[8];
                    o[0] = v0[0] * cs[0][0] - v0[1] * sn[0][0]; o[1] = v0[0] * sn[0][0] + v0[1] * cs[0][0];
                    o[2] = v0[2] * cs[0][1] - v0[3] * sn[0][1]; o[3] = v0[2] * sn[0][1] + v0[3] * cs[0][1];
                    o[4] = v1[0] * cs[1][0] - v1[1] * sn[1][0]; o[5] = v1[0] * sn[1][0] + v1[1] * cs[1][0];
                    o[6] = v1[2] * cs[1][1] - v1[3] * sn[1][1]; o[7] = v1[2] * sn[1][1] + v1[3] * cs[1][1];
                    u32x4 w; w.x = cvtpk(o[0] * sc, o[1] * sc); w.y = cvtpk(o[2] * sc, o[3] * sc); w.z = cvtpk(o[4] * sc, o[5] * sc); w.w = cvtpk(o[6] * sc, o[7] * sc);
                    *(u32x4*)(O + PX((size_t)row, col0 + bj * 128)) = w;
                    if (bj == 1 && pn == 1 && wc < 2)
                        *(u32x4*)(KIP + (size_t)(row >> 5) * 2048 + ((4 * wc + fq) * 32 + (row & 31)) * 8) = w;
                }
                asm volatile("" ::: "memory");
            }
    }
};
struct EpiProjI8 {
    static constexpr bool PERM = true, AFTER_DRAIN = false;
    bf16* O; const float* HS; const unsigned* WMAX;
    __device__ __forceinline__ void operator()(const pg8::f32x4 (&acc)[2][2][4][2], const pg8::Unit& u, int wr, int wc, int fr, int fq) const {
        const int row0 = u.pm * 256 + wr * 64 + fr, col0 = u.pn * 256 + wc * 32 + 8 * fq;
        const float sw = __uint_as_float(*WMAX) * (1.f / 127.f);
        float rs[2][4];
#pragma unroll
        for (int ai = 0; ai < 2; ++ai)
#pragma unroll
            for (int m = 0; m < 4; ++m) rs[ai][m] = HS[row0 + ai * 128 + m * 16];
#pragma unroll
        for (int ai = 0; ai < 2; ++ai)
#pragma unroll
            for (int m = 0; m < 4; ++m) {
                const int row = row0 + ai * 128 + m * 16; const float sc = rs[ai][m] * sw;
#pragma unroll
                for (int bj = 0; bj < 2; ++bj) {
                    const pg8::f32x4 a0 = acc[ai][bj][m][0], a1 = acc[ai][bj][m][1];
                    u32x4 w;
                    w.x = cvtpk((float)__float_as_int(a0[0]) * sc, (float)__float_as_int(a0[1]) * sc); w.y = cvtpk((float)__float_as_int(a0[2]) * sc, (float)__float_as_int(a0[3]) * sc);
                    w.z = cvtpk((float)__float_as_int(a1[0]) * sc, (float)__float_as_int(a1[1]) * sc); w.w = cvtpk((float)__float_as_int(a1[2]) * sc, (float)__float_as_int(a1[3]) * sc);
                    *(u32x4*)(O + PX((size_t)row, col0 + bj * 128)) = w;
                }
            }
    }
};
struct EpiY2 {
    static constexpr bool PERM = true, AFTER_DRAIN = false;
    bf16* O; float* SS; float osc;
    __device__ __forceinline__ void operator()(const pg8::f32x4 (&acc)[2][2][4][2], const pg8::Unit& u, int wr, int wc, int fr, int fq) const {
        const int row0 = u.pm * 256 + wr * 64 + fr, col0 = u.pn * 256 + wc * 32 + 8 * fq;
#pragma unroll
        for (int ai = 0; ai < 2; ++ai)
#pragma unroll
            for (int m = 0; m < 4; ++m) {
                const int row = row0 + ai * 128 + m * 16; float ss = 0.f;
                bf16* rowp = O + (size_t)row * D + col0;
#pragma unroll
                for (int bj = 0; bj < 2; ++bj) {
                    const pg8::f32x4 v0 = acc[ai][bj][m][0] * osc, v1 = acc[ai][bj][m][1] * osc;
                    ss += (v0[0] * v0[0] + v0[1] * v0[1]) + (v0[2] * v0[2] + v0[3] * v0[3]) + (v1[0] * v1[0] + v1[1] * v1[1]) + (v1[2] * v1[2] + v1[3] * v1[3]);
                    u32x4 w; w.x = cvtpk(v0[0], v0[1]); w.y = cvtpk(v0[2], v0[3]); w.z = cvtpk(v1[0], v1[1]); w.w = cvtpk(v1[2], v1[3]);
                    *(u32x4*)(rowp + bj * 128) = w;
                }
                ss += swz_xor<16>(ss); ss = half_sum(ss);
                if (fq == 0) SS[(size_t)row * 16 + u.pn * 4 + wc] = ss;
            }
    }
};
constexpr float U_SCALE = 4.f, W2_SCALE = 256.f;
__device__ __forceinline__ unsigned pk4_fp8(float a, float b, float c, float d) {
    int w = __builtin_amdgcn_cvt_pk_fp8_f32(a, b, 0, false); w = __builtin_amdgcn_cvt_pk_fp8_f32(c, d, w, true); return (unsigned)w;
}
struct EpiRelu2F8 {
    static constexpr bool PERM = true, AFTER_DRAIN = false;
    unsigned char* O;
    __device__ __forceinline__ void operator()(const pg8::f32x4 (&acc)[2][2][4][2], const pg8::Unit& u, int wr, int wc, int fr, int fq) const {
        const int row0 = u.pm * 256 + wr * 64 + fr, col0 = u.pn * 256 + wc * 32 + 8 * fq;
#pragma unroll
        for (int ai = 0; ai < 2; ++ai)
#pragma unroll
            for (int m = 0; m < 4; ++m) {
                unsigned char* rowp = O + (size_t)(row0 + ai * 128 + m * 16) * FF + col0;
#pragma unroll
                for (int bj = 0; bj < 2; ++bj) {
                    pg8::f32x4 v0 = acc[ai][bj][m][0], v1 = acc[ai][bj][m][1];
#pragma unroll
                    for (int j = 0; j < 4; ++j) { const float a = fmaxf(v0[j], 0.f), b = fmaxf(v1[j], 0.f); v0[j] = fminf(a * a * U_SCALE, 448.f); v1[j] = fminf(b * b * U_SCALE, 448.f); }
                    u32x2 w; w.x = pk4_fp8(v0[0], v0[1], v0[2], v0[3]); w.y = pk4_fp8(v1[0], v1[1], v1[2], v1[3]);
                    *(u32x2*)(rowp + bj * 128) = w;
                }
            }
    }
};
struct EpiRelu2I8 {
    static constexpr bool PERM = true, AFTER_DRAIN = false;
    unsigned char* O; const float* HS; const unsigned* WMAX;
    __device__ __forceinline__ void operator()(const pg8::f32x4 (&acc)[2][2][4][2], const pg8::Unit& u, int wr, int wc, int fr, int fq) const {
        const int row0 = u.pm * 256 + wr * 64 + fr, col0 = u.pn * 256 + wc * 32 + 8 * fq;
        const float sw = __uint_as_float(*WMAX) * (1.f / 127.f);
        float rs[2][4];
#pragma unroll
        for (int ai = 0; ai < 2; ++ai)
#pragma unroll
            for (int m = 0; m < 4; ++m) rs[ai][m] = HS[row0 + ai * 128 + m * 16];
#pragma unroll
        for (int ai = 0; ai < 2; ++ai)
#pragma unroll
            for (int m = 0; m < 4; ++m) {
                unsigned char* rowp = O + (size_t)(row0 + ai * 128 + m * 16) * FF + col0;
                const float sc = rs[ai][m] * sw;
#pragma unroll
                for (int bj = 0; bj < 2; ++bj) {
                    const pg8::f32x4 a0 = acc[ai][bj][m][0], a1 = acc[ai][bj][m][1];
                    float v0[4], v1[4];
#pragma unroll
                    for (int j = 0; j < 4; ++j) { const float a = fmaxf((float)__float_as_int(a0[j]) * sc, 0.f), b = fmaxf((float)__float_as_int(a1[j]) * sc, 0.f); v0[j] = fminf(a * a * U_SCALE, 448.f); v1[j] = fminf(b * b * U_SCALE, 448.f); }
                    u32x2 w; w.x = pk4_fp8(v0[0], v0[1], v0[2], v0[3]); w.y = pk4_fp8(v1[0], v1[1], v1[2], v1[3]);
                    *(u32x2*)(rowp + bj * 128) = w;
                }
            }
    }
};
struct EpiRelu2 {
    static constexpr bool PERM = true, AFTER_DRAIN = false;
    bf16* O;
    __device__ __forceinline__ void operator()(const pg8::f32x4 (&acc)[2][2][4][2], const pg8::Unit& u, int wr, int wc, int fr, int fq) const {
        const int row0 = u.pm * 256 + wr * 64 + fr, col0 = u.pn * 256 + wc * 32 + 8 * fq;
#pragma unroll
        for (int ai = 0; ai < 2; ++ai)
#pragma unroll
            for (int m = 0; m < 4; ++m) {
                bf16* rowp = O + (size_t)(row0 + ai * 128 + m * 16) * FF + col0;
#pragma unroll
                for (int bj = 0; bj < 2; ++bj) {
                    pg8::f32x4 v0 = acc[ai][bj][m][0], v1 = acc[ai][bj][m][1];
#pragma unroll
                    for (int j = 0; j < 4; ++j) { const float a = fmaxf(v0[j], 0.f), b = fmaxf(v1[j], 0.f); v0[j] = a * a; v1[j] = b * b; }
                    u32x4 w; w.x = cvtpk(v0[0], v0[1]); w.y = cvtpk(v0[2], v0[3]); w.z = cvtpk(v1[0], v1[1]); w.w = cvtpk(v1[2], v1[3]);
                    *(u32x4*)(rowp + bj * 128) = w;
                }
            }
    }
};

__device__ __forceinline__ int map_rope(int j, int R) { return (j < R) ? ((j >> 1) + (j & 1) * (R >> 1)) : j; }
__device__ __forceinline__ int win_src(int n) {
    if (n < 256) return (n >> 6) * 64 + map_rope(n & 63, 16);
    if (n < 320) return 256 + map_rope(n - 256, 16);
    if (n < 384) return 320 + (n - 320);
    if (n < 448) return 896 + map_rope(n - 384, 16);
    if (n < 464) return 2504 + (n - 448);
    if (n < 472) return 960 + (n - 464);
    if (n < 512) return -1;
    if (n < 1024) { const int m = n - 512; return 384 + (m >> 6) * 64 + map_rope(m & 63, 16); }
    if (n < 1280) { const int m = n - 1024; return 968 + (m >> 6) * 64 + map_rope(m & 63, 64); }
    if (n < 1536) { const int m = n - 1280; return 1224 + (m >> 6) * 64 + map_rope(m & 63, 64); }
    if (n < 1792) return 1480 + (n - 1536);
    if (n < 2048) return 1736 + (n - 1792);
    if (n < 2176) return 1992 + (n - 2048);
    if (n < 2304) return 2120 + (n - 2176);
    if (n < 2560) return 2248 + (n - 2304);
    if (n < 2816) return 2520 + (n - 2560);
    if (n < 3072) { const int m = n - 2816; return 2776 + (m >> 5) * 32 + map_rope(m & 31, 8); }
    if (n < 3328) { const int m = n - 3072; return 3032 + (m >> 5) * 32 + map_rope(m & 31, 8); }
    return 3288 + (n - 3328);
}
template <bool PERMUTE>
__device__ __forceinline__ void transpose_item(const float* W, int K, int Nsrc, int Nout, bf16* WT, LAS float* scr, int item, int lane) {
    const int nblk = Nout / 32, kb = item / nblk, nb = item % nblk, k0 = 64 * kb, n0 = 32 * nb;
    const int nn = n0 + (lane & 31); const int src = PERMUTE ? win_src(nn) : nn;
#pragma unroll 8
    for (int i = 0; i < 32; ++i) { const int kk = 2 * i + (lane >> 5); scr[kk * 33 + (lane & 31)] = (src >= 0) ? W[(size_t)(k0 + kk) * Nsrc + src] : 0.f; }
    LDS_FENCE();
    const int c = lane & 7;
#pragma unroll
    for (int j = 0; j < 4; ++j) { const int n = (lane >> 3) + 8 * j; const LAS float* s = scr + (8 * c) * 33 + n;
        u32x4 o; o.x = cvtpk(s[0 * 33], s[1 * 33]); o.y = cvtpk(s[2 * 33], s[3 * 33]); o.z = cvtpk(s[4 * 33], s[5 * 33]); o.w = cvtpk(s[6 * 33], s[7 * 33]);
        *(u32x4*)(WT + (size_t)(n0 + n) * K + k0 + 8 * c) = o; }
    LDS_FENCE();
}

__device__ __forceinline__ void transpose_item_i8(const float* W, int K, int N, unsigned char* WT, LAS float* scr, int item, int lane, float inv) {
    const int nblk = N / 32, kb = item / nblk, nb = item % nblk, k0 = 64 * kb, n0 = 32 * nb;
#pragma unroll 8
    for (int i = 0; i < 32; ++i) { const int kk = 2 * i + (lane >> 5); scr[kk * 33 + (lane & 31)] = W[(size_t)(k0 + kk) * N + n0 + (lane & 31)]; }
    LDS_FENCE();
    const int c = lane & 7;
#pragma unroll
    for (int j = 0; j < 4; ++j) { const int n = (lane >> 3) + 8 * j; const LAS float* s = scr + (8 * c) * 33 + n;
        unsigned o[2];
#pragma unroll
        for (int hwd = 0; hwd < 2; ++hwd) {
            const int q0 = (int)__builtin_rintf(s[(4 * hwd + 0) * 33] * inv), q1 = (int)__builtin_rintf(s[(4 * hwd + 1) * 33] * inv), q2 = (int)__builtin_rintf(s[(4 * hwd + 2) * 33] * inv), q3 = (int)__builtin_rintf(s[(4 * hwd + 3) * 33] * inv);
            o[hwd] = (unsigned)(q0 & 255) | ((unsigned)(q1 & 255) << 8) | ((unsigned)(q2 & 255) << 16) | ((unsigned)q3 << 24);
        }
        u32x2 ov; ov.x = o[0]; ov.y = o[1];
        *(u32x2*)(WT + (size_t)(n0 + n) * K + k0 + 8 * c) = ov; }
    LDS_FENCE();
}
__device__ __forceinline__ void transpose_item_i8_win(const float* W, unsigned char* WT, LAS float* scr, int kb, int n0, int lane, float inv) {
    const int k0 = 64 * kb; const int src = win_src(n0 + (lane & 31));
#pragma unroll 8
    for (int i = 0; i < 32; ++i) { const int kk = 2 * i + (lane >> 5); scr[kk * 33 + (lane & 31)] = (src >= 0) ? W[(size_t)(k0 + kk) * NPROJ_SRC + src] : 0.f; }
    LDS_FENCE();
    const int c = lane & 7;
#pragma unroll
    for (int j = 0; j < 4; ++j) { const int n = (lane >> 3) + 8 * j; const LAS float* s = scr + (8 * c) * 33 + n;
        unsigned o[2];
#pragma unroll
        for (int hwd = 0; hwd < 2; ++hwd) {
            const int q0 = (int)__builtin_rintf(s[(4 * hwd + 0) * 33] * inv), q1 = (int)__builtin_rintf(s[(4 * hwd + 1) * 33] * inv), q2 = (int)__builtin_rintf(s[(4 * hwd + 2) * 33] * inv), q3 = (int)__builtin_rintf(s[(4 * hwd + 3) * 33] * inv);
            o[hwd] = (unsigned)(q0 & 255) | ((unsigned)(q1 & 255) << 8) | ((unsigned)(q2 & 255) << 16) | ((unsigned)q3 << 24);
        }
        u32x2 ov; ov.x = o[0]; ov.y = o[1];
        *(u32x2*)(WT + (size_t)(n0 + n) * D + k0 + 8 * c) = ov; }
    LDS_FENCE();
}
__device__ __forceinline__ void transpose_item_f8(const float* W, int K, int N, unsigned char* WT, LAS float* scr, int item, int lane) {
    const int nblk = N / 32, kb = item / nblk, nb = item % nblk, k0 = 64 * kb, n0 = 32 * nb;
#pragma unroll 8
    for (int i = 0; i < 32; ++i) { const int kk = 2 * i + (lane >> 5); scr[kk * 33 + (lane & 31)] = W[(size_t)(k0 + kk) * N + n0 + (lane & 31)]; }
    LDS_FENCE();
    const int c = lane & 7;
#pragma unroll
    for (int j = 0; j < 4; ++j) { const int n = (lane >> 3) + 8 * j; const LAS float* s = scr + (8 * c) * 33 + n;
        float v[8];
#pragma unroll
        for (int e = 0; e < 8; ++e) v[e] = fminf(fmaxf(s[e * 33] * W2_SCALE, -448.f), 448.f);
        u32x2 o; o.x = pk4_fp8(v[0], v[1], v[2], v[3]); o.y = pk4_fp8(v[4], v[5], v[6], v[7]);
        *(u32x2*)(WT + (size_t)(n0 + n) * K + k0 + 8 * c) = o; }
    LDS_FENCE();
}

#ifndef ROWS_IN_FLIGHT
#define ROWS_IN_FLIGHT 2
#endif
__device__ __forceinline__ size_t x1_off(int m) { return (size_t)(m & (M / 2 - 1)) * D; }
__device__ __forceinline__ float wave_max(float v) {
    v = fmaxf(v, swz_xor<1>(v)); v = fmaxf(v, swz_xor<2>(v)); v = fmaxf(v, swz_xor<4>(v)); v = fmaxf(v, swz_xor<8>(v)); v = fmaxf(v, swz_xor<16>(v));
    return half_max(v);
}
template <bool HAS_RES, bool DO_H, bool XIN_BF, bool XOUT_BF, int H_I8 = 0>
__device__ __forceinline__ void rowpass(const float* xin, float* xout, bf16* xa, bf16* xb, const bf16* y2, const float* ss, const float* gpost, const float* gate,
                                        const float* gpre, const float* scale, const float* shift, bf16* hout, int gw, int ngw, int lane, float* hs = nullptr, unsigned char* h8 = nullptr) {
    constexpr int NR = ROWS_IN_FLIGHT;
    const int wpb = ngw / BATCH;
    if (wpb * BATCH != ngw || wpb == 0) return;
    const int b = gw / wpb, j0 = gw - b * wpb;
    f32x4 gpo[4], gat[4], gpr[4], scl[4], shf[4];
#pragma unroll
    for (int j = 0; j < 4; ++j) {
        const int c = 4 * lane + 256 * j;
        if (HAS_RES) { gpo[j] = *(const f32x4*)(gpost + c); gat[j] = *(const f32x4*)(gate + (size_t)b * 6144 + c); }
        if (DO_H) { gpr[j] = *(const f32x4*)(gpre + c); scl[j] = *(const f32x4*)(scale + (size_t)b * 6144 + c) + 1.0f; shf[j] = *(const f32x4*)(shift + (size_t)b * 6144 + c); }
    }
    for (int r0 = j0; r0 < T; r0 += NR * wpb) {
        int mm[NR]; bool live[NR];
#pragma unroll
        for (int u = 0; u < NR; ++u) { live[u] = (u == 0) || (r0 + u * wpb < T); mm[u] = b * T + (live[u] ? r0 + u * wpb : r0); }
        f32x4 v[NR][4]; float rstd[NR];
#pragma unroll
        for (int u = 0; u < NR; ++u)
#pragma unroll
            for (int j = 0; j < 4; ++j) {
                if (XIN_BF) { const u32x2 t = *(const u32x2*)((mm[u] < M / 2 ? xa : xb) + x1_off(mm[u]) + 4 * lane + 256 * j); v[u][j] = (f32x4){bflo(t.x), bfhi(t.x), bflo(t.y), bfhi(t.y)}; }
                else v[u][j] = *(const f32x4*)(xin + (size_t)mm[u] * D + 4 * lane + 256 * j);
            }
        if (HAS_RES) {
            u32x2 yy[NR][4];
#pragma unroll
            for (int u = 0; u < NR; ++u) {
                const float* sp = ss + (size_t)mm[u] * 16;
                const f32x4 s0 = *(const f32x4*)(sp), s1 = *(const f32x4*)(sp + 4), s2 = *(const f32x4*)(sp + 8), s3 = *(const f32x4*)(sp + 12);
                const float s = ((s0[0] + s0[1]) + (s0[2] + s0[3])) + ((s1[0] + s1[1]) + (s1[2] + s1[3])) + ((s2[0] + s2[1]) + (s2[2] + s2[3])) + ((s3[0] + s3[1]) + (s3[2] + s3[3]));
                rstd[u] = 1.0f / sqrtf(s * (1.f / D) + EPS);
#pragma unroll
                for (int j = 0; j < 4; ++j) yy[u][j] = *(const u32x2*)(y2 + (size_t)mm[u] * D + 4 * lane + 256 * j);
            }
#pragma unroll
            for (int u = 0; u < NR; ++u)
#pragma unroll
                for (int j = 0; j < 4; ++j) {
                    const int c = 4 * lane + 256 * j;
                    const f32x4 yv = {bflo(yy[u][j].x), bfhi(yy[u][j].x), bflo(yy[u][j].y), bfhi(yy[u][j].y)};
                    v[u][j] = v[u][j] + gat[j] * (yv * rstd[u] * gpo[j]);
                    if (live[u]) {
                        if (XOUT_BF) { u32x2 w; w.x = cvtpk(v[u][j][0], v[u][j][1]); w.y = cvtpk(v[u][j][2], v[u][j][3]); *(u32x2*)((mm[u] < M / 2 ? xa : xb) + x1_off(mm[u]) + c) = w; }
                        else *(f32x4*)(xout + (size_t)mm[u] * D + c) = v[u][j];
                    }
                }
        }
        if (DO_H) {
            float q[NR];
#pragma unroll
            for (int u = 0; u < NR; ++u) { q[u] = 0.f;
#pragma unroll
                for (int j = 0; j < 4; ++j) q[u] += (v[u][j][0] * v[u][j][0] + v[u][j][1] * v[u][j][1]) + (v[u][j][2] * v[u][j][2] + v[u][j][3] * v[u][j][3]); }
#pragma unroll
            for (int u = 0; u < NR; ++u) q[u] = wave_sum(q[u]);
#pragma unroll
            for (int u = 0; u < NR; ++u) {
                const float rstd2 = 1.0f / sqrtf(q[u] * (1.f / D) + EPS);
                if (H_I8) {
                    f32x4 hq[4]; float am = 0.f;
#pragma unroll
                    for (int j = 0; j < 4; ++j) { hq[j] = (v[u][j] * rstd2 * gpr[j]) * scl[j] + shf[j]; am = fmaxf(am, fmaxf(fmaxf(fabsf(hq[j][0]), fabsf(hq[j][1])), fmaxf(fabsf(hq[j][2]), fabsf(hq[j][3])))); }
                    am = fmaxf(wave_max(am), 1.0e-20f);
                    const float inv = 127.f / am;
                    unsigned char* hb = h8 + (size_t)mm[u] * D + 4 * lane;
#pragma unroll
                    for (int j = 0; j < 4; ++j) {
                        const int q0 = (int)__builtin_rintf(hq[j][0] * inv), q1 = (int)__builtin_rintf(hq[j][1] * inv), q2 = (int)__builtin_rintf(hq[j][2] * inv), q3 = (int)__builtin_rintf(hq[j][3] * inv);
                        const unsigned w = (unsigned)(q0 & 255) | ((unsigned)(q1 & 255) << 8) | ((unsigned)(q2 & 255) << 16) | ((unsigned)q3 << 24);
                        if (live[u]) *(unsigned*)(hb + 256 * j) = w;
                    }
                    if (live[u] && lane == 0) hs[mm[u]] = am * (1.f / 127.f);
                    if (H_I8 == 2) {
#pragma unroll
                        for (int j = 0; j < 4; ++j) { u32x2 w; w.x = cvtpk(hq[j][0], hq[j][1]); w.y = cvtpk(hq[j][2], hq[j][3]); if (live[u]) *(u32x2*)(hout + (size_t)mm[u] * D + 4 * lane + 256 * j) = w; }
                    }
                } else {
#pragma unroll
                for (int j = 0; j < 4; ++j) {
                    const int c = 4 * lane + 256 * j;
                    const f32x4 h = (v[u][j] * rstd2 * gpr[j]) * scl[j] + shf[j];
                    u32x2 w; w.x = cvtpk(h[0], h[1]); w.y = cvtpk(h[2], h[3]);
                    if (live[u]) *(u32x2*)(hout + (size_t)mm[u] * D + c) = w;
                }
                }
            }
        }
    }
}

__device__ __forceinline__ void store_pair16(const u32x2 a, const u32x2 b, bf16* p) {
    const auto r0 = __builtin_amdgcn_permlane32_swap(a.x, b.x, false, false), r1 = __builtin_amdgcn_permlane32_swap(a.y, b.y, false, false);
    u32x4 o; o.x = r0[0]; o.y = r1[0]; o.z = r0[1]; o.w = r1[1];
    *(u32x4*)p = o;
}
__device__ __forceinline__ void load_rows16(const bf16* p, int hh, u32x4 (&raw)[4]) {
#pragma unroll
    for (int me = 0; me < 2; ++me)
#pragma unroll
        for (int gp = 0; gp < 4; gp += 2) raw[me * 2 + (gp >> 1)] = *(const u32x4*)(p + (4 * me + gp + hh) * PXC);
}
__device__ __forceinline__ void unpack_pair16(const u32x4 raw, u32x2& ga, u32x2& gb) {
    const auto r0 = __builtin_amdgcn_permlane32_swap(raw.x, raw.z, false, false), r1 = __builtin_amdgcn_permlane32_swap(raw.y, raw.w, false, false);
    ga.x = r0[0]; ga.y = r1[0]; gb.x = r0[1]; gb.y = r1[1];
}
__device__ __forceinline__ void load_gains(const float* gptr, int hh, f32x4 (&gain)[8]) {
#pragma unroll
    for (int me = 0; me < 2; ++me)
#pragma unroll
        for (int g = 0; g < 4; ++g) gain[me * 4 + g] = *(const f32x4*)(gptr + 32 * me + 8 * g + 4 * hh);
}
template <bool GATE, bool FASTSILU>
__device__ __forceinline__ void headnorm_pair(const f32x16& resme, int me, int gp, int hh, float rstd, const f32x4 (&gain)[8], const u32x4 graw, bf16* outp) {
    u32x2 ga, gb, w[2];
    if (GATE) unpack_pair16(graw, ga, gb);
#pragma unroll
    for (int k = 0; k < 2; ++k) {
        const int g = gp + k;
        const f32x4 gv = gain[me * 4 + g];
        float o[4];
#pragma unroll
        for (int j = 0; j < 4; ++j) o[j] = resme[4 * g + j] * rstd * gv[j];
        if (GATE) {
            const u32x2 gg = k ? gb : ga;
            const float z[4] = {bflo(gg.x), bfhi(gg.x), bflo(gg.y), bfhi(gg.y)};
#pragma unroll
            for (int j = 0; j < 4; ++j) o[j] *= FASTSILU ? z[j] * __builtin_amdgcn_rcpf(1.f + __builtin_amdgcn_exp2f(-z[j] * LOG2E)) : z[j] / (1.f + __expf(-z[j]));
        }
        w[k].x = cvtpk(o[0], o[1]); w[k].y = cvtpk(o[2], o[3]);
    }
    store_pair16(w[0], w[1], outp + 32 * me + 8 * gp + 8 * hh);
}
template <bool CENTER, bool GATE>
__device__ __forceinline__ void headnorm_store(f32x16 (&res)[2], int hh_in, const float* gptr, const bf16* gateptr, float oscale, bf16* outp) {
    int hh = hh_in; asm volatile("" : "+v"(hh));
    f32x4 gain[8]; load_gains(gptr, hh, gain);
    u32x4 graw[4];
    if (GATE) load_rows16(gateptr, hh, graw);
    if (CENTER) {
        float s = 0.f;
#pragma unroll
        for (int me = 0; me < 2; ++me)
#pragma unroll
            for (int i = 0; i < 16; ++i) s += res[me][i];
        s = half_sum(s);
        const float mean = s * (1.f / 64.f);
#pragma unroll
        for (int me = 0; me < 2; ++me)
#pragma unroll
            for (int i = 0; i < 16; ++i) res[me][i] -= mean;
    }
    float q = 0.f;
#pragma unroll
    for (int me = 0; me < 2; ++me)
#pragma unroll
        for (int i = 0; i < 16; ++i) q += res[me][i] * res[me][i];
    q = half_sum(q);
    const float rstd = oscale / sqrtf(q * (1.f / 64.f) + EPS);
#pragma unroll
    for (int me = 0; me < 2; ++me)
#pragma unroll
        for (int gp = 0; gp < 4; gp += 2) headnorm_pair<GATE, false>(res[me], me, gp, hh, rstd, gain, GATE ? graw[me * 2 + (gp >> 1)] : (u32x4){0u, 0u, 0u, 0u}, outp);
}

#ifndef ATTN_PREFETCH
#define ATTN_PREFETCH 1
#endif
#ifndef ATTN_SB
#define ATTN_SB 0
#endif
template <bool CENTER>
__device__ __forceinline__ void headnorm_store_g(f32x16 (&res)[2], int hh_in, const float* gptr, const u32x4 (&graw)[4], float oscale, bf16* outp) {
    int hh = hh_in; asm volatile("" : "+v"(hh));
    f32x4 gain[8]; load_gains(gptr, hh, gain);
    if (CENTER) {
        float s = 0.f;
#pragma unroll
        for (int me = 0; me < 2; ++me)
#pragma unroll
            for (int i = 0; i < 16; ++i) s += res[me][i];
        s = half_sum(s);
        const float mean = s * (1.f / 64.f);
#pragma unroll
        for (int me = 0; me < 2; ++me)
#pragma unroll
            for (int i = 0; i < 16; ++i) res[me][i] -= mean;
    }
    float q = 0.f;
#pragma unroll
    for (int me = 0; me < 2; ++me)
#pragma unroll
        for (int i = 0; i < 16; ++i) q += res[me][i] * res[me][i];
    q = half_sum(q);
    const float rstd = oscale / sqrtf(q * (1.f / 64.f) + EPS);
#pragma unroll
    for (int me = 0; me < 2; ++me)
#pragma unroll
        for (int gp = 0; gp < 4; gp += 2) headnorm_pair<true, true>(res[me], me, gp, hh, rstd, gain, graw[me * 2 + (gp >> 1)], outp);
}

constexpr int ATTN_BUF = 64 * 144 + 8192;
template <int NC, int DK, bool MASKED>
__device__ __forceinline__ void attn_core(LAS unsigned char* lds, const bf16* kbase, const bf16* vbase, const bf16* qrow, int nt_block, int nt_wave,
                                          const u64* mrow, f32x16 (&o)[NC][2], float (&lsum)[NC], int tid, int lane) {
    static_assert((NC == 2 && !MASKED) || (NC == 1 && MASKED), "two maps unmasked (differential) or one map masked (DSA)");
    constexpr int KST = DK / 16;
    constexpr float THR = 14.f;
    const int r = lane & 31, hh = lane >> 5;
    bf16x8 qf[NC][KST];
#pragma unroll
    for (int cc = 0; cc < NC; ++cc)
#pragma unroll
        for (int s = 0; s < KST; ++s) qf[cc][s] = ldg16(qrow + ((cc * DK + 16 * s) / 8 + hh) * PXC);
    float negm[NC];
#pragma unroll
    for (int cc = 0; cc < NC; ++cc) { negm[cc] = 0.f; lsum[cc] = 0.f; o[cc][0] = zero16(); o[cc][1] = zero16(); }
    const int krow_ = tid >> 3, kch = tid & 7;
    const int ksw = krow_ * 144 + kch * 16, vsw = 64 * 144 + (kch >> 2) * 4096 + krow_ * 64 + (kch & 3) * 16;
    const int kfo = r * 144 + hh * 16;
    const int vto = (int)(tr_base_perm(lds + 64 * 144, lane) - lds);
    const bf16* kp = kbase + (kch * 64 + krow_) * 8; const bf16* vp = vbase + (kch * 64 + krow_) * 8;
    bf16x8 kreg = ldg16(kp), vreg = ldg16(vp);
    *(LAS bf16x8*)(lds + ksw) = kreg; *(LAS bf16x8*)(lds + vsw) = vreg;
    if (nt_block > 1) { kreg = ldg16(kp + PX_TILE_STRIDE); vreg = ldg16(vp + PX_TILE_STRIDE); }
    __syncthreads();
    for (int t = 0; t < nt_block; ++t) {
        LAS unsigned char* const buf = lds + (t & 1) * ATTN_BUF;
        if (t < nt_wave) {
            const LAS unsigned char* const kfb = buf + kfo; const LAS unsigned char* const vtb = buf + vto;
            if constexpr (NC == 2) {
                bf16x8 vf[2][4];
                vf[0][0] = ld_tr_perm<0, 0>(vtb); vf[0][1] = ld_tr_perm<0, 16>(vtb); vf[0][2] = ld_tr_perm<0, 32>(vtb); vf[0][3] = ld_tr_perm<0, 48>(vtb);
                vf[1][0] = ld_tr_perm<1, 0>(vtb); vf[1][1] = ld_tr_perm<1, 16>(vtb); vf[1][2] = ld_tr_perm<1, 32>(vtb); vf[1][3] = ld_tr_perm<1, 48>(vtb);
                f32x16 sa[2][2];
                if (__builtin_amdgcn_ballot_w64(negm[0] != 0.f || negm[1] != 0.f) == 0ull) {
#pragma unroll
                    for (int cc = 0; cc < 2; ++cc)
#pragma unroll
                        for (int kt = 0; kt < 2; ++kt) {
                            sa[cc][kt] = mfma32(*(const LAS bf16x8*)(kfb + (32 * kt * 144 + (cc * DK) * 2)), qf[cc][0], zero16());
#pragma unroll
                            for (int s = 1; s < KST; ++s) sa[cc][kt] = mfma32(*(const LAS bf16x8*)(kfb + (32 * kt * 144 + (cc * DK + 16 * s) * 2)), qf[cc][s], sa[cc][kt]);
                        }
                } else {
#pragma unroll
                    for (int cc = 0; cc < 2; ++cc)
#pragma unroll
                        for (int kt = 0; kt < 2; ++kt) {
                            f32x16 c0;
#pragma unroll
                            for (int i = 0; i < 16; ++i) c0[i] = negm[cc];
                            sa[cc][kt] = mfma32(*(const LAS bf16x8*)(kfb + (32 * kt * 144 + (cc * DK) * 2)), qf[cc][0], c0);
#pragma unroll
                            for (int s = 1; s < KST; ++s) sa[cc][kt] = mfma32(*(const LAS bf16x8*)(kfb + (32 * kt * 144 + (cc * DK + 16 * s) * 2)), qf[cc][s], sa[cc][kt]);
                        }
                }
#pragma unroll
                for (int cc = 0; cc < 2; ++cc) {
                    float tmax = sa[cc][0][0];
#pragma unroll
                    for (int i = 1; i < 16; ++i) tmax = fmaxf(tmax, sa[cc][0][i]);
#pragma unroll
                    for (int i = 0; i < 16; ++i) tmax = fmaxf(tmax, sa[cc][1][i]);
                    if (__builtin_amdgcn_ballot_w64(tmax > THR || (t == 0 && tmax < -24.f)) != 0ull) {
                        const float hm = half_max(tmax);
                        tmax = (hm > THR) ? hm : ((t == 0 && hm < -24.f) ? fmaxf(hm, -64.f) : 0.f);
                        const float alpha = __builtin_amdgcn_exp2f(-tmax);
                        negm[cc] -= tmax; lsum[cc] *= alpha;
#pragma unroll
                        for (int i = 0; i < 16; ++i) { o[cc][0][i] *= alpha; o[cc][1][i] *= alpha; sa[cc][0][i] -= tmax; sa[cc][1][i] -= tmax; }
                    }
                    float ps = 0.f;
#pragma unroll
                    for (int kt = 0; kt < 2; ++kt)
#pragma unroll
                        for (int i = 0; i < 16; ++i) { const float p = __builtin_amdgcn_exp2f(sa[cc][kt][i]); sa[cc][kt][i] = p; ps += p; }
                    lsum[cc] += ps;
                    const bf16x8 p00 = pack8<0>(sa[cc][0]), p01 = pack8<1>(sa[cc][0]), p10 = pack8<0>(sa[cc][1]), p11 = pack8<1>(sa[cc][1]);
                    o[cc][0] = mfma32(vf[0][0], p00, o[cc][0]); o[cc][0] = mfma32(vf[0][1], p01, o[cc][0]);
                    o[cc][0] = mfma32(vf[0][2], p10, o[cc][0]); o[cc][0] = mfma32(vf[0][3], p11, o[cc][0]);
                    o[cc][1] = mfma32(vf[1][0], p00, o[cc][1]); o[cc][1] = mfma32(vf[1][1], p01, o[cc][1]);
                    o[cc][1] = mfma32(vf[1][2], p10, o[cc][1]); o[cc][1] = mfma32(vf[1][3], p11, o[cc][1]);
                }
            } else {
                const u64 mw = mrow[t];
                bf16x8 vf[2][4];
                vf[0][0] = ld_tr_perm<0, 0>(vtb); vf[0][1] = ld_tr_perm<0, 16>(vtb); vf[0][2] = ld_tr_perm<0, 32>(vtb); vf[0][3] = ld_tr_perm<0, 48>(vtb);
                vf[1][0] = ld_tr_perm<1, 0>(vtb); vf[1][1] = ld_tr_perm<1, 16>(vtb); vf[1][2] = ld_tr_perm<1, 32>(vtb); vf[1][3] = ld_tr_perm<1, 48>(vtb);
                f32x16 sa[2];
#pragma unroll
                for (int kt = 0; kt < 2; ++kt) {
                    const unsigned m32 = (unsigned)(mw >> (32 * kt + 4 * hh));
#pragma unroll
                    for (int i = 0; i < 16; ++i) {
                        const int sel = __builtin_amdgcn_sbfe((int)m32, (i & 3) + 8 * (i >> 2), 1);
                        sa[kt][i] = __int_as_float((sel & __float_as_int(negm[0])) | (~sel & (int)0xF149F2CAu));
                    }
#pragma unroll
                    for (int s = 0; s < KST; ++s) sa[kt] = mfma32(*(const LAS bf16x8*)(kfb + (32 * kt * 144 + (16 * s) * 2)), qf[0][s], sa[kt]);
                }
#pragma unroll
                for (int kt = 0; kt < 2; ++kt) {
                    float tmax = sa[kt][0];
#pragma unroll
                    for (int i = 1; i < 16; ++i) tmax = fmaxf(tmax, sa[kt][i]);
                    if ((t == 0 && kt == 0) || __builtin_amdgcn_ballot_w64(tmax > THR) != 0ull) {
                        tmax = fmaxf(half_max(tmax), (t == 0 && kt == 0) ? -64.f : 0.f);
                        const float alpha = __builtin_amdgcn_exp2f(-tmax);
                        negm[0] -= tmax; lsum[0] *= alpha;
#pragma unroll
                        for (int i = 0; i < 16; ++i) { o[0][0][i] *= alpha; o[0][1][i] *= alpha; sa[kt][i] -= tmax; if (kt == 0) sa[1][i] -= tmax; }
                    }
                    float ps = 0.f;
#pragma unroll
                    for (int i = 0; i < 16; ++i) { const float p = __builtin_amdgcn_exp2f(sa[kt][i]); sa[kt][i] = p; ps += p; }
                    lsum[0] += ps;
                    const bf16x8 p0 = pack8<0>(sa[kt]), p1 = pack8<1>(sa[kt]);
                    o[0][0] = mfma32(vf[0][2 * kt], p0, o[0][0]); o[0][0] = mfma32(vf[0][2 * kt + 1], p1, o[0][0]);
                    o[0][1] = mfma32(vf[1][2 * kt], p0, o[0][1]); o[0][1] = mfma32(vf[1][2 * kt + 1], p1, o[0][1]);
                }
            }
        }
        if (t + 1 < nt_block) {
            LAS unsigned char* const nb = lds + ((t + 1) & 1) * ATTN_BUF;
            *(LAS bf16x8*)(nb + ksw) = kreg; *(LAS bf16x8*)(nb + vsw) = vreg;
            if (t + 2 < nt_block) { kreg = ldg16(kp + (size_t)(t + 2) * PX_TILE_STRIDE); vreg = ldg16(vp + (size_t)(t + 2) * PX_TILE_STRIDE); }
        }
        __syncthreads();
    }
}

__device__ __forceinline__ void diff_unit(LAS unsigned char* lds, const bf16* proj, bf16* Y, const float* hng, float lam, float lam_init, int b, int h, int qb, int tid, int lane, int wave) {
    const int q0 = 256 * qb, qtok = q0 + 32 * wave + (lane & 31), hh = lane >> 5;
    const size_t tokrow = (size_t)b * T + qtok;
    f32x16 o[2][2]; float ls[2];
    const int nt_block = (q0 + 256) / 64, nt_wave = ((q0 + 32 * wave) >> 6) + 1;
    attn_core<2, 32, false>(lds, proj + PX((size_t)b * T, COL_DK + h * 64), proj + PX((size_t)b * T, COL_DV + h * 64), proj + PX(tokrow, COL_DQ + h * 64), nt_block, nt_wave, nullptr, o, ls, tid, lane);
    const float l0 = half_sum(ls[0]), l1 = half_sum(ls[1]);
    const float i0 = 1.f / l0, i1 = lam / l1;
    f32x16 res[2];
#pragma unroll
    for (int me = 0; me < 2; ++me)
#pragma unroll
        for (int i = 0; i < 16; ++i) res[me][i] = o[0][me][i] * i0 - o[1][me][i] * i1;
    headnorm_store<false, false>(res, hh, hng + 768 + h * 64, nullptr, 1.f - lam_init, Y + tokrow * D + 768 + h * 64);
}
__device__ __forceinline__ void dsa_unit(LAS unsigned char* lds, const bf16* proj, const u64* mask, bf16* Y, const float* hng, int b, int qc, int tid, int lane, int wave) {
    const int head = wave >> 1, qtok = 64 * qc + 32 * (wave & 1) + (lane & 31), hh = lane >> 5;
    const size_t tokrow = (size_t)b * T + qtok;
    f32x16 o[1][2]; float ls[1];
    attn_core<1, 64, true>(lds, proj + PX((size_t)b * T, COL_AK), proj + PX((size_t)b * T, COL_AV), proj + PX(tokrow, COL_AQ + head * 64), qc + 1, qc + 1, mask + tokrow * 64, o, ls, tid, lane);
    const float l0 = half_sum(ls[0]), i0 = 1.f / l0;
    f32x16 res[2];
#pragma unroll
    for (int me = 0; me < 2; ++me)
#pragma unroll
        for (int i = 0; i < 16; ++i) res[me][i] = o[0][me][i] * i0;
    headnorm_store<false, false>(res, hh, hng + head * 64, nullptr, 1.f, Y + tokrow * D + head * 64);
}
#ifndef REP_IDX_MM
#define REP_IDX_MM 1
#endif
__device__ __forceinline__ void count8(int& acc0, int& acc1, float k0, float k1, float k2, float k3, float k4, float k5, float k6, float k7, float cand) {
    unsigned long long m0, m1, m2, m3, m4, m5, m6, m7, dmy;
    asm volatile(
        "v_cmp_ge_f32_e64 %2, %11, %19\n\t"
        "v_cmp_ge_f32_e64 %3, %12, %19\n\t"
        "v_cmp_ge_f32_e64 %4, %13, %19\n\t"
        "v_cmp_ge_f32_e64 %5, %14, %19\n\t"
        "v_cmp_ge_f32_e64 %6, %15, %19\n\t"
        "v_cmp_ge_f32_e64 %7, %16, %19\n\t"
        "v_cmp_ge_f32_e64 %8, %17, %19\n\t"
        "v_cmp_ge_f32_e64 %9, %18, %19\n\t"
        "v_addc_co_u32_e64 %0, %10, %0, 0, %2\n\t"
        "v_addc_co_u32_e64 %1, %10, %1, 0, %3\n\t"
        "v_addc_co_u32_e64 %0, %10, %0, 0, %4\n\t"
        "v_addc_co_u32_e64 %1, %10, %1, 0, %5\n\t"
        "v_addc_co_u32_e64 %0, %10, %0, 0, %6\n\t"
        "v_addc_co_u32_e64 %1, %10, %1, 0, %7\n\t"
        "v_addc_co_u32_e64 %0, %10, %0, 0, %8\n\t"
        "v_addc_co_u32_e64 %1, %10, %1, 0, %9"
        : "+v"(acc0), "+v"(acc1), "=&s"(m0), "=&s"(m1), "=&s"(m2), "=&s"(m3), "=&s"(m4), "=&s"(m5), "=&s"(m6), "=&s"(m7), "=&s"(dmy)
        : "v"(k0), "v"(k1), "v"(k2), "v"(k3), "v"(k4), "v"(k5), "v"(k6), "v"(k7), "v"(cand));
}
__device__ __forceinline__ float key_to_float(unsigned k) { return __uint_as_float((k & 0x80000000u) ? (k & 0x7fffffffu) : ~k); }
#define DPP_F(v, ctrl) __int_as_float(__builtin_amdgcn_update_dpp(0, __float_as_int(v), (ctrl), 0xF, 0xF, true))
__device__ __forceinline__ float wave_max_f(float v) {
    v = fmaxf(v, DPP_F(v, 0xB1)); v = fmaxf(v, DPP_F(v, 0x4E)); v = fmaxf(v, DPP_F(v, 0x141)); v = fmaxf(v, DPP_F(v, 0x140));
    const float a = __int_as_float(__builtin_amdgcn_readlane(__float_as_int(v), 0)), b = __int_as_float(__builtin_amdgcn_readlane(__float_as_int(v), 16));
    const float c = __int_as_float(__builtin_amdgcn_readlane(__float_as_int(v), 32)), d = __int_as_float(__builtin_amdgcn_readlane(__float_as_int(v), 48));
    return fmaxf(fmaxf(a, b), fmaxf(c, d));
}
__device__ __forceinline__ float wave_min_f(float v) { return -wave_max_f(-v); }
__device__ __forceinline__ unsigned wave_incl_scan(unsigned v) {
    v += (unsigned)__builtin_amdgcn_update_dpp(0, (int)v, 0x111, 0xF, 0xF, false);
    v += (unsigned)__builtin_amdgcn_update_dpp(0, (int)v, 0x112, 0xF, 0xF, false);
    v += (unsigned)__builtin_amdgcn_update_dpp(0, (int)v, 0x114, 0xF, 0xF, false);
    v += (unsigned)__builtin_amdgcn_update_dpp(0, (int)v, 0x118, 0xF, 0xF, false);
    v += (unsigned)__builtin_amdgcn_update_dpp(0, (int)v, 0x142, 0xA, 0xF, false);
    v += (unsigned)__builtin_amdgcn_update_dpp(0, (int)v, 0x143, 0xC, 0xF, false);
    return v;
}
template <int NG>
__device__ __forceinline__ bool topk_hist(const float (&x)[64], LAS unsigned* H, LAS float* LIST, float& tf, bool& found, int lane) {
    float g0 = x[0], g1 = x[1], g2 = x[2], g3 = x[3];
#pragma unroll
    for (int i = 4; i < 8 * NG; i += 4) { g0 = fmaxf(g0, x[i]); g1 = fmaxf(g1, x[i + 1]); g2 = fmaxf(g2, x[i + 2]); g3 = fmaxf(g3, x[i + 3]); }
    const float hi = wave_max_f(fmaxf(fmaxf(g0, g1), fmaxf(g2, g3))), lo = wave_min_f(fminf(fminf(g0, g1), fminf(g2, g3)));
    if (!(hi > lo) || !(lo > -3.0e38f) || !(hi < 3.0e38f)) return false;
    const float s4 = 16124.f / (hi - lo), hs4 = __builtin_fmaf(hi, s4, 0.25f);
    if (!(s4 < 1.0e30f)) return false;
#pragma unroll
    for (int k = 0; k < 16; ++k) *(LAS u32x4*)(H + 4 * (lane + 64 * k)) = (u32x4){0u, 0u, 0u, 0u};
    const float dummy = (float)(16128 + 4 * lane);
    const unsigned hbase = (unsigned)(__UINTPTR_TYPE__)H;
#pragma unroll
    for (int i = 0; i < 8 * NG; ++i) {
        const float t4 = __builtin_fmaf(x[i], -s4, hs4);
        __hip_atomic_fetch_add((LAS unsigned*)(__UINTPTR_TYPE__)(((unsigned)fminf(t4, dummy) & ~3u) | hbase), 1u, __ATOMIC_RELAXED, __HIP_MEMORY_SCOPE_WORKGROUP);
    }
    LDS_FENCE();
    const LAS unsigned* hp = H + 63 * lane;
    unsigned tot = 0u;
#pragma unroll
    for (int jb = 0; jb < 64; jb += 16) {
        unsigned hv[16];
#pragma unroll
        for (int j = 0; j < 16; ++j) hv[j] = (jb + j < 63) ? hp[jb + j] : 0u;
        __builtin_amdgcn_sched_barrier(0);
#pragma unroll
        for (int j = 0; j < 16; j += 2) tot += hv[j] + hv[j + 1];
        __builtin_amdgcn_sched_barrier(0);
    }
    const unsigned P = wave_incl_scan(tot);
    if (__builtin_amdgcn_readlane((int)P, 63) < 256) return false;
    const int Ls = __builtin_ctzll(__builtin_amdgcn_ballot_w64(P >= 256u));
    const unsigned basec = (unsigned)__builtin_amdgcn_readlane((int)(P - tot), Ls);
    const unsigned h = (lane < 63) ? H[63 * Ls + lane] : 0u;
    const unsigned Q = wave_incl_scan(h);
    const int js = __builtin_ctzll(__builtin_amdgcn_ballot_w64(basec + Q >= 256u));
    const int cab = (int)basec + __builtin_amdgcn_readlane((int)(Q - h), js), nB = __builtin_amdgcn_readlane((int)h, js);
    const int B = 63 * Ls + js, need = 256 - cab;
    const float lo4 = 4.f * (float)B;
    int ncand = 0;
#pragma unroll
    for (int g = 0; g < NG; ++g) {
        u64 m[8], any = 0ull;
#pragma unroll
        for (int k = 0; k < 8; ++k) { const float t4 = __builtin_fmaf(x[8 * g + k], -s4, hs4); m[k] = __builtin_amdgcn_ballot_w64(__float_as_uint(t4 - lo4) < 0x40800000u); any |= m[k]; }
        if (any != 0ull) {
#pragma unroll
            for (int k = 0; k < 8; ++k) if (m[k] != 0ull) {
                const int pos = ncand + (int)__builtin_amdgcn_mbcnt_hi((unsigned)(m[k] >> 32), __builtin_amdgcn_mbcnt_lo((unsigned)m[k], 0u));
                if (((m[k] >> lane) & 1ull) && pos < 256) LIST[pos] = x[8 * g + k];
                ncand += __builtin_popcountll(m[k]);
            }
        }
    }
    if (ncand != nB || ncand > 64 || need < 1 || need > ncand) return false;
    LDS_FENCE();
    const float c = (lane < ncand) ? LIST[lane] : -__builtin_inff();
    int G = 0, GE = 0;
    for (int i = 0; i < ncand; ++i) { const float v = LIST[i]; G += (v > c) ? 1 : 0; GE += (v >= c) ? 1 : 0; }
    const u64 ok = __builtin_amdgcn_ballot_w64(lane < ncand && G < need && need <= GE);
    if (ok == 0ull) return false;
    const int j0 = __builtin_ctzll(ok);
    tf = __int_as_float(__builtin_amdgcn_readlane(__float_as_int(c), j0));
    found = (__builtin_amdgcn_readlane(GE, j0) == need);
    return true;
}
template <int NG>
__device__ __forceinline__ void topk_search(const float (&x)[64], LAS unsigned* H, LAS float* LIST, float& tf, bool& found, u64& myword, int lane_o) {
    found = false;
    if (!topk_hist<NG>(x, H, LIST, tf, found, lane_o)) {
    unsigned Tk = 0u; found = false;
    for (int bit = 31; bit >= 0; --bit) {
        const unsigned cand = Tk | (1u << bit);
        const float cf = key_to_float(cand);
        int cl = 0, cl2 = 0;
#pragma unroll
        for (int g = 0; g < NG; ++g) count8(cl, cl2, x[8 * g], x[8 * g + 1], x[8 * g + 2], x[8 * g + 3], x[8 * g + 4], x[8 * g + 5], x[8 * g + 6], x[8 * g + 7], cf);
        const int cnt = wave_sum_i(cl + cl2);
        if (cnt >= 256) { Tk = cand; if (cnt == 256) { found = true; break; } }
    }
    tf = key_to_float(Tk);
    }
    if (found) {
#pragma unroll
        for (int i = 0; i < 8 * NG; ++i) {
            const u64 w = __ballot(x[i] >= tf);
            if (lane_o == i) myword = w;
            if ((i & 3) == 3) __builtin_amdgcn_sched_barrier(0);
        }
    }
}
__device__ __forceinline__ void indexer_unit(LAS unsigned char* lds, const bf16* proj, const bf16* kip, u64* mask, int b, int g8, int lane, int wave) {
    const int q0 = g8 * 8, qc = q0 >> 6, L = 64 * (qc + 1), nr = qc + 1;
    u64* mout = mask + ((size_t)b * T + q0 + wave) * 64;
    if (L <= 256) { u64 ones = ~0ull; asm volatile("" : "+v"(ones)); if (lane < nr) mout[lane] = ones; return; }
    LAS float* SCR = (LAS float*)lds;
    const int r = lane & 31, hh = lane >> 5;
    bf16x8 af[2][4]; float wv[2][2][8];
    {
        const int a_ = r >> 4, b_ = (r >> 3) & 1, c_ = (r >> 2) & 1, d_ = r & 3;
#pragma unroll
        for (int mi = 0; mi < 2; ++mi) {
            const bf16* qp = proj + PX((size_t)b * T + q0 + 4 * mi + 2 * a_ + c_, COL_AQI + (4 * b_ + d_) * 64) + hh * PXC;
#pragma unroll
            for (int s = 0; s < 4; ++s) af[mi][s] = ldg16(qp + 2 * s * PXC);
#pragma unroll
            for (int a = 0; a < 2; ++a) {
                const u32x4 w4 = *(const u32x4*)(proj + PX((size_t)b * T + q0 + 4 * mi + 2 * a + hh, COL_AWI));
                wv[mi][a][0] = bflo(w4.x); wv[mi][a][1] = bfhi(w4.x); wv[mi][a][2] = bflo(w4.y); wv[mi][a][3] = bfhi(w4.y);
                wv[mi][a][4] = bflo(w4.z); wv[mi][a][5] = bfhi(w4.z); wv[mi][a][6] = bflo(w4.w); wv[mi][a][7] = bfhi(w4.w);
            }
        }
    }
    const bf16* kb = kip + (size_t)b * (T / 32) * 2048 + lane * 8;
    const int ntl = L / 32;
    for (int rep_mm = 0; rep_mm < REP_IDX_MM; ++rep_mm) {
    bf16x8 b0[4], b1[4], b2[4];
#pragma unroll
    for (int s = 0; s < 4; ++s) { b0[s] = ldg16(kb + (size_t)wave * 2048 + s * 512); b1[s] = b0[s]; b2[s] = b0[s]; }
    if (wave + 8 < ntl) {
#pragma unroll
        for (int s = 0; s < 4; ++s) b1[s] = ldg16(kb + (size_t)(wave + 8) * 2048 + s * 512);
    }
    if (wave + 16 < ntl) {
#pragma unroll
        for (int s = 0; s < 4; ++s) b2[s] = ldg16(kb + (size_t)(wave + 16) * 2048 + s * 512);
    }
    auto tile = [&](int kt, bf16x8 (&bq)[4]) {
#pragma unroll
        for (int mi = 0; mi < 2; ++mi) {
            f32x16 acc = zero16();
#pragma unroll
            for (int s = 0; s < 4; ++s) acc = mfma32(af[mi][s], bq[s], acc);
#pragma unroll
            for (int a = 0; a < 2; ++a) {
                float sc = 0.f;
#pragma unroll
                for (int h8 = 0; h8 < 8; ++h8) { const int ri = __float_as_int(acc[8 * a + h8]); sc = __builtin_fmaf(__int_as_float(ri > 0 ? ri : 0), wv[mi][a][h8], sc); }
                SCR[(4 * mi + 2 * a + hh) * 4096 + 32 * kt + r] = sc;
            }
        }
        if (kt + 24 < ntl) {
#pragma unroll
            for (int s = 0; s < 4; ++s) bq[s] = ldg16(kb + (size_t)(kt + 24) * 2048 + s * 512);
        }
    };
    for (int kt = wave; kt < ntl; kt += 24) {
        tile(kt, b0);
        if (kt + 8 < ntl) tile(kt + 8, b1);
        if (kt + 16 < ntl) tile(kt + 16, b2);
    }
    }
    {
        LAS float* padrow = SCR + wave * 4096;
        const int Lp = ((nr + 7) & ~7) * 64;
        for (int c = L + lane; c < Lp; c += 64) padrow[c] = -__builtin_inff();
    }
    __syncthreads();
    const LAS float* myrow = SCR + wave * 4096;
    float x[64];
#pragma unroll
    for (int g = 0; g < 8; ++g) {
        if (8 * g < nr) {
#pragma unroll
            for (int i = 0; i < 8; ++i) x[8 * g + i] = myrow[64 * (8 * g + i) + lane];
        } else {
#pragma unroll
            for (int i = 0; i < 8; ++i) x[8 * g + i] = -__builtin_inff();
        }
    }
    float tf = 0.f; bool found = false; u64 myword = 0ull;
    LAS unsigned* HH = (LAS unsigned*)(SCR + wave * 4096); LAS float* LIST = (LAS float*)(lds + 131072 + wave * 2048);
    int lane_o = lane; asm volatile("" : "+v"(lane_o));
    switch ((nr + 7) >> 3) {
        case 1: topk_search<1>(x, HH, LIST, tf, found, myword, lane_o); break;
        case 2: topk_search<2>(x, HH, LIST, tf, found, myword, lane_o); break;
        case 3: topk_search<3>(x, HH, LIST, tf, found, myword, lane_o); break;
        case 4: topk_search<4>(x, HH, LIST, tf, found, myword, lane_o); break;
        case 5: topk_search<5>(x, HH, LIST, tf, found, myword, lane_o); break;
        case 6: topk_search<6>(x, HH, LIST, tf, found, myword, lane_o); break;
        case 7: topk_search<7>(x, HH, LIST, tf, found, myword, lane_o); break;
        default: topk_search<8>(x, HH, LIST, tf, found, myword, lane_o); break;
    }
    if (!found) {
        int cgt = 0;
#pragma unroll
        for (int i = 0; i < 64; ++i) { cgt += __popcll(__ballot(x[i] > tf)); if ((i & 3) == 3) __builtin_amdgcn_sched_barrier(0); }
        int need = 256 - cgt;
        float tf2 = tf; asm volatile("" : "+v"(tf2));
#pragma unroll
        for (int i = 0; i < 64; ++i) {
            u64 w = __ballot(x[i] > tf2);
            u64 e = __ballot(x[i] == tf2);
            if (need > 0 && e != 0ull) {
                const int c = __popcll(e);
                if (c <= need) { w |= e; need -= c; }
                else { for (int t2 = 0; t2 < need; ++t2) { const u64 low = e & (0ull - e); w |= low; e ^= low; } need = 0; }
            }
            if (lane_o == i) myword = w;
            if ((i & 3) == 3) __builtin_amdgcn_sched_barrier(0);
        }
    }
    if (lane < nr) mout[lane] = myword;
    __syncthreads();
}

__device__ __forceinline__ float ret_log2g(int h) { return log2f(1.f - exp2f(-5.f - (float)h)); }
template <bool SCALE>
__device__ __forceinline__ void stage_img64(LAS unsigned char* img, const bf16* proj, size_t tok0, int col, int lane, float scale) {
    const bf16* vp = proj + PX(tok0 + lane, col);
#pragma unroll
    for (int ch = 0; ch < 8; ++ch) {
        bf16x8 vv = ldg16(vp + ch * PXC);
        if (SCALE) { u32x4 w; w.x = cvtpk(bf2f(vv[0]) * scale, bf2f(vv[1]) * scale); w.y = cvtpk(bf2f(vv[2]) * scale, bf2f(vv[3]) * scale); w.z = cvtpk(bf2f(vv[4]) * scale, bf2f(vv[5]) * scale); w.w = cvtpk(bf2f(vv[6]) * scale, bf2f(vv[7]) * scale); vv = __builtin_bit_cast(bf16x8, w); }
        *(LAS bf16x8*)(img + (ch >> 2) * 4096 + lane * 64 + (ch & 3) * 16) = vv;
    }
}
__device__ __forceinline__ void ret_state_unit(LAS unsigned char* wl, const bf16* proj, float* UB, int b, int c, int h, int lane) {
    LAS unsigned char* VI = wl; LAS unsigned char* KI = wl + 8192;
    const size_t tok0 = (size_t)b * T + 64 * c;
    const int r = lane & 31, hh = lane >> 5;
    stage_img64<false>(VI, proj, tok0, COL_BV + h * 64, lane, 1.f);
    stage_img64<true>(KI, proj, tok0, COL_BK + h * 64, lane, exp2f((63.f - (float)lane) * ret_log2g(h)));
    LDS_FENCE();
    const LAS unsigned char* const vnb = tr_base_nat(VI, lane); const LAS unsigned char* const knb = tr_base_nat(KI, lane);
    float* ub = UB + (size_t)((b * NCH + c) * 4 + h) * 4096;
    f32x16 acc[2][2];
#pragma unroll
    for (int me = 0; me < 2; ++me)
#pragma unroll
        for (int nd = 0; nd < 2; ++nd) acc[me][nd] = zero16();
#define RS_STEP(K0) do { const bf16x8 a0 = ld_tr_nat<0, K0>(vnb), a1 = ld_tr_nat<1, K0>(vnb), b0_ = ld_tr_nat<0, K0>(knb), b1_ = ld_tr_nat<1, K0>(knb); \
        acc[0][0] = mfma32(a0, b0_, acc[0][0]); acc[0][1] = mfma32(a0, b1_, acc[0][1]); acc[1][0] = mfma32(a1, b0_, acc[1][0]); acc[1][1] = mfma32(a1, b1_, acc[1][1]); } while (0)
    RS_STEP(0); RS_STEP(16); RS_STEP(32); RS_STEP(48);
#undef RS_STEP
#pragma unroll
    for (int me = 0; me < 2; ++me)
#pragma unroll
        for (int nd = 0; nd < 2; ++nd)
#pragma unroll
            for (int i = 0; i < 16; ++i) ub[(32 * me + crow(i, hh)) * 64 + 32 * nd + r] = acc[me][nd][i];
    LDS_FENCE();
}
__device__ __forceinline__ void ret_out_unit(LAS unsigned char* wl, const bf16* proj, const bf16* RB, const float* hng, bf16* Y, int b, int c, int h, int lane_in) {
    int lane = lane_in; asm volatile("" : "+v"(lane));
    LAS unsigned char* VI = wl;
    const size_t tok0 = (size_t)b * T + 64 * c;
    const int r = lane & 31, hh = lane >> 5;
    bf16x8 vrow[8], kf[2][4], qf[2][4], rbf[2][4];
    {
        const bf16* vp = proj + PX(tok0 + lane, COL_BV + h * 64);
#pragma unroll
        for (int ch = 0; ch < 8; ++ch) vrow[ch] = ldg16(vp + ch * PXC);
        const bf16* rb = RB + (size_t)((b * NCH + c) * 4 + h) * 4096;
#pragma unroll
        for (int mi = 0; mi < 2; ++mi)
#pragma unroll
            for (int s = 0; s < 4; ++s) {
                kf[mi][s] = ldg16(proj + PX(tok0 + 32 * mi + r, COL_BK + h * 64) + (2 * s + hh) * PXC);
                if (mi == 0) qf[0][s] = ldg16(proj + PX(tok0 + r, COL_BQ + h * 64) + (2 * s + hh) * PXC);
                rbf[mi][s] = ldg16(rb + (32 * mi + r) * 64 + 16 * s + 8 * hh);
            }
    }
#pragma unroll
    for (int ch = 0; ch < 8; ++ch) *(LAS bf16x8*)(VI + (ch >> 2) * 4096 + lane * 64 + (ch & 3) * 16) = vrow[ch];
    LDS_FENCE();
    const LAS unsigned char* const vtb = tr_base_perm(VI, lane);
    const float lg = ret_log2g(h);
#pragma unroll
    for (int ni = 0; ni < 2; ++ni) {
        const int i_ = 32 * ni + r;
        u32x4 gt[4];
        load_rows16(proj + PX(tok0 + i_, COL_BG + h * 64), hh, gt);
        if (ni == 0) {
#pragma unroll
            for (int s = 0; s < 4; ++s) qf[1][s] = ldg16(proj + PX(tok0 + 32 + r, COL_BQ + h * 64) + (2 * s + hh) * PXC);
        }
        f32x16 out[2];
#pragma unroll
        for (int me = 0; me < 2; ++me) {
            out[me] = zero16();
#pragma unroll
            for (int s = 0; s < 4; ++s) out[me] = mfma32(rbf[me][s], qf[ni][s], out[me]);
        }
        const float xi = __builtin_amdgcn_exp2f((float)(i_ + 1) * lg);
#pragma unroll
        for (int me = 0; me < 2; ++me)
#pragma unroll
            for (int i = 0; i < 16; ++i) out[me][i] *= xi;
#pragma unroll
        for (int mi = 0; mi < 2; ++mi) {
            f32x16 x = zero16();
#pragma unroll
            for (int s = 0; s < 4; ++s) x = mfma32(kf[mi][s], qf[ni][s], x);
#pragma unroll
            for (int i = 0; i < 16; ++i) { const int j_ = 32 * mi + crow(i, hh); x[i] *= __builtin_amdgcn_exp2f(fabsf((float)(i_ - j_)) * lg); }
            const bf16x8 p0 = pack8<0>(x), p1 = pack8<1>(x);
            if (mi == 0) {
                out[0] = mfma32(ld_tr_perm<0, 0>(vtb), p0, out[0]); out[0] = mfma32(ld_tr_perm<0, 16>(vtb), p1, out[0]);
                out[1] = mfma32(ld_tr_perm<1, 0>(vtb), p0, out[1]); out[1] = mfma32(ld_tr_perm<1, 16>(vtb), p1, out[1]);
            } else {
                out[0] = mfma32(ld_tr_perm<0, 32>(vtb), p0, out[0]); out[0] = mfma32(ld_tr_perm<0, 48>(vtb), p1, out[0]);
                out[1] = mfma32(ld_tr_perm<1, 32>(vtb), p0, out[1]); out[1] = mfma32(ld_tr_perm<1, 48>(vtb), p1, out[1]);
            }
        }
        headnorm_store_g<true>(out, hh, hng + 256 + h * 64, gt, 1.f, Y + (tok0 + i_) * D + 256 + h * 64);
    }
    LDS_FENCE();
}

__device__ __forceinline__ void gla_cumsum(LAS float* BL, const bf16* proj, const float* wa2, const float* ba, size_t tok0, int h, int lane) {
    const int k = lane & 31, hh = lane >> 5;
    bf16x8 wf;
    {
        float w[8];
#pragma unroll
        for (int j = 0; j < 8; ++j) w[j] = wa2[(8 * hh + j) * 128 + h * 32 + k];
        u32x4 p; p.x = cvtpk(w[0], w[1]); p.y = cvtpk(w[2], w[3]); p.z = cvtpk(w[4], w[5]); p.w = cvtpk(w[6], w[7]);
        wf = __builtin_bit_cast(bf16x8, p);
    }
    const float bias = ba[h * 32 + k];
    const int tau = 16 * ((k >> 2) & 1) + 4 * (k >> 3) + (k & 3);
    f32x16 z[2];
#pragma unroll
    for (int mi = 0; mi < 2; ++mi) {
        const bf16x8 af = ldg16(proj + PX(tok0 + 32 * mi + tau, COL_CA) + hh * PXC);
        f32x16 c0;
#pragma unroll
        for (int i = 0; i < 16; ++i) c0[i] = bias;
        z[mi] = mfma32(af, wf, c0);
    }
    float tot[2];
#pragma unroll
    for (int mi = 0; mi < 2; ++mi) {
        float run = 0.f;
#pragma unroll
        for (int i = 0; i < 16; ++i) {
            const float e = __builtin_amdgcn_exp2f(fminf(-z[mi][i] * LOG2E, 120.f));
            run -= __builtin_amdgcn_logf(1.f + e) * (1.f / 16.f);
            z[mi][i] = run;
        }
        tot[mi] = run;
    }
    const float oth0 = __int_as_float(__builtin_amdgcn_ds_bpermute((lane ^ 32) << 2, __float_as_int(tot[0])));
    const float oth1 = __int_as_float(__builtin_amdgcn_ds_bpermute((lane ^ 32) << 2, __float_as_int(tot[1])));
    const float off0 = hh ? oth0 : 0.f, off1 = tot[0] + oth0 + (hh ? oth1 : 0.f);
#pragma unroll
    for (int i = 0; i < 16; ++i) { BL[(16 * hh + i) * 33 + k] = z[0][i] + off0; BL[(32 + 16 * hh + i) * 33 + k] = z[1][i] + off1; }
    LDS_FENCE();
}
__device__ __forceinline__ float clamp_exp(float x) { return __builtin_amdgcn_exp2f(fminf(fmaxf(x, -115.f), 115.f)); }
__device__ __forceinline__ void gla_state_unit(LAS unsigned char* wl, const bf16* proj, const float* wa2, const float* ba, float* UC, float* GC, int b, int c, int h, int lane) {
    LAS float* BL = (LAS float*)wl; LAS unsigned char* VI = wl; LAS unsigned char* KI = wl + 9216;
    const size_t tok0 = (size_t)b * T + 64 * c;
    const int r = lane & 31, hh = lane >> 5;
    gla_cumsum(BL, proj, wa2, ba, tok0, h, lane);
    {
        const bf16* kp = proj + PX(tok0 + lane, COL_CK + h * 32);
#pragma unroll
        for (int ch = 0; ch < 4; ++ch) { const bf16x8 kv = ldg16(kp + ch * PXC);
            float x[8];
#pragma unroll
            for (int i = 0; i < 8; ++i) { const int kk = 8 * ch + i; x[i] = bf2f(kv[i]) * clamp_exp(BL[63 * 33 + kk] - BL[lane * 33 + kk]); }
            u32x4 w; w.x = cvtpk(x[0], x[1]); w.y = cvtpk(x[2], x[3]); w.z = cvtpk(x[4], x[5]); w.w = cvtpk(x[6], x[7]);
            *(LAS u32x4*)(KI + lane * 64 + ch * 16) = w; }
        if (lane < 32) GC[(size_t)((b * NCH + c) * 4 + h) * 32 + lane] = clamp_exp(BL[63 * 33 + lane]);
    }
    LDS_FENCE();
    stage_img64<false>(VI, proj, tok0, COL_CV + h * 64, lane, 1.f);
    LDS_FENCE();
    const LAS unsigned char* const vnb = tr_base_nat(VI, lane); const LAS unsigned char* const knb = tr_base_nat(KI, lane);
    float* uc = UC + (size_t)((b * NCH + c) * 4 + h) * 2048;
    f32x16 acc[2]; acc[0] = zero16(); acc[1] = zero16();
#define GS_STEP(K0) do { const bf16x8 a0 = ld_tr_nat<0, K0>(vnb), a1 = ld_tr_nat<1, K0>(vnb), b0_ = ld_tr_nat<0, K0>(knb); acc[0] = mfma32(a0, b0_, acc[0]); acc[1] = mfma32(a1, b0_, acc[1]); } while (0)
    GS_STEP(0); GS_STEP(16); GS_STEP(32); GS_STEP(48);
#undef GS_STEP
#pragma unroll
    for (int me = 0; me < 2; ++me)
#pragma unroll
        for (int i = 0; i < 16; ++i) uc[(32 * me + crow(i, hh)) * 32 + r] = acc[me][i];
    LDS_FENCE();
}
__device__ __forceinline__ void gla_frag(const bf16x8 v, const LAS float* bl, bf16x8& fp, bf16x8& fm) {
    float xp[8], xm[8];
#pragma unroll
    for (int j = 0; j < 8; ++j) { const float x = bf2f(v[j]), bb = bl[j]; xp[j] = x * clamp_exp(bb); xm[j] = x * clamp_exp(-bb); }
    u32x4 a, c;
    a.x = cvtpk(xp[0], xp[1]); a.y = cvtpk(xp[2], xp[3]); a.z = cvtpk(xp[4], xp[5]); a.w = cvtpk(xp[6], xp[7]);
    c.x = cvtpk(xm[0], xm[1]); c.y = cvtpk(xm[2], xm[3]); c.z = cvtpk(xm[4], xm[5]); c.w = cvtpk(xm[6], xm[7]);
    fp = __builtin_bit_cast(bf16x8, a); fm = __builtin_bit_cast(bf16x8, c);
}
__device__ __forceinline__ void gla_out_unit(LAS unsigned char* wl, const bf16* proj, const float* wa2, const float* ba, const bf16* SCB, const float* hng, bf16* Y, int b, int c, int h, int lane_in) {
    int lane = lane_in; asm volatile("" : "+v"(lane));
    LAS unsigned char* VI = wl; LAS float* BL = (LAS float*)(wl + 9216);
    const size_t tok0 = (size_t)b * T + 64 * c;
    const int r = lane & 31, hh = lane >> 5;
    bf16x8 vrow[8], kraw[2][2], qraw[2][2], stf[2][2];
    {
        const bf16* vp = proj + PX(tok0 + lane, COL_CV + h * 64);
#pragma unroll
        for (int ch = 0; ch < 8; ++ch) vrow[ch] = ldg16(vp + ch * PXC);
        const bf16* sc = SCB + (size_t)((b * NCH + c) * 4 + h) * 2048;
#pragma unroll
        for (int mi = 0; mi < 2; ++mi)
#pragma unroll
            for (int s = 0; s < 2; ++s) {
                kraw[mi][s] = ldg16(proj + PX(tok0 + 32 * mi + r, COL_CK + h * 32) + (2 * s + hh) * PXC);
                if (mi == 0) qraw[0][s] = ldg16(proj + PX(tok0 + r, COL_CQ + h * 32) + (2 * s + hh) * PXC);
                stf[mi][s] = ldg16(sc + (32 * mi + r) * 32 + 16 * s + 8 * hh);
            }
    }
    gla_cumsum(BL, proj, wa2, ba, tok0, h, lane);
#pragma unroll
    for (int ch = 0; ch < 8; ++ch) *(LAS bf16x8*)(VI + (ch >> 2) * 4096 + lane * 64 + (ch & 3) * 16) = vrow[ch];
    LDS_FENCE();
    const LAS unsigned char* const vtb = tr_base_perm(VI, lane);
    bf16x8 kp_[2][2], km_[2][2];
#pragma unroll
    for (int mi = 0; mi < 2; ++mi)
#pragma unroll
        for (int s = 0; s < 2; ++s) gla_frag(kraw[mi][s], BL + (32 * mi + r) * 33 + 16 * s + 8 * hh, kp_[mi][s], km_[mi][s]);
#pragma unroll
    for (int ni = 0; ni < 2; ++ni) {
        const int t_ = 32 * ni + r;
        if (ni == 0) {
#pragma unroll
            for (int s = 0; s < 2; ++s) qraw[1][s] = ldg16(proj + PX(tok0 + 32 + r, COL_CQ + h * 32) + (2 * s + hh) * PXC);
        }
        bf16x8 qp_[2], qm_[2];
#pragma unroll
        for (int s = 0; s < 2; ++s) gla_frag(qraw[ni][s], BL + t_ * 33 + 16 * s + 8 * hh, qp_[s], qm_[s]);
        f32x16 out[2];
#pragma unroll
        for (int me = 0; me < 2; ++me) {
            out[me] = zero16();
#pragma unroll
            for (int s = 0; s < 2; ++s) out[me] = mfma32(stf[me][s], qp_[s], out[me]);
        }
#pragma unroll
        for (int mi = 0; mi < 2; ++mi) {
            f32x16 x;
            if (mi < ni) {
                x = zero16();
#pragma unroll
                for (int s = 0; s < 2; ++s) x = mfma32(km_[mi][s], qp_[s], x);
            } else if (mi > ni) {
                x = zero16();
#pragma unroll
                for (int s = 0; s < 2; ++s) x = mfma32(kp_[mi][s], qm_[s], x);
            } else {
                f32x16 x1 = zero16(), x2 = zero16();
#pragma unroll
                for (int s = 0; s < 2; ++s) { x1 = mfma32(km_[mi][s], qp_[s], x1); x2 = mfma32(kp_[mi][s], qm_[s], x2); }
#pragma unroll
                for (int i = 0; i < 16; ++i) x[i] = (crow(i, hh) <= r) ? x1[i] : x2[i];
            }
            const bf16x8 p0 = pack8<0>(x), p1 = pack8<1>(x);
            if (mi == 0) {
                out[0] = mfma32(ld_tr_perm<0, 0>(vtb), p0, out[0]); out[0] = mfma32(ld_tr_perm<0, 16>(vtb), p1, out[0]);
                out[1] = mfma32(ld_tr_perm<1, 0>(vtb), p0, out[1]); out[1] = mfma32(ld_tr_perm<1, 16>(vtb), p1, out[1]);
            } else {
                out[0] = mfma32(ld_tr_perm<0, 32>(vtb), p0, out[0]); out[0] = mfma32(ld_tr_perm<0, 48>(vtb), p1, out[0]);
                out[1] = mfma32(ld_tr_perm<1, 32>(vtb), p0, out[1]); out[1] = mfma32(ld_tr_perm<1, 48>(vtb), p1, out[1]);
            }
        }
        headnorm_store<true, true>(out, hh, hng + 512 + h * 64, proj + PX(tok0 + t_, COL_CG + h * 64), 1.f, Y + (tok0 + t_) * D + 512 + h * 64);
    }
    LDS_FENCE();
}

#ifndef EN_P0
#define EN_P0 1
#endif
#ifndef EN_ROW
#define EN_ROW 1
#endif
#ifndef EN_G0
#define EN_G0 1
#endif
#ifndef EN_M1
#define EN_M1 1
#endif
#ifndef EN_M2
#define EN_M2 1
#endif
#ifndef EN_M3
#define EN_M3 1
#endif
#ifndef EN_G1
#define EN_G1 1
#endif
#ifndef EN_G2
#define EN_G2 1
#endif
#ifndef EN_G3
#define EN_G3 1
#endif
#ifndef EN_M1A
#define EN_M1A 1
#endif
#ifndef EN_M1A2
#define EN_M1A2 1
#endif
#ifndef EN_M1B
#define EN_M1B 1
#endif
#ifndef EN_M1C
#define EN_M1C 1
#endif
#ifndef EN_M3A
#define EN_M3A 1
#endif
#ifndef EN_M3B
#define EN_M3B 1
#endif
struct Args { const void* in[20]; float* out; unsigned char* ws; int ph_lo, ph_hi; };
#ifndef MK_ALIGN
#define MK_ALIGN true
#endif
#ifndef MK_SP2
#define MK_SP2 true
#endif

#ifndef REP_M1A
#define REP_M1A 1
#endif
#ifndef REP_M1B
#define REP_M1B 1
#endif
#ifndef REP_M1C
#define REP_M1C 1
#endif
#ifndef REP_M2A
#define REP_M2A 1
#endif
#ifndef REP_M2B
#define REP_M2B 1
#endif
#ifndef REP_M3
#define REP_M3 1
#endif
#ifndef REP_G
#define REP_G 1
#endif
#ifndef EN_SEAM
#define EN_SEAM 1
#endif
#ifndef NLAYER_LOOP
#define NLAYER_LOOP 2
#endif
__device__ __forceinline__ unsigned long long karg_raw(int idx) {
    const __attribute__((address_space(4))) unsigned char* k = (const __attribute__((address_space(4))) unsigned char*)__builtin_amdgcn_kernarg_segment_ptr();
    const unsigned long long v = *(const volatile __attribute__((address_space(4))) unsigned long long*)(k + 8 * idx);
    const unsigned lo = __builtin_amdgcn_readfirstlane((unsigned)v), hi = __builtin_amdgcn_readfirstlane((unsigned)(v >> 32));
    return ((unsigned long long)hi << 32) | lo;
}
template <class Tp> __device__ __forceinline__ Tp* kptr(int idx) { return (Tp*)(GAS Tp*)karg_raw(idx); }
#define KIN(idx) kptr<const float>(idx)
#define KWS() kptr<unsigned char>(21)
#define KOUT() kptr<float>(20)

__global__ void __launch_bounds__(NTHREADS, 2) mk_fwd(Args args) {
    extern __shared__ __attribute__((aligned(16))) unsigned char lds_raw[];
    LAS unsigned char* lds = (LAS unsigned char*)lds_raw;
    const int G = gridDim.x, bx = blockIdx.x;
    const int wave_s = __builtin_amdgcn_readfirstlane(threadIdx.x >> 6);
#define PHASE_IDS int tid; asm volatile("v_mbcnt_lo_u32_b32 %0, -1, 0\n\tv_mbcnt_hi_u32_b32 %0, -1, %0\n\tv_lshl_add_u32 %0, %1, 6, %0" : "=&v"(tid) : "s"(wave_s)); const int lane = tid & 63, wave = __builtin_amdgcn_readfirstlane(tid >> 6); const int gw = bx * NWAVES + wave, ngw = G * NWAVES; (void)gw; (void)ngw; (void)lane;

    for (int u = threadIdx.x; u < (LDS_BYTES - LDSCTL_OFF) / 4; u += NTHREADS) ((LAS unsigned*)(lds + LDSCTL_OFF))[u] = 0u;
    __syncthreads();
    const int lo = args.ph_lo, hi = args.ph_hi;
    if (hi - lo > 1) (void)xcd_barrier_post((unsigned*)(KWS() + WS_CTL) + CW_BAR, (volatile LAS unsigned*)(lds + LDSCTL_OFF));
#define IN(k) (lo <= (k) && (k) < hi)
#define SEAM(k) do { if (EN_SEAM && IN(k) && IN((k) + 1)) { XcdBarrier b_; b_.bar = (unsigned*)(KWS() + WS_CTL) + CW_BAR; b_.x = xb_xcc_id(); b_.st = (volatile LAS unsigned*)(lds + LDSCTL_OFF); xcd_barrier(b_); } } while (0)

    if (EN_P0 && IN(0)) {
        PHASE_IDS
        unsigned char* ws = KWS();
        LAS float* scr = (LAS float*)(lds + wave * 8448);
        constexpr int I_IN = (D / 64) * (NPROJ / 32), I_OUT = (D / 64) * (D / 32), I_1 = (D / 64) * (FF / 32), I_2 = (FF / 64) * (D / 32), I_AIN = (D * NPROJ_SRC) / 2048, I_L = I_IN + I_OUT + I_1 + I_2 + I_AIN;
        static_assert((D * NPROJ_SRC) % 2048 == 0, "w_in absmax items");
        {
            LAS float* condT = (LAS float*)lds;
            LAS float* part = (LAS float*)(lds + 65536);
            const float* c_in = KIN(1); const float* mod_w = KIN(3); const float* mod_b = KIN(4); float* MOD = (float*)(ws + WS_MOD);
            for (int i = tid; i < BATCH * D; i += NTHREADS) { const int b = i >> 10, k = i & 1023; const float v = c_in[i]; condT[k * 16 + b] = v / (1.f + expf(-v)); }
            __syncthreads();
            for (int cg = bx; cg < 256; cg += G) {
                const int l = cg >> 7, jj = 48 * (cg & 127) + (lane < 48 ? lane : 0);
                float acc[16];
#pragma unroll
                for (int b = 0; b < 16; ++b) acc[b] = 0.f;
                const float* wp = mod_w + ((size_t)l * D + 128 * wave) * 6144 + jj;
#pragma unroll 16
                for (int k = 0; k < 128; ++k) {
                    const float w = wp[(size_t)k * 6144];
                    const LAS float* cp = condT + (128 * wave + k) * 16;
                    const f32x4 c0 = *(const LAS f32x4*)(cp), c1 = *(const LAS f32x4*)(cp + 4), c2 = *(const LAS f32x4*)(cp + 8), c3 = *(const LAS f32x4*)(cp + 12);
#pragma unroll
                    for (int b = 0; b < 4; ++b) { acc[b] += c0[b] * w; acc[4 + b] += c1[b] * w; acc[8 + b] += c2[b] * w; acc[12 + b] += c3[b] * w; }
                }
                if (lane < 48) {
#pragma unroll
                    for (int b = 0; b < 16; ++b) part[(wave * 16 + b) * 48 + lane] = acc[b];
                }
                __syncthreads();
                for (int o = tid; o < 768; o += NTHREADS) {
                    const int b = o / 48, cc = o % 48, j = 48 * (cg & 127) + cc;
                    float s = mod_b[l * 6144 + j];
#pragma unroll
                    for (int w8 = 0; w8 < 8; ++w8) s += part[(w8 * 16 + b) * 48 + cc];
                    MOD[(size_t)(l * 16 + b) * 6144 + j] = s;
                }
                __syncthreads();
            }
        }
        const float* w_in = KIN(9); const float* w_out = KIN(17); const float* mlp_w1 = KIN(18); const float* mlp_w2 = KIN(19);
        for (int it = gw; it < 2 * I_L; it += ngw) {
            const int l = it / I_L; int rr = it % I_L;
            unsigned char* wl = ws + WS_W + (size_t)l * W_LAYER;
            if (rr < I_IN) { transpose_item<true>(w_in + (size_t)l * D * NPROJ_SRC, D, NPROJ_SRC, NPROJ, (bf16*)(wl + W_IN), scr, rr, lane); continue; } rr -= I_IN;
            if (rr < I_OUT) { transpose_item<false>(w_out + (size_t)l * D * D, D, D, D, (bf16*)(wl + W_OUT), scr, rr, lane); continue; } rr -= I_OUT;
            if (rr < I_1) {
                const float* wp = mlp_w1 + (size_t)l * D * FF + (size_t)rr * 2048 + 4 * lane; float am = 0.f;
#pragma unroll
                for (int j = 0; j < 8; ++j) { const f32x4 t = *(const f32x4*)(wp + 256 * j); am = fmaxf(am, fmaxf(fmaxf(fabsf(t[0]), fabsf(t[1])), fmaxf(fabsf(t[2]), fabsf(t[3])))); }
                am = wave_max(am);
                if (lane == 0) atomicMax((unsigned*)(ws + WS_CTL) + CW_W1MAX + l, __float_as_uint(am));
                continue; } rr -= I_1;
            if (rr < I_2) { transpose_item_f8(mlp_w2 + (size_t)l * FF * D, FF, D, wl + W_2, scr, rr, lane); continue; } rr -= I_2;
            {
                const float* wp = w_in + (size_t)l * D * NPROJ_SRC + (size_t)rr * 2048 + 4 * lane; float am = 0.f;
#pragma unroll
                for (int j = 0; j < 8; ++j) { const f32x4 t = *(const f32x4*)(wp + 256 * j); am = fmaxf(am, fmaxf(fmaxf(fabsf(t[0]), fabsf(t[1])), fmaxf(fabsf(t[2]), fabsf(t[3])))); }
                am = wave_max(am);
                if (lane == 0) atomicMax((unsigned*)(ws + WS_CTL) + CW_WINMAX + l, __float_as_uint(am));
            }
        }
    }
    SEAM(0);
    if (EN_ROW && IN(1)) { PHASE_IDS unsigned char* ws = KWS(); const float* MOD = (const float*)(ws + WS_MOD);
        {
            LAS float* scr = (LAS float*)(lds + wave * 8448); const float* mlp_w1 = KIN(18);
            constexpr int I_1 = (D / 64) * (FF / 32);
            for (int it = gw; it < 2 * I_1; it += ngw) {
                const int l = it / I_1, rr = it % I_1;
                const float amax = fmaxf(__uint_as_float(__hip_atomic_load((unsigned*)(ws + WS_CTL) + CW_W1MAX + l, __ATOMIC_RELAXED, __HIP_MEMORY_SCOPE_AGENT)), 1.0e-30f);
                transpose_item_i8(mlp_w1 + (size_t)l * D * FF, D, FF, ws + WS_W + (size_t)l * W_LAYER + W_1, scr, rr, lane, 127.f / amax);
            }
            const float* w_in = KIN(9);
            constexpr int I_IN8 = (D / 64) * 64;
            for (int it = gw; it < 2 * I_IN8; it += ngw) {
                const int l = it / I_IN8, rr = it % I_IN8, kb = rr / 64, nb = rr % 64, t8 = nb >> 3, pn = t8 < 7 ? 4 + t8 : 13;
                const float amax = fmaxf(__uint_as_float(__hip_atomic_load((unsigned*)(ws + WS_CTL) + CW_WINMAX + l, __ATOMIC_RELAXED, __HIP_MEMORY_SCOPE_AGENT)), 1.0e-30f);
                transpose_item_i8_win(w_in + (size_t)l * D * NPROJ_SRC, ws + WS_W + (size_t)l * W_LAYER + W_IN8, scr, kb, pn * 256 + (nb & 7) * 32, lane, 127.f / amax);
            }
        }
        rowpass<false, true, false, false, 2>(KIN(0), nullptr, nullptr, nullptr, nullptr, nullptr, nullptr, nullptr, KIN(5), MOD + 1 * D, MOD + 0 * D, (bf16*)(ws + WS_H), gw, ngw, lane, (float*)(ws + WS_HSP), ws + WS_H8P); }
    SEAM(1);

    for (int l = 0; l < NLAYER_LOOP; ++l) {
        const int pb = 2 + 9 * l;
        if (EN_G0 && IN(pb + 0)) for (int rep = 0; rep < REP_G; ++rep) {
            unsigned char* ws = KWS();
            {
                pg8::Gemm g{(const bf16*)(ws + WS_H), (const bf16*)(ws + WS_W + (size_t)l * W_LAYER + W_IN), M, NPROJ, D}; pg8::MapOrder S; S.init(M, G, bx, 0);
                EpiProj<false> E{(bf16*)(ws + WS_PROJ), kptr<const int>(2), (bf16*)(ws + WS_KIP), nullptr, nullptr};
                { PHASE_IDS pg8::gemm_phase<EpiProj<false>, pg8::MapOrder, MK_ALIGN, MK_SP2>(lds, g, S, E, tid); }
            }
            {
                pg8::Gemm g{(const bf16*)(ws + WS_H8P), (const bf16*)(ws + WS_W + (size_t)l * W_LAYER + W_IN8), M, NPROJ, D / 2}; pg8::MapOrder S; S.init(M, G, bx, 1);
                EpiProj<true> E{(bf16*)(ws + WS_PROJ), kptr<const int>(2), (bf16*)(ws + WS_KIP), (const float*)(ws + WS_HSP), (const unsigned*)(ws + WS_CTL) + CW_WINMAX + l};
                { PHASE_IDS pg8::gemm_phase<EpiProj<true>, pg8::MapOrder, MK_ALIGN, MK_SP2, false, true>(lds, g, S, E, tid); }
            }
        }
        SEAM(pb + 0);
        if (EN_M1 && IN(pb + 1)) {
            for (int rep = 0; rep < REP_M1A; ++rep) {
                PHASE_IDS
                unsigned char* ws = KWS(); const bf16* PROJ = (const bf16*)(ws + WS_PROJ);
                float* UB = (float*)(ws + WS_UB); float* UC = (float*)(ws + WS_UC); float* GC = (float*)(ws + WS_GC);
                const float* gla_wa2 = KIN(10) + l * 16 * 128; const float* gla_ba = KIN(11) + l * 128;
                if (EN_M1A) for (int wu = gw; wu < 4096; wu += ngw) { const int b = wu >> 8, c = (wu >> 2) & 63, h = wu & 3; ret_state_unit(lds + wave * 18432, PROJ, UB, b, c, h, lane); }
                __builtin_amdgcn_sched_barrier(0);
                if (EN_M1A2) for (int wu = gw; wu < 4096; wu += ngw) { const int b = wu >> 8, c = (wu >> 2) & 63, h = wu & 3; gla_state_unit(lds + wave * 18432, PROJ, gla_wa2, gla_ba, UC, GC, b, c, h, lane); }
            }
            __syncthreads();
            if (EN_M1B) for (int rep = 0; rep < REP_M1B; ++rep) {
                PHASE_IDS
                unsigned char* ws = KWS(); const bf16* PROJ = (const bf16*)(ws + WS_PROJ);
                const float lam_init = 0.8f - 0.6f * expf(-0.3f * (float)l);
                float a1 = 0.f, a2 = 0.f;
                if (lane < 32) { a1 = KIN(12)[l * 32 + lane] * KIN(13)[l * 32 + lane]; a2 = KIN(14)[l * 32 + lane] * KIN(15)[l * 32 + lane]; }
                const float lam = expf(wave_sum(a1)) - expf(wave_sum(a2)) + lam_init;
                bf16* Y = (bf16*)(ws + WS_Y); const float* hng = KIN(16) + l * D;
                for (int i = bx; i < 1024; i += G) {
                    const int bh = i & 63, slot = i >> 6, qb = slot ^ ((slot & 4) ? 3 : 0);
                    diff_unit(lds, PROJ, Y, hng, lam, lam_init, bh >> 2, bh & 3, qb, tid, lane, wave);
                }
            }
            if (EN_M1C) for (int rep = 0; rep < REP_M1C; ++rep) {
                PHASE_IDS
                unsigned char* ws = KWS(); const bf16* PROJ = (const bf16*)(ws + WS_PROJ);
                u64* MASK = (u64*)(ws + WS_MASK);
                for (int i = bx; i < 8192; i += G) {
                    const int b = i & 15, slot = i >> 4, g8 = slot ^ ((slot & 16) ? 15 : 0);
                    indexer_unit(lds, PROJ, (const bf16*)(ws + WS_KIP), MASK, b, g8, lane, wave);
                }
            }
        }
        SEAM(pb + 1);
        if (EN_M2 && IN(pb + 2)) {
            for (int rep = 0; rep < REP_M2A; ++rep) {
                PHASE_IDS
                unsigned char* ws = KWS();
                const float* UB = (const float*)(ws + WS_UB); bf16* RB = (bf16*)(ws + WS_RB);
                for (int e = bx * NTHREADS + tid; e < 16 * 4 * 4096; e += G * NTHREADS) {
                    const int b = e >> 14, h = (e >> 12) & 3, ed = e & 4095;
                    const float g64 = exp2f(64.f * ret_log2g(h));
                    float rs = 0.f, uu[NCH];
#pragma unroll
                    for (int c = 0; c < NCH; ++c) uu[c] = UB[(size_t)((b * NCH + c) * 4 + h) * 4096 + ed];
#pragma unroll
                    for (int c = 0; c < NCH; ++c) { RB[(size_t)((b * NCH + c) * 4 + h) * 4096 + ed] = f2bf(rs); rs = g64 * rs + uu[c]; }
                }
                const float* UC = (const float*)(ws + WS_UC); const float* GC = (const float*)(ws + WS_GC); bf16* SCB = (bf16*)(ws + WS_SCB);
                for (int e = bx * NTHREADS + tid; e < 16 * 4 * 2048; e += G * NTHREADS) {
                    const int b = e >> 13, h = (e >> 11) & 3, dk = e & 2047, k = e & 31;
                    float st = 0.f;
                    for (int c0 = 0; c0 < NCH; c0 += 32) {
                        float uu[32], gg[32];
#pragma unroll
                        for (int c = 0; c < 32; ++c) { const size_t u0 = (size_t)((b * NCH + c0 + c) * 4 + h); uu[c] = UC[u0 * 2048 + dk]; gg[c] = GC[u0 * 32 + k]; }
#pragma unroll
                        for (int c = 0; c < 32; ++c) { const size_t u0 = (size_t)((b * NCH + c0 + c) * 4 + h); SCB[u0 * 2048 + dk] = f2bf(st); st = gg[c] * st + uu[c]; }
                    }
                }
            }
            __syncthreads();
            for (int rep = 0; rep < REP_M2B; ++rep) {
                PHASE_IDS
                unsigned char* ws = KWS();
                const bf16* PROJ = (const bf16*)(ws + WS_PROJ); const u64* MASK = (const u64*)(ws + WS_MASK); bf16* Y = (bf16*)(ws + WS_Y); const float* hng = KIN(16) + l * D;
                for (int i = bx; i < 1024; i += G) {
                    const int b = i & 15, slot = i >> 4, qc = slot ^ ((slot & 16) ? 15 : 0);
                    dsa_unit(lds, PROJ, MASK, Y, hng, b, qc, tid, lane, wave);
                }
            }
        }
        SEAM(pb + 2);
        if (EN_M3 && IN(pb + 3)) for (int rep = 0; rep < REP_M3; ++rep) {
            PHASE_IDS
            unsigned char* ws = KWS();
            const bf16* PROJ = (const bf16*)(ws + WS_PROJ); bf16* Y = (bf16*)(ws + WS_Y); const float* hng = KIN(16) + l * D;
            const bf16* RB = (const bf16*)(ws + WS_RB); const bf16* SCB = (const bf16*)(ws + WS_SCB);
            const float* gla_wa2 = KIN(10) + l * 16 * 128; const float* gla_ba = KIN(11) + l * 128;
            if (EN_M3A) for (int wu = gw; wu < 4096; wu += ngw) { const int b = wu >> 8, c = (wu >> 2) & 63, h = wu & 3; ret_out_unit(lds + wave * 18432, PROJ, RB, hng, Y, b, c, h, lane); }
            __builtin_amdgcn_sched_barrier(0);
            if (EN_M3B) for (int wu = gw; wu < 4096; wu += ngw) { const int b = wu >> 8, c = (wu >> 2) & 63, h = wu & 3; gla_out_unit(lds + wave * 18432, PROJ, gla_wa2, gla_ba, SCB, hng, Y, b, c, h, lane); }
            __syncthreads();
        }
        SEAM(pb + 3);
        if (EN_G1 && IN(pb + 4)) for (int rep = 0; rep < REP_G; ++rep) {
            unsigned char* ws = KWS();
            pg8::Gemm g{(const bf16*)(ws + WS_Y), (const bf16*)(ws + WS_W + (size_t)l * W_LAYER + W_OUT), M, D, D}; pg8::StaticOrder S; S.init(M, D, G, bx);
            EpiY2 E{(bf16*)(ws + WS_Y2), (float*)(ws + WS_SS), 1.f};
            { PHASE_IDS pg8::gemm_phase<EpiY2, pg8::StaticOrder, MK_ALIGN, MK_SP2>(lds, g, S, E, tid); }
        }
        SEAM(pb + 4);
        if (EN_ROW && IN(pb + 5)) {
            PHASE_IDS
            unsigned char* ws = KWS(); const float* modl = (const float*)(ws + WS_MOD) + (size_t)l * 16 * 6144; float* out = KOUT();
            rowpass<true, true, false, true, 1>(l == 0 ? KIN(0) : (const float*)out, nullptr, (bf16*)(ws + WS_X1A), (bf16*)(ws + WS_X1B), (const bf16*)(ws + WS_Y2), (const float*)(ws + WS_SS), KIN(6) + l * D, modl + 2 * D, KIN(7) + l * D, modl + 4 * D, modl + 3 * D, (bf16*)(ws + WS_H), gw, ngw, lane, (float*)(ws + WS_HS), ws + WS_H);
        }
        SEAM(pb + 5);
        if (EN_G2 && IN(pb + 6)) for (int rep = 0; rep < REP_G; ++rep) {
            unsigned char* ws = KWS();
            pg8::Gemm g{(const bf16*)(ws + WS_H), (const bf16*)(ws + WS_W + (size_t)l * W_LAYER + W_1), M, FF, D / 2}; pg8::StaticOrder S; S.init(M, FF, G, bx);
            EpiRelu2I8 E{ws + WS_U, (const float*)(ws + WS_HS), (const unsigned*)(ws + WS_CTL) + CW_W1MAX + l};
            { PHASE_IDS pg8::gemm_phase<EpiRelu2I8, pg8::StaticOrder, MK_ALIGN, MK_SP2, false, true>(lds, g, S, E, tid); }
        }
        SEAM(pb + 6);
        if (EN_G3 && IN(pb + 7)) for (int rep = 0; rep < REP_G; ++rep) {
            unsigned char* ws = KWS();
            pg8::Gemm g{(const bf16*)(ws + WS_U), (const bf16*)(ws + WS_W + (size_t)l * W_LAYER + W_2), M, D, FF / 2}; pg8::StaticOrder S; S.init(M, D, G, bx);
            EpiY2 E{(bf16*)(ws + WS_Y2), (float*)(ws + WS_SS), 1.f / (U_SCALE * W2_SCALE)};
            { PHASE_IDS pg8::gemm_phase<EpiY2, pg8::StaticOrder, MK_ALIGN, MK_SP2, true>(lds, g, S, E, tid); }
        }
        SEAM(pb + 7);
        if (EN_ROW && IN(pb + 8)) {
            PHASE_IDS
            unsigned char* ws = KWS(); const float* MOD = (const float*)(ws + WS_MOD); const float* modl = MOD + (size_t)l * 16 * 6144; float* out = KOUT();
            if (l == 0) rowpass<true, true, true, false, 2>(nullptr, out, (bf16*)(ws + WS_X1A), (bf16*)(ws + WS_X1B), (const bf16*)(ws + WS_Y2), (const float*)(ws + WS_SS), KIN(8) + l * D, modl + 5 * D, KIN(5) + D, MOD + (size_t)16 * 6144 + 1 * D, MOD + (size_t)16 * 6144 + 0 * D, (bf16*)(ws + WS_H), gw, ngw, lane, (float*)(ws + WS_HSP), ws + WS_H8P);
            else rowpass<true, false, true, false>(nullptr, out, (bf16*)(ws + WS_X1A), (bf16*)(ws + WS_X1B), (const bf16*)(ws + WS_Y2), (const float*)(ws + WS_SS), KIN(8) + l * D, modl + 5 * D, nullptr, nullptr, nullptr, nullptr, gw, ngw, lane);
        }
        SEAM(pb + 8);
    }
#undef IN
#undef SEAM
}

#ifndef MK_N_LAUNCHES
#define MK_N_LAUNCHES 1
#endif
extern "C" void kernel_launch(void* const* d_in, const int* in_sizes, int n_in, void* d_out, int out_size, void* d_ws, size_t ws_size, hipStream_t stream) {
    static int grid = 0;
    if (grid == 0) {
        if (n_in != 20 || out_size != M * D || ws_size < WS_END) { fprintf(stderr, "kernel_launch: unexpected problem (n_in %d, out %d, ws %zu)\n", n_in, out_size, ws_size); grid = -1; return; }
        int dev = 0, cus = 0, per_cu = 0;
        if (hipGetDevice(&dev) != hipSuccess || hipDeviceGetAttribute(&cus, hipDeviceAttributeMultiprocessorCount, dev) != hipSuccess) { grid = -1; return; }
        if (hipFuncSetAttribute((const void*)mk_fwd, hipFuncAttributeMaxDynamicSharedMemorySize, LDS_BYTES) != hipSuccess) { fprintf(stderr, "kernel_launch: hipFuncSetAttribute failed\n"); grid = -1; return; }
        if (hipOccupancyMaxActiveBlocksPerMultiprocessor(&per_cu, (const void*)mk_fwd, NTHREADS, LDS_BYTES) != hipSuccess || per_cu < 1) fprintf(stderr, "kernel_launch: occupancy query says %d\n", per_cu);
        (void)hipGetLastError();
        grid = cus;
    }
    if (grid < 0) return;
    (void)hipMemsetAsync((char*)d_ws + WS_CTL, 0, CTL_ZERO_BYTES, stream);
    Args a{};
    for (int i = 0; i < 20; ++i) a.in[i] = d_in[i];
    a.out = (float*)d_out; a.ws = (unsigned char*)d_ws;
    if (MK_N_LAUNCHES == 1) { a.ph_lo = 0; a.ph_hi = NPHASES; hipLaunchKernelGGL(mk_fwd, dim3(grid), dim3(NTHREADS), LDS_BYTES, stream, a); }
    else for (int p = 0; p < NPHASES; ++p) { a.ph_lo = p; a.ph_hi = p + 1; hipLaunchKernelGGL(mk_fwd, dim3(grid), dim3(NTHREADS), LDS_BYTES, stream, a); }
}
```
